# Optimizing an MI355X kernel written in HIP

```python
import jax, jax.numpy as jnp
from jax import lax
import numpy as np

D_MODEL = 2048
BATCH = 4
SEQ = 4096
DEPTH = 4

GRID_W = 64
CTX_LEN = 256
N_MIXERS = 2
N_RET_LAYERS = (DEPTH + N_MIXERS - 1) // N_MIXERS
N_HG_LAYERS = DEPTH // N_MIXERS
RET_HEADS = 8
RET_HEAD_DIM = D_MODEL // RET_HEADS
RET_CHUNK = 128
HG_EXPAND = 128
HG_HEADS = D_MODEL // HG_EXPAND
HG_CHUNK = 64
FFN_HIDDEN = -(-8 * D_MODEL // (3 * 256)) * 256
ROPE_BASE = 10000.0
EPS = 1e-6

kernel_name = "hybrid_retention_hgrn2_prefix_dit"


def rms_norm(x, gain):
    xf = x.astype(jnp.float32)
    y = xf * lax.rsqrt(jnp.mean(xf * xf, axis=-1, keepdims=True) + EPS)
    return (y * gain.astype(jnp.float32)).astype(x.dtype)


def modulate(h, shift, scale):
    return h * (1 + scale) + shift


def swiglu(h, w_gate_up, w_down):
    a, b = jnp.split(h @ w_gate_up, 2, axis=-1)
    return (jax.nn.silu(a) * b) @ w_down


def grid_positions(seq):
    rows_n = seq // GRID_W
    rows = jnp.repeat(jnp.arange(rows_n, dtype=jnp.float32), GRID_W)
    cols = jnp.tile(jnp.arange(GRID_W, dtype=jnp.float32), rows_n)
    return rows, cols


def rope_2d(t, rows, cols):
    half = t.shape[-1] // 2
    quarter = half // 2
    inv_freq = ROPE_BASE ** (-jnp.arange(quarter, dtype=jnp.float32) / quarter)
    ang = jnp.concatenate([rows[:, None] * inv_freq, cols[:, None] * inv_freq], axis=-1)
    cos, sin = jnp.cos(ang), jnp.sin(ang)
    t1, t2 = t[..., :half], t[..., half:]
    return jnp.concatenate([t1 * cos - t2 * sin, t1 * sin + t2 * cos], axis=-1)


def to_heads(t, n_heads):
    b, n, _ = t.shape
    return t.reshape(b, n, n_heads, -1).transpose(0, 2, 1, 3).astype(jnp.float32)


def from_heads(t):
    b, h, n, d = t.shape
    return t.transpose(0, 2, 1, 3).reshape(b, n, h * d)


def identity(t):
    return t


def flip_seq(t):
    return jnp.flip(t, axis=2)


def to_chunks(t, size):
    b, h, n, d = t.shape
    return t.reshape(b, h, n // size, size, d).transpose(2, 0, 1, 3, 4)


def from_chunks(t):
    n, b, h, size, d = t.shape
    return t.transpose(1, 2, 0, 3, 4).reshape(b, h, n * size, d)


def retention_chunks(q, k, v, log_gamma, s0):
    size = RET_CHUNK
    idx = jnp.arange(size, dtype=jnp.float32)
    lg = log_gamma[:, None]
    diff = idx[:, None] - idx[None, :]
    intra = jnp.where(diff >= 0, jnp.exp(lg[:, :, None] * jnp.maximum(diff, 0.0)), 0.0)
    q_dec = jnp.exp(lg * (idx + 1.0))[:, :, None]
    k_dec = jnp.exp(lg * (size - 1.0 - idx))[:, :, None]
    c_dec = jnp.exp(log_gamma * size)[:, None, None]

    def step(s, blk):
        qb, kb, vb = blk
        scores = jnp.einsum('bhnd,bhmd->bhnm', qb, kb) * intra
        o = jnp.einsum('bhnm,bhme->bhne', scores, vb) + jnp.einsum('bhnd,bhde->bhne', qb * q_dec, s)
        s = s * c_dec + jnp.einsum('bhmd,bhme->bhde', kb * k_dec, vb)
        return s, o

    s, o = lax.scan(step, s0, (to_chunks(q, size), to_chunks(k, size), to_chunks(v, size)))
    return from_chunks(o), s


def retention_state(k, v, log_gamma):
    n = k.shape[2]
    w = jnp.exp(log_gamma[:, None] * (n - 1.0 - jnp.arange(n, dtype=jnp.float32)))
    return jnp.einsum('bhtd,bhte->bhde', k * w[:, :, None], v)


def hgrn_chunks(q, k, v, log_f, s0):
    size = HG_CHUNK
    causal = jnp.tril(jnp.ones((size, size), dtype=bool))[:, :, None]

    def step(s, blk):
        qb, kb, vb, gb = blk
        cum = jnp.cumsum(gb, axis=2)
        diff = cum[:, :, :, None, :] - cum[:, :, None, :, :]
        pair = jnp.where(causal, jnp.exp(jnp.minimum(diff, 0.0)), 0.0)
        scores = jnp.einsum('bhnd,bhmd,bhnmd->bhnm', qb, kb, pair)
        o = jnp.einsum('bhnm,bhme->bhne', scores, vb) + jnp.einsum('bhnd,bhde->bhne', qb * jnp.exp(cum), s)
        cum_end = cum[:, :, -1:, :]
        s = jnp.exp(cum_end[:, :, 0, :, None]) * s + jnp.einsum('bhmd,bhme->bhde', kb * jnp.exp(cum_end - cum), vb)
        return s, o

    s, o = lax.scan(step, s0, (to_chunks(q, size), to_chunks(k, size), to_chunks(v, size), to_chunks(log_f, size)))
    return from_chunks(o), s


def hgrn_state(k, v, log_f):
    cum = jnp.cumsum(log_f, axis=2)
    return jnp.einsum('bhtd,bhte->bhde', k * jnp.exp(cum[:, :, -1:, :] - cum), v)


def retention_mixer(h, hc, w_in, w_out, decay_logits, ctx_out):
    rows, cols = grid_positions(h.shape[1])
    k_scale = RET_HEAD_DIM ** -0.5
    q, k, v, g = jnp.split(h @ w_in, 4, axis=-1)
    qc, kc, vc, gc = jnp.split(hc @ w_in, 4, axis=-1)
    q = rope_2d(to_heads(q, RET_HEADS), rows, cols)
    k = rope_2d(to_heads(k, RET_HEADS), rows, cols) * k_scale
    v = to_heads(v, RET_HEADS)
    qc = to_heads(qc, RET_HEADS)
    kc = to_heads(kc, RET_HEADS) * k_scale
    vc = to_heads(vc, RET_HEADS)
    log_gamma = jax.nn.log_sigmoid(decay_logits.astype(jnp.float32))
    s_zero = jnp.zeros(kc.shape[:2] + (kc.shape[-1], vc.shape[-1]), jnp.float32)
    o_lat, o_ctx = 0.0, 0.0
    for d, orient in enumerate((identity, flip_seq)):
        if ctx_out:
            oc, s_ctx = retention_chunks(orient(qc), orient(kc), orient(vc), log_gamma[d], s_zero)
            o_ctx = o_ctx + orient(oc)
        else:
            s_ctx = retention_state(orient(kc), orient(vc), log_gamma[d])
        ol, _ = retention_chunks(orient(q), orient(k), orient(v), log_gamma[d], s_ctx)
        o_lat = o_lat + orient(ol)

    def readout(o, gate):
        o = o * lax.rsqrt(jnp.mean(o * o, axis=-1, keepdims=True) + EPS)
        return (from_heads(o).astype(gate.dtype) * jax.nn.silu(gate)) @ w_out

    return readout(o_lat, g), (readout(o_ctx, gc) if ctx_out else None)


def hgrn_mixer(h, hc, w_in, w_out, norm_gain, lower_bound, ctx_out):
    lb = lower_bound.astype(jnp.float32).reshape(HG_HEADS, 1, HG_EXPAND)

    def project(t):
        q, f_fwd, f_bwd, i, g = jnp.split(t @ w_in, 5, axis=-1)
        return (jax.nn.silu(to_heads(q, HG_HEADS)),
                (to_heads(f_fwd, HG_HEADS), to_heads(f_bwd, HG_HEADS)),
                to_heads(i, HG_HEADS), g)

    def gates(z):
        f = lb + (1.0 - lb) * jax.nn.sigmoid(z)
        return jnp.log(f), (1.0 - lb) * jax.nn.sigmoid(-z)

    q, fz, i, g = project(h)
    qc, fzc, ic, gc = project(hc)
    s_zero = jnp.zeros(ic.shape[:2] + (HG_EXPAND, ic.shape[-1]), jnp.float32)
    o_lat, o_ctx = 0.0, 0.0
    for d, orient in enumerate((identity, flip_seq)):
        log_f, key = gates(fz[d])
        log_fc, keyc = gates(fzc[d])
        if ctx_out:
            oc, s_ctx = hgrn_chunks(orient(qc), orient(keyc), orient(ic), orient(log_fc), s_zero)
            o_ctx = o_ctx + orient(oc)
        else:
            s_ctx = hgrn_state(orient(keyc), orient(ic), orient(log_fc))
        ol, _ = hgrn_chunks(orient(q), orient(key), orient(i), orient(log_f), s_ctx)
        o_lat = o_lat + orient(ol)

    def readout(o, gate):
        return (rms_norm(from_heads(o), norm_gain).astype(gate.dtype) * jax.nn.sigmoid(gate)) @ w_out

    return readout(o_lat, g), (readout(o_ctx, gc) if ctx_out else None)


def setup_inputs(seed: int = 0) -> dict:
    key = jax.random.key(seed)
    ks = jax.random.split(key, 18)
    f32 = jnp.float32
    D = D_MODEL

    def nrm(k, shape, scale):
        return jax.random.normal(k, shape, f32) * scale

    base_logit = jnp.log(jnp.exp2(5.0 + jnp.arange(RET_HEADS, dtype=f32)) - 1.0)
    return {
        "x": nrm(ks[0], (BATCH, SEQ, D), 1.0),
        "c": nrm(ks[1], (BATCH, D), 1.0),
        "ctx": nrm(ks[2], (BATCH, CTX_LEN, D), 1.0),
        "c_ctx": nrm(ks[3], (D,), 1.0),
        "ada_w": nrm(ks[4], (DEPTH, D, 6 * D), 0.5 * D ** -0.5),
        "ada_b": nrm(ks[5], (DEPTH, 6 * D), 0.02),
        "norm1_g": 1.0 + nrm(ks[6], (DEPTH, D), 0.02),
        "norm2_g": 1.0 + nrm(ks[7], (DEPTH, D), 0.02),
        "ret_w_in": nrm(ks[8], (N_RET_LAYERS, D, 4 * D), D ** -0.5),
        "ret_w_out": nrm(ks[9], (N_RET_LAYERS, D, D), D ** -0.5),
        "ret_decay_logits": base_logit + nrm(ks[10], (N_RET_LAYERS, 2, RET_HEADS), 0.1),
        "hg_w_in": nrm(ks[11], (N_HG_LAYERS, D, 5 * D), D ** -0.5),
        "hg_w_out": nrm(ks[12], (N_HG_LAYERS, D, D), D ** -0.5),
        "hg_norm_g": 1.0 + nrm(ks[13], (N_HG_LAYERS, D), 0.02),
        "hg_lower_bounds": nrm(ks[14], (N_HG_LAYERS, D), 0.1),
        "ffn_w_gate_up": nrm(ks[15], (DEPTH, D, 2 * FFN_HIDDEN), D ** -0.5),
        "ffn_w_down": nrm(ks[16], (DEPTH, FFN_HIDDEN, D), FFN_HIDDEN ** -0.5),
        "final_norm_g": 1.0 + nrm(ks[17], (D,), 0.02),
    }


def reference(x, c, ctx, c_ctx, ada_w, ada_b, norm1_g, norm2_g, ret_w_in, ret_w_out,
              ret_decay_logits, hg_w_in, hg_w_out, hg_norm_g, hg_lower_bounds,
              ffn_w_gate_up, ffn_w_down, final_norm_g):
    lb_p = jax.nn.softmax(hg_lower_bounds.astype(jnp.float32), axis=0)
    lower_bounds = jnp.cumsum(lb_p, axis=0) - lb_p[0]
    c_act = jax.nn.silu(c)
    cc_act = jax.nn.silu(c_ctx)
    for layer in range(DEPTH):
        last = layer == DEPTH - 1
        j = layer // N_MIXERS
        mod = (c_act @ ada_w[layer] + ada_b[layer])[:, None, :]
        mod_c = cc_act @ ada_w[layer] + ada_b[layer]
        sh1, sc1, gt1, sh2, sc2, gt2 = jnp.split(mod, 6, axis=-1)
        csh1, csc1, cgt1, csh2, csc2, cgt2 = jnp.split(mod_c, 6, axis=-1)
        h = modulate(rms_norm(x, norm1_g[layer]), sh1, sc1)
        hc = modulate(rms_norm(ctx, norm1_g[layer]), csh1, csc1)
        if layer % N_MIXERS == 0:
            mix, mix_c = retention_mixer(h, hc, ret_w_in[j], ret_w_out[j], ret_decay_logits[j], not last)
        else:
            mix, mix_c = hgrn_mixer(h, hc, hg_w_in[j], hg_w_out[j], hg_norm_g[j], lower_bounds[j], not last)
        x = x + gt1 * mix
        x = x + gt2 * swiglu(modulate(rms_norm(x, norm2_g[layer]), sh2, sc2),
                             ffn_w_gate_up[layer], ffn_w_down[layer])
        if not last:
            ctx = ctx + cgt1 * mix_c
            ctx = ctx + cgt2 * swiglu(modulate(rms_norm(ctx, norm2_g[layer]), csh2, csc2),
                                      ffn_w_gate_up[layer], ffn_w_down[layer])
    return rms_norm(x, final_norm_g)
```

```cpp
#include <hip/hip_runtime.h>
#include <cstdio>
#include <cstdint>
#ifndef REP_EPI
#define REP_EPI 1
#endif
#ifndef REP_PRO
#define REP_PRO 1
#endif
#ifndef REP_BAR
#define REP_BAR 1
#endif
#ifndef RESID_ATOMIC
#define RESID_ATOMIC 1
#endif
#ifndef REP_RESID
#define REP_RESID 1
#endif
#ifndef MXP_STG
#define MXP_STG 1
#endif
#ifndef MXP_S1
#define MXP_S1 1
#endif
#ifndef MXP_S2
#define MXP_S2 1
#endif
#ifndef MX_PF_HG
#define MX_PF_HG 1
#endif
#ifndef MX_PF_RET
#define MX_PF_RET 1
#endif
#ifndef MXP_SLEEP
#define MXP_SLEEP 0
#endif
#ifndef MXP_BAR
#define MXP_BAR 1
#endif
#ifndef MXV_RET
#define MXV_RET 0
#endif
#ifndef MXV_HG
#define MXV_HG 0
#endif
#ifndef REP_BIAS
#define REP_BIAS 1
#endif
#ifndef KPROBE_GU
#define KPROBE_GU 0
#endif
#ifndef STEAL_TICKS_UNIT
#define STEAL_TICKS_UNIT 4000u
#endif
#ifndef STEAL_TICKS_OUT
#define STEAL_TICKS_OUT 900u
#endif
#ifndef STEAL_TICKS_DOWN
#define STEAL_TICKS_DOWN 2800u
#endif
#ifndef STEAL_BATCH
#define STEAL_BATCH 4
#endif
#ifndef RESID_ALIGN
#define RESID_ALIGN false
#endif
#ifndef GEMM_ALIGN
#define GEMM_ALIGN true
#endif
#ifndef PG8_WGM
#define PG8_WGM 4
#endif
#ifndef GEMM_SP2
#define GEMM_SP2 true
#endif
#ifndef PG8_ROUND_MAJOR
#define PG8_ROUND_MAJOR 1
#endif
#ifndef PRO_NT
#define PRO_NT 1
#endif
#ifndef WT_STORES
#define WT_STORES 0
#endif
#ifndef GU_WGM
#define GU_WGM 8
#endif
namespace pg8 {
#define PG8_LAS __attribute__((address_space(3)))
typedef unsigned short bf16_t;
typedef short bf16x8 __attribute__((ext_vector_type(8)));
typedef float f32x4 __attribute__((ext_vector_type(4)));
typedef unsigned u32x4 __attribute__((ext_vector_type(4)));
constexpr int BM = 256, BK = 64, HALF = 128, HTB = HALF * BK * 2  , STAGE_BYTES = 8 * HTB, NXCD = 8, WGM = PG8_WGM;

__host__ __device__ __forceinline__ int lds_byte(int r, int c) { const int st = (r >> 4) * 2 + (c >> 5), rr = r & 15, cc = c & 31, ob = rr * 64 + cc * 2; return st * 1024 + (ob ^ (((ob >> 9) & 1) << 5)); }
__host__ __device__ __forceinline__ void stage_rc(int b, int& R, int& C) { const int st = b / 1024, sb = b % 1024, swz = sb ^ (((sb >> 9) & 1) << 5); R = (st >> 1) * 16 + swz / 64; C = (st & 1) * 32 + (swz % 64) / 2; }
__host__ __device__ __forceinline__ int perm32(int rho) { const int n = rho >> 4, i = rho & 15; return 8 * (i >> 2) + 4 * n + (i & 3); }

struct Unit { int pm, pn, k0; };
struct Gemm { const bf16_t* A; const bf16_t* Bt; int M, N, K, lda, ldb; };

struct StaticOrder {
    static constexpr bool KTWICE = false;
    int nM, nN, nwg, G, c, wgm;
    __host__ __device__ void init(int M, int N, int G_, int c_, int wgm_ = WGM) { nM = M / BM; nN = N / BM; nwg = nM * nN; G = G_; c = c_; wgm = wgm_; }
    __host__ __device__ bool next(int i, Unit& u) const {
        const long L = (long)i * G + c; if (!(PG8_ROUND_MAJOR && G % NXCD == 0) && L >= nwg) return false; if ((long)i * G >= nwg) return false;
        int wgid = (int)L;
        if (PG8_ROUND_MAJOR && G % NXCD == 0) { const int per = G / NXCD; wgid = ((i * NXCD) + (c % NXCD)) * per + (c / NXCD); if (wgid >= nwg) return false; }
        else { const int q = nwg / NXCD, r = nwg % NXCD, xcd = wgid % NXCD, off = wgid / NXCD; wgid = (xcd < r ? xcd * (q + 1) : r * (q + 1) + (xcd - r) * q) + off; }
        const int nig = wgm * nN, gid = wgid / nig, fm = gid * wgm, gsz = (nM - fm) < wgm ? (nM - fm) : wgm;
        u.pm = fm + ((wgid % nig) % gsz); u.pn = (wgid % nig) / gsz; u.k0 = 0; return true;
    }
    __device__ __forceinline__ void a_ready(const Unit&) const {}
    __device__ __forceinline__ void done(const Unit&) const {}
};
struct TwiceOrder : StaticOrder {
    static constexpr bool KTWICE = true;
    __host__ __device__ bool next(int i, Unit& u) const { return StaticOrder::next(i >> 1, u); }
};
struct SplitKOrder {
    static constexpr bool KTWICE = false;
    int G, c, pm0, ksub;
    __device__ __forceinline__ bool next(int i, Unit& u) const { const int s = i * G + c; if (s >= 128) return false; const int t = s >> 2; u.pm = pm0 + (t & 3); u.pn = t >> 2; u.k0 = (s & 3) * ksub; return true; }
    __device__ __forceinline__ void a_ready(const Unit&) const {}
    __device__ __forceinline__ void done(const Unit&) const {}
};
__device__ __forceinline__ unsigned cvt_pk_bf16(float lo, float hi) { unsigned r; asm volatile("v_cvt_pk_bf16_f32 %0, %1, %2" : "=v"(r) : "v"(lo), "v"(hi)); return r; }
__device__ __forceinline__ float fast_sigmoid(float x) { return __builtin_amdgcn_rcpf(1.0f + __expf(-x)); }
__device__ __forceinline__ f32x4 silu4(f32x4 v) { f32x4 o; o[0] = v[0] * fast_sigmoid(v[0]); o[1] = v[1] * fast_sigmoid(v[1]); o[2] = v[2] * fast_sigmoid(v[2]); o[3] = v[3] * fast_sigmoid(v[3]); return o; }
__device__ __forceinline__ f32x4 sigm4(f32x4 v) { f32x4 o; o[0] = fast_sigmoid(v[0]); o[1] = fast_sigmoid(v[1]); o[2] = fast_sigmoid(v[2]); o[3] = fast_sigmoid(v[3]); return o; }
template <typename T> __device__ __forceinline__ void st16(T* base, size_t elem_off, u32x4 v) {
#if WT_STORES
    const __amdgpu_buffer_rsrc_t r = __builtin_amdgcn_make_buffer_rsrc(base, 0, 0x7fffffff, 0x00020000);
    __builtin_amdgcn_raw_buffer_store_b128(v, r, (int)(elem_off * sizeof(T)), 0, 16);
#else
    *(u32x4*)(base + elem_off) = v;
#endif
}
__device__ __forceinline__ u32x4 pack8(f32x4 v0, f32x4 v1) { u32x4 w; w.x = cvt_pk_bf16(v0[0], v0[1]); w.y = cvt_pk_bf16(v0[2], v0[3]); w.z = cvt_pk_bf16(v1[0], v1[1]); w.w = cvt_pk_bf16(v1[2], v1[3]); return w; }

struct EpiRetIn {
    static constexpr bool PERM = true, AFTER_DRAIN = false, REP2 = false;
    bf16_t* act; size_t tstride; const float* cosT; const float* sinT; int n_lat_panels;
    __device__ __forceinline__ void store_rows(const f32x4& a0, const f32x4& a1, const f32x4& b0, const f32x4& b1, int type, bf16_t* base, size_t off) const {
        f32x4 x0 = a0, x1 = a1, y0 = b0, y1 = b1;
        if (type == 1) { x0 = x0 * 0.0625f; x1 = x1 * 0.0625f; y0 = y0 * 0.0625f; y1 = y1 * 0.0625f; }
        if (type == 3) { x0 = silu4(x0); x1 = silu4(x1); y0 = silu4(y0); y1 = silu4(y1); }
        st16(base, off, pack8(x0, x1));
        st16(base, off + HALF, pack8(y0, y1));
    }
    __device__ __forceinline__ void operator()(const f32x4 (&acc)[2][2][4][2], const Unit& u, int wr, int wc, int fr, int fq) const {
        const int type = u.pn >> 3, head = u.pn & 7;
        bf16_t* base = act + (size_t)type * tstride; const size_t coff = head * 256 + wc * 32 + 8 * fq;
        const int row0 = u.pm * BM + wr * 64 + fr;
        const bool rope = (type < 2) && (u.pm < n_lat_panels);
        const int fidx = (wc & 1) * 32 + 8 * fq;
        if (!rope) {
#pragma unroll
            for (int ai = 0; ai < 2; ++ai)
#pragma unroll
                for (int m = 0; m < 4; ++m) store_rows(acc[ai][0][m][0], acc[ai][0][m][1], acc[ai][1][m][0], acc[ai][1][m][1], type, base, (size_t)(row0 + ai * HALF + m * 16) * 2048 + coff);
        } else if (wc < 2) {
#pragma unroll
            for (int ai = 0; ai < 2; ++ai) {
                const int pos = (4 * u.pm + 2 * ai + wr) & 63;
                const f32x4 c0 = *(const f32x4*)(cosT + pos * 64 + fidx), c1 = *(const f32x4*)(cosT + pos * 64 + fidx + 4), s0 = *(const f32x4*)(sinT + pos * 64 + fidx), s1 = *(const f32x4*)(sinT + pos * 64 + fidx + 4);
#pragma unroll
                for (int m = 0; m < 4; ++m) { const f32x4 a0 = acc[ai][0][m][0], a1 = acc[ai][0][m][1], b0 = acc[ai][1][m][0], b1 = acc[ai][1][m][1];
                    store_rows(a0 * c0 - b0 * s0, a1 * c1 - b1 * s1, a0 * s0 + b0 * c0, a1 * s1 + b1 * c1, type, base, (size_t)(row0 + ai * HALF + m * 16) * 2048 + coff); }
            }
        } else {
#pragma unroll
            for (int m = 0; m < 4; ++m) {
                const int pos = 16 * m + fr;
                const f32x4 c0 = *(const f32x4*)(cosT + pos * 64 + fidx), c1 = *(const f32x4*)(cosT + pos * 64 + fidx + 4), s0 = *(const f32x4*)(sinT + pos * 64 + fidx), s1 = *(const f32x4*)(sinT + pos * 64 + fidx + 4);
#pragma unroll
                for (int ai = 0; ai < 2; ++ai) { const f32x4 a0 = acc[ai][0][m][0], a1 = acc[ai][0][m][1], b0 = acc[ai][1][m][0], b1 = acc[ai][1][m][1];
                    store_rows(a0 * c0 - b0 * s0, a1 * c1 - b1 * s1, a0 * s0 + b0 * c0, a1 * s1 + b1 * c1, type, base, (size_t)(row0 + ai * HALF + m * 16) * 2048 + coff); }
            }
        }
    }
};

struct EpiHgIn {
    static constexpr bool PERM = true, AFTER_DRAIN = false, REP2 = false;
    bf16_t* act; size_t tstride; const float* lb;
    __device__ __forceinline__ void operator()(const f32x4 (&acc)[2][2][4][2], const Unit& u, int wr, int wc, int fr, int fq) const {
        const int type = u.pn >> 3, cb = (u.pn & 7) * 256 + wc * 32 + 8 * fq;
        const int row0 = u.pm * BM + wr * 64 + fr;
        const int slot = (type == 0) ? 0 : (type == 1) ? 1 : (type == 2) ? 3 : (type == 3) ? 5 : 6;
        bf16_t* base = act + (size_t)slot * tstride;
        f32x4 lbv[2][2];
#pragma unroll
        for (int bj = 0; bj < 2; ++bj)
#pragma unroll
            for (int n = 0; n < 2; ++n) lbv[bj][n] = (type == 1 || type == 2) ? *(const f32x4*)(lb + cb + bj * HALF + 4 * n) : (f32x4){0.f, 0.f, 0.f, 0.f};
#pragma unroll
        for (int ai = 0; ai < 2; ++ai)
#pragma unroll
            for (int m = 0; m < 4; ++m) {
                const int r = row0 + ai * HALF + m * 16;
                const size_t roff = (size_t)r * 2048 + cb;
#pragma unroll
                for (int bj = 0; bj < 2; ++bj) {
                    f32x4 v0 = acc[ai][bj][m][0], v1 = acc[ai][bj][m][1];
                    if (type == 0) { v0 = silu4(v0); v1 = silu4(v1); }
                    if (type == 4) { v0 = sigm4(v0); v1 = sigm4(v1); }
                    if (type == 1 || type == 2) {
                        f32x4 k0, k1;
#pragma unroll
                        for (int j = 0; j < 4; ++j) {
                            { const float z = fminf(fmaxf(v0[j], -80.f), 80.f), e = __expf(-z), sg = __builtin_amdgcn_rcpf(1.0f + e), l = lbv[bj][0][j];
                              v0[j] = __logf(l + (1.0f - l) * sg); k0[j] = (1.0f - l) * (e * sg); }
                            { const float z = fminf(fmaxf(v1[j], -80.f), 80.f), e = __expf(-z), sg = __builtin_amdgcn_rcpf(1.0f + e), l = lbv[bj][1][j];
                              v1[j] = __logf(l + (1.0f - l) * sg); k1[j] = (1.0f - l) * (e * sg); }
                        }
                        st16(base + tstride, roff + bj * HALF, pack8(k0, k1));
                    }
                    st16(base, roff + bj * HALF, pack8(v0, v1));
                }
            }
    }
};

struct EpiResid {
    static constexpr bool PERM = false, AFTER_DRAIN = false, REP2 = false;
    float* X; const float* Xin; const float* gate; int gstride; int n_lat_panels;
    __device__ __forceinline__ void operator()(const f32x4 (&acc)[2][2][4][2], const Unit& u, int wr, int wc, int fr, int fq) const {
        const int row0 = u.pm * BM + wr * 64 + fr, col0 = u.pn * BM + wc * 32 + 4 * fq;
        const int b = (u.pm < n_lat_panels) ? (u.pm >> 4) : 4;
        const float* g = gate + (size_t)b * gstride + col0;
        float* xb = X + (size_t)row0 * 2048 + col0; const float* xi = Xin + (size_t)row0 * 2048 + col0;
        f32x4 gv[2][2];
#pragma unroll
        for (int bj = 0; bj < 2; ++bj)
#pragma unroll
            for (int n = 0; n < 2; ++n) gv[bj][n] = *(const f32x4*)(g + bj * HALF + n * 16);
        f32x4 xa[2][2][2], xc[2][2][2];
#define ER_LOAD(dst, ai, mp) do { _Pragma("unroll") for (int mm = 0; mm < 2; ++mm) _Pragma("unroll") for (int bj = 0; bj < 2; ++bj) _Pragma("unroll") for (int n = 0; n < 2; ++n) \
            dst[mm][bj][n] = *(const f32x4*)(xi + (size_t)((ai) * HALF + (2 * (mp) + mm) * 16) * 2048 + bj * HALF + n * 16); } while (0)
#define ER_STORE(src, ai, mp) do { _Pragma("unroll") for (int mm = 0; mm < 2; ++mm) _Pragma("unroll") for (int bj = 0; bj < 2; ++bj) _Pragma("unroll") for (int n = 0; n < 2; ++n) \
            *(f32x4*)(xb + (size_t)((ai) * HALF + (2 * (mp) + mm) * 16) * 2048 + bj * HALF + n * 16) = src[mm][bj][n] + gv[bj][n] * acc[ai][bj][2 * (mp) + mm][n]; } while (0)
        ER_LOAD(xa, 0, 0); ER_LOAD(xc, 0, 1);
        ER_STORE(xa, 0, 0); ER_LOAD(xa, 1, 0);
        ER_STORE(xc, 0, 1); ER_LOAD(xc, 1, 1);
        ER_STORE(xa, 1, 0); ER_STORE(xc, 1, 1);
#undef ER_LOAD
#undef ER_STORE
    }
};

struct EpiGateUp {
    static constexpr bool PERM = true, AFTER_DRAIN = false, REP2 = true;
    bf16_t* H; int ldh; float pre;
    __device__ __forceinline__ void operator()(const f32x4 (&acc)[2][2][4][2], const Unit& u, int wr, int wc, int fr, int fq) const {
        const int row0 = u.pm * BM + wr * 64 + fr, col0 = u.pn * HALF + wc * 32 + 8 * fq;
#pragma unroll
        for (int ai = 0; ai < 2; ++ai)
#pragma unroll
            for (int m = 0; m < 4; ++m) {
                const f32x4 h0 = silu4(acc[ai][0][m][0] * pre) * (acc[ai][1][m][0] * pre), h1 = silu4(acc[ai][0][m][1] * pre) * (acc[ai][1][m][1] * pre);
                st16(H, (size_t)(row0 + ai * HALF + m * 16) * ldh + col0, pack8(h0, h1));
            }
    }
};


struct EpiSlab {
    static constexpr bool PERM = false, AFTER_DRAIN = false, REP2 = false;
    float* slab; int pm0, ksub; size_t kstride;
    __device__ __forceinline__ void operator()(const f32x4 (&acc)[2][2][4][2], const Unit& u, int wr, int wc, int fr, int fq) const {
        float* base = slab + (size_t)(u.k0 / ksub) * kstride + (size_t)((u.pm - pm0) * BM + wr * 64 + fr) * 2048 + u.pn * BM + wc * 32 + 4 * fq;
#pragma unroll
        for (int ai = 0; ai < 2; ++ai)
#pragma unroll
            for (int m = 0; m < 4; ++m) { float* rowp = base + (size_t)(ai * HALF + m * 16) * 2048;
#pragma unroll
                for (int bj = 0; bj < 2; ++bj)
#pragma unroll
                    for (int n = 0; n < 2; ++n) *(f32x4*)(rowp + bj * HALF + n * 16) = acc[ai][bj][m][n]; }
    }
};
template <class Epi, class Sched, bool ALIGN_EPI = false, bool SP2 = false>
__device__ __forceinline__ void gemm_phase(PG8_LAS unsigned char* lds, const Gemm g, const Sched& S, const Epi& E) {
    int tid_ = threadIdx.x; asm volatile("" : "+v"(tid_));
    const int tid = tid_, wid = __builtin_amdgcn_readfirstlane(tid >> 6), lane = tid & 63, wr = wid >> 2, wc = wid & 3, fr = lane & 15, fq = lane >> 4;
    const int K = g.K, nt = K / BK;
    unsigned voffA[2], voffB[2];
#pragma unroll
    for (int i = 0; i < 2; ++i) { int R, C; stage_rc(tid * 16 + i * 8192, R, C); const int Rb = Epi::PERM ? ((R & ~31) + perm32(R & 31)) : R;
        voffA[i] = (unsigned)(R * g.lda + C) * 2u; voffB[i] = (unsigned)(Rb * g.ldb + C) * 2u; }
    const size_t kstep = (size_t)(BK * 2);
    const size_t hsA = (size_t)HALF * g.lda * 2, hsB = (size_t)HALF * g.ldb * 2;
    const size_t tsA = 2 * hsA, tsB = 2 * hsB;
    const unsigned ldsw = (unsigned)wid * 1024u;
    const int aoff = lds_byte(wr * 64 + fr, fq * 8), boff = lds_byte(wc * 32 + fr, fq * 8);
#define PG8_SA(b, h) (((b) * 2 + (h)) * HTB)
#define PG8_SB(b, h) ((4 + (b) * 2 + (h)) * HTB)
#define PG8_STAGE(bufoff, gbase, voff) do { _Pragma("unroll") for (int _i = 0; _i < 2; ++_i) \
        __builtin_amdgcn_global_load_lds((const unsigned*)((const char*)(gbase) + (voff)[_i]), (PG8_LAS unsigned*)(lds + (bufoff) + ldsw + _i * 8192), 16, 0, 0); } while (0)
#define PG8_LDA(dst, b, h) do { _Pragma("unroll") for (int m = 0; m < 4; ++m) _Pragma("unroll") for (int k = 0; k < 2; ++k) dst[m][k] = *(const PG8_LAS bf16x8*)(lds + PG8_SA(b, h) + aoff + m * 2048 + k * 1024); } while (0)
#define PG8_LDB(dst, b, h) do { _Pragma("unroll") for (int n = 0; n < 2; ++n) _Pragma("unroll") for (int k = 0; k < 2; ++k) dst[n][k] = *(const PG8_LAS bf16x8*)(lds + PG8_SB(b, h) + boff + n * 2048 + k * 1024); } while (0)
#define PG8_MMA(ai, bj, At, Bt) do { __builtin_amdgcn_s_setprio(1); _Pragma("unroll") for (int m = 0; m < 4; ++m) _Pragma("unroll") for (int n = 0; n < 2; ++n) _Pragma("unroll") for (int k = 0; k < 2; ++k) \
        acc[ai][bj][m][n] = __builtin_amdgcn_mfma_f32_16x16x32_bf16(Bt[n][k], At[m][k], acc[ai][bj][m][n], 0, 0, 0); __builtin_amdgcn_s_setprio(0); } while (0)
#define PG8_WAIT_V(n) asm volatile("s_waitcnt vmcnt(" #n ")" ::: "memory")
#define PG8_WAIT_L(n) asm volatile("s_waitcnt lgkmcnt(" #n ")" ::: "memory")
#define PG8_BAR __builtin_amdgcn_s_barrier()
#define PG8_SCHED __builtin_amdgcn_sched_barrier(0)
    Unit cur, nxt; int ui = 0;
    if (!S.next(0, cur)) return;
    f32x4 acc[2][2][4][2];
#pragma unroll
    for (int a = 0; a < 2; ++a)
#pragma unroll
        for (int b = 0; b < 2; ++b)
#pragma unroll
            for (int m = 0; m < 4; ++m)
#pragma unroll
                for (int n = 0; n < 2; ++n) acc[a][b][m][n] = (f32x4){0.f, 0.f, 0.f, 0.f};
    bf16x8 At[4][2], B0[2][2], B1[2][2];
    const char* cA = (const char*)g.A + (size_t)cur.pm * tsA + (size_t)cur.k0 * 2; const char* cB = (const char*)g.Bt + (size_t)cur.pn * tsB + (size_t)cur.k0 * 2;
    S.a_ready(cur);
    if constexpr (SP2) {
        PG8_STAGE(PG8_SB(0, 0), cB, voffB); PG8_STAGE(PG8_SB(0, 1), cB + hsB, voffB); PG8_STAGE(PG8_SA(0, 0), cA, voffA); PG8_STAGE(PG8_SA(0, 1), cA + hsA, voffA);
        if (wr == 1) PG8_BAR;
        PG8_WAIT_V(2); PG8_BAR;
        PG8_STAGE(PG8_SB(1, 0), cB + kstep, voffB); PG8_STAGE(PG8_SA(1, 0), cA + kstep, voffA); PG8_STAGE(PG8_SB(1, 1), cB + hsB + kstep, voffB);
        PG8_WAIT_V(6); PG8_BAR;
    } else {
        PG8_STAGE(PG8_SB(0, 0), cB, voffB); PG8_STAGE(PG8_SA(0, 0), cA, voffA); PG8_STAGE(PG8_SB(0, 1), cB + hsB, voffB); PG8_STAGE(PG8_SA(0, 1), cA + hsA, voffA);
        if (wr == 1) PG8_BAR;
        PG8_WAIT_V(4); PG8_BAR;
        PG8_STAGE(PG8_SB(1, 0), cB + kstep, voffB); PG8_STAGE(PG8_SA(1, 0), cA + kstep, voffA); PG8_STAGE(PG8_SB(1, 1), cB + hsB + kstep, voffB);
        PG8_WAIT_V(6); PG8_BAR;
    }
    for (;;) {
        const bool has_next = S.next(ui + 1, nxt);
        const char* nA = has_next ? (const char*)g.A + (size_t)nxt.pm * tsA + (size_t)nxt.k0 * 2 : cA; const char* nB = has_next ? (const char*)g.Bt + (size_t)nxt.pn * tsB + (size_t)nxt.k0 * 2 : cB;
        for (int t = 0; t < nt; t += 2) {
            const bool last = (t == nt - 2);
            const char* a1 = cA + (size_t)(t + 1) * kstep;
            const char* a2 = last ? nA : cA + (size_t)(t + 2) * kstep; const char* b2 = last ? nB : cB + (size_t)(t + 2) * kstep;
            const char* a3 = a2 + kstep; const char* b3 = b2 + kstep;
            if (last && has_next) S.a_ready(nxt);
            if constexpr (SP2) {
            PG8_LDB(B0, 0, 0); PG8_LDB(B1, 0, 1); PG8_SCHED; PG8_LDA(At, 0, 0); PG8_STAGE(PG8_SA(1, 1), a1 + hsA, voffA);
            PG8_WAIT_V(8); PG8_WAIT_L(0); PG8_BAR; PG8_MMA(0, 0, At, B0); PG8_MMA(0, 1, At, B1); PG8_BAR; PG8_SCHED;
            PG8_LDA(At, 0, 1); PG8_STAGE(PG8_SB(0, 0), b2, voffB); PG8_STAGE(PG8_SB(0, 1), b2 + hsB, voffB); PG8_STAGE(PG8_SA(0, 0), a2, voffA);
            PG8_WAIT_V(8); PG8_WAIT_L(0); PG8_BAR; PG8_MMA(1, 0, At, B0); PG8_MMA(1, 1, At, B1); PG8_BAR; PG8_SCHED;
            PG8_LDB(B0, 1, 0); PG8_LDB(B1, 1, 1); PG8_SCHED; PG8_LDA(At, 1, 0); PG8_STAGE(PG8_SA(0, 1), a2 + hsA, voffA);
            PG8_WAIT_V(8); PG8_WAIT_L(0); PG8_BAR; PG8_MMA(0, 0, At, B0); PG8_MMA(0, 1, At, B1); PG8_BAR; PG8_SCHED;
            PG8_LDA(At, 1, 1); PG8_STAGE(PG8_SB(1, 0), b3, voffB); PG8_STAGE(PG8_SB(1, 1), b3 + hsB, voffB); PG8_STAGE(PG8_SA(1, 0), a3, voffA);
            PG8_WAIT_V(8); PG8_WAIT_L(0); PG8_BAR; PG8_MMA(1, 0, At, B0); PG8_MMA(1, 1, At, B1); PG8_BAR; PG8_SCHED;
            } else {
            PG8_LDB(B0, 0, 0); PG8_SCHED; PG8_LDA(At, 0, 0); PG8_STAGE(PG8_SA(1, 1), a1 + hsA, voffA);
            PG8_WAIT_L(8); PG8_BAR; PG8_WAIT_L(0); PG8_MMA(0, 0, At, B0); PG8_BAR; PG8_SCHED;
            PG8_LDB(B1, 0, 1); PG8_STAGE(PG8_SB(0, 0), b2, voffB);
            PG8_BAR; PG8_WAIT_L(0); PG8_MMA(0, 1, At, B1); PG8_BAR;
            PG8_LDA(At, 0, 1); PG8_STAGE(PG8_SA(0, 0), a2, voffA);
            PG8_BAR; PG8_WAIT_L(0); PG8_MMA(1, 0, At, B0); PG8_BAR; PG8_SCHED;
            PG8_STAGE(PG8_SB(0, 1), b2 + hsB, voffB);
            PG8_WAIT_V(6); PG8_BAR; PG8_MMA(1, 1, At, B1); PG8_BAR;
            PG8_LDB(B0, 1, 0); PG8_SCHED; PG8_LDA(At, 1, 0); PG8_STAGE(PG8_SA(0, 1), a2 + hsA, voffA);
            PG8_WAIT_L(8); PG8_BAR; PG8_WAIT_L(0); PG8_MMA(0, 0, At, B0); PG8_BAR; PG8_SCHED;
            PG8_LDB(B1, 1, 1); PG8_STAGE(PG8_SB(1, 0), b3, voffB);
            PG8_BAR; PG8_WAIT_L(0); PG8_MMA(0, 1, At, B1); PG8_BAR;
            PG8_LDA(At, 1, 1); PG8_STAGE(PG8_SA(1, 0), a3, voffA);
            PG8_BAR; PG8_WAIT_L(0); PG8_MMA(1, 0, At, B0); PG8_BAR; PG8_SCHED;
            PG8_STAGE(PG8_SB(1, 1), b3 + hsB, voffB);
            PG8_WAIT_V(6); PG8_BAR; PG8_MMA(1, 1, At, B1); PG8_BAR;
            }
        }
        const bool kp_first = Sched::KTWICE && ((ui & 1) == 0);
        if constexpr (ALIGN_EPI) { if (wr == 0) PG8_BAR; }
        if (!kp_first) if constexpr (!Epi::AFTER_DRAIN) { E(acc, cur, wr, wc, fr, fq); if constexpr (REP_EPI > 1 && Epi::REP2) { asm volatile("" ::: "memory"); E(acc, cur, wr, wc, fr, fq); } S.done(cur); }
        if (!has_next) break;
        if (!kp_first)
#pragma unroll
        for (int a = 0; a < 2; ++a)
#pragma unroll
            for (int b = 0; b < 2; ++b)
#pragma unroll
                for (int m = 0; m < 4; ++m)
#pragma unroll
                    for (int n = 0; n < 2; ++n) acc[a][b][m][n] = (f32x4){0.f, 0.f, 0.f, 0.f};
        cur = nxt; cA = nA; cB = nB; ++ui;
        if constexpr (ALIGN_EPI) { if (wr == 1) PG8_BAR; }
    }
    PG8_WAIT_V(0);
    if constexpr (!ALIGN_EPI) { if (wr == 0) PG8_BAR; }
    PG8_BAR;
    if constexpr (Epi::AFTER_DRAIN) { E.fused(acc, cur, wr, wc, fr, fq, lds, wid, lane); S.done(cur); }
#undef PG8_SA
#undef PG8_SB
#undef PG8_STAGE
#undef PG8_LDA
#undef PG8_LDB
#undef PG8_MMA
#undef PG8_WAIT_V
#undef PG8_WAIT_L
#undef PG8_BAR
#undef PG8_SCHED
}
}

#ifndef MK_N_LAUNCHES
#define MK_N_LAUNCHES 1
#endif
constexpr int NWAVES = 8;
constexpr int D = 2048, BATCH = 4, SEQ = 4096, CTXL = 256, DEPTH = 4, FF = 5632;
constexpr int ML = BATCH * SEQ, MC = BATCH * CTXL, M = ML + MC;
constexpr int NLP = ML / 256;
constexpr int MOD_LD = 6 * D;
constexpr float EPS = 1e-6f;
constexpr int N_PHASES = 2 + 8 * DEPTH;

constexpr size_t MiB = 1u << 20;
constexpr size_t WS_CTL = 0, WS_MOD = 1 * MiB, ZERO_BYTES = 2 * MiB;
constexpr size_t WS_TAB = 2 * MiB;
constexpr size_t TAB_COS = 0, TAB_SIN = 16384, TAB_LB = 32768;
constexpr size_t WS_X = 4 * MiB;
constexpr size_t WS_HN = 140 * MiB;
constexpr size_t WS_ACT = 208 * MiB;
constexpr size_t ACT_STRIDE = (size_t)M * D;
constexpr size_t WS_OF = 684 * MiB, WS_OB = 820 * MiB;
constexpr size_t WS_W = 956 * MiB, W_LAYER = 114 * MiB;
constexpr size_t W_IN = 0, W_OUT = 40 * MiB, W_GU = 48 * MiB, W_DN = 92 * MiB;
constexpr size_t WS_SLAB = WS_W + 4 * W_LAYER;
constexpr size_t WS_END = WS_SLAB + 32 * MiB;
constexpr int CW_BAR = 4096;

constexpr int RING_BYTES = 131072;
constexpr int LDSCTL_OFF = RING_BYTES, MISC_OFF = LDSCTL_OFF + 320;
constexpr int LDS_BYTES = 147456;

#define GAS __attribute__((address_space(1)))
#define LAS __attribute__((address_space(3)))
typedef unsigned short bf16;
typedef unsigned v4u __attribute__((ext_vector_type(4)));
typedef unsigned v2u __attribute__((ext_vector_type(2)));
typedef float f32x4 __attribute__((ext_vector_type(4)));
typedef GAS unsigned gu32;
#define LDS_WAIT() asm volatile("s_waitcnt lgkmcnt(0)" ::: "memory")
__device__ __forceinline__ unsigned f2bf(float f) { unsigned u = __builtin_bit_cast(unsigned, f); return (u + 0x7fffu + ((u >> 16) & 1u)) >> 16; }
typedef float f32x2_t __attribute__((ext_vector_type(2)));
typedef __bf16 bf16x2_t __attribute__((ext_vector_type(2)));
__device__ __forceinline__ unsigned pk2(float lo, float hi) { const f32x2_t v = {lo, hi}; const bf16x2_t b = __builtin_convertvector(v, bf16x2_t); return __builtin_bit_cast(unsigned, b); }
__device__ __forceinline__ float bflo(unsigned w) { return __builtin_bit_cast(float, w << 16); }
__device__ __forceinline__ float bfhi(unsigned w) { return __builtin_bit_cast(float, w & 0xffff0000u); }
template <int CTRL> __device__ __forceinline__ float dpp_mov(float v) { return __builtin_bit_cast(float, __builtin_amdgcn_update_dpp(0, __builtin_bit_cast(int, v), CTRL, 0xF, 0xF, true)); }
__device__ __forceinline__ float wave_sum(float v) {
    v += dpp_mov<0xB1>(v);
    v += dpp_mov<0x4E>(v);
    v += dpp_mov<0x141>(v);
    v += dpp_mov<0x140>(v);
    const int iv = __builtin_bit_cast(int, v);
    const float a = __builtin_bit_cast(float, __builtin_amdgcn_readlane(iv, 0)), b = __builtin_bit_cast(float, __builtin_amdgcn_readlane(iv, 16));
    const float c = __builtin_bit_cast(float, __builtin_amdgcn_readlane(iv, 32)), d = __builtin_bit_cast(float, __builtin_amdgcn_readlane(iv, 48));
    return (a + b) + (c + d);
}
#define XB_TMO      128
#define XB_XCNT(j)  (256  + 64 * (j))
#define XB_XSUB(j)  (1280 + 64 * (j))
#define XB_XGEN(j)  (2304 + 64 * (j))
#define XB_TOP      3328
#define XB_TOPGEN   3392
#define XCD_BAR_WORDS 3456
#define XB_SPIN_CAP (1u << 18)

__device__ __forceinline__ unsigned xb_ld(unsigned* p)              { return __hip_atomic_load(p, __ATOMIC_RELAXED, __HIP_MEMORY_SCOPE_AGENT); }
__device__ __forceinline__ unsigned xb_add(unsigned* p, unsigned v) { return __hip_atomic_fetch_add(p, v, __ATOMIC_RELAXED, __HIP_MEMORY_SCOPE_AGENT); }
__device__ __forceinline__ unsigned xb_xcc_id() { return (unsigned)__builtin_amdgcn_s_getreg((3 << 11) | 20) & 0xFu; }
#define XB_SPIN(cond, bar) do { unsigned _sp = 0; while (cond) { __builtin_amdgcn_s_sleep(1); \
    if ((++_sp & 255u) == 0u) { if (xb_ld(&(bar)[XB_TMO])) break; if (_sp > XB_SPIN_CAP) { atomicAdd(&(bar)[XB_TMO], 1u); break; } } } } while (0)

struct XcdBarrier {
    unsigned* bar; unsigned x;
    volatile LAS unsigned* st;
};

__device__ __forceinline__ XcdBarrier xcd_barrier_post(unsigned* bar, volatile LAS unsigned* st) {
    XcdBarrier b; b.bar = bar; b.x = xb_xcc_id(); b.st = st;
    if (threadIdx.x == 0) (void)xb_add(&bar[XB_XCNT(b.x)], 1u);
    return b;
}
__device__ __forceinline__ void xcd_barrier_complete(unsigned* bar, unsigned x, unsigned& nloc, unsigned& nx) {
    const unsigned G = gridDim.x * gridDim.y * gridDim.z;
    unsigned sum, cnt, mine, sp = 0u;
    for (;;) {
        sum = 0u; cnt = 0u; mine = 0u;
#pragma unroll
        for (unsigned j = 0; j < 16; ++j) { const unsigned c = xb_ld(&bar[XB_XCNT(j)]); sum += c; cnt += (c > 0u) ? 1u : 0u; mine = (j == x) ? c : mine; }
        if (sum == G) break;
        __builtin_amdgcn_s_sleep(1);
        if ((++sp & 255u) == 0u) { if (xb_ld(&bar[XB_TMO])) break; if (sp > XB_SPIN_CAP) { atomicAdd(&bar[XB_TMO], 1u); break; } }
    }
    nloc = mine > 0u ? mine : 1u; nx = cnt > 0u ? cnt : 1u;
}

__device__ __forceinline__ void xcd_barrier(const XcdBarrier& b) {
    asm volatile("s_waitcnt vmcnt(0)" ::: "memory");
    __syncthreads();
    if (threadIdx.x == 0) {
        unsigned* bar = b.bar;
        __builtin_amdgcn_s_waitcnt(0);
        unsigned nloc = b.st[0], nx = b.st[1];
        if (nloc == 0u) { xcd_barrier_complete(bar, b.x, nloc, nx); b.st[0] = nloc; b.st[1] = nx; }
        const unsigned old = xb_add(&bar[XB_XSUB(b.x)], 1u);
        const unsigned gen = old / nloc;
        if (old + 1u == (gen + 1u) * nloc) {
            __builtin_amdgcn_fence(__ATOMIC_RELEASE, "agent");
            asm volatile("s_waitcnt vmcnt(0)" ::: "memory");
            const unsigned og = xb_add(&bar[XB_TOP], 1u);
            const unsigned tg = og / nx;
            if (og + 1u == (tg + 1u) * nx) xb_add(&bar[XB_TOPGEN], 1u);
            else XB_SPIN(xb_ld(&bar[XB_TOPGEN]) == tg, bar);
            __builtin_amdgcn_fence(__ATOMIC_ACQUIRE, "agent");
            xb_add(&bar[XB_XGEN(b.x)], 1u);
            asm volatile("s_waitcnt vmcnt(0)" ::: "memory");
        } else {
            XB_SPIN(xb_ld(&bar[XB_XGEN(b.x)]) == gen, bar);
            __builtin_amdgcn_fence(__ATOMIC_ACQUIRE, "agent");
            asm volatile("s_waitcnt vmcnt(0)" ::: "memory");
        }
    }
    __syncthreads();
}

struct Args { const float* in[18]; float* out; unsigned char* ws; int ph_lo, ph_hi; };
struct Frame {
    LAS unsigned char* lds;
    gu32* ctl;
    int tid, lane, wave, vcu, G;
};
__device__ __forceinline__ void relaunder(Frame& F) { int t = threadIdx.x; asm volatile("" : "+v"(t)); F.tid = t; F.lane = t & 63; F.wave = __builtin_amdgcn_readfirstlane(t >> 6); }

__device__ __forceinline__ void p0_transpose_item(const float* W, int K, int N, bf16* WT, int dst_row0, LAS float* scr, int k0, int n0, int lane) {
#pragma unroll 8
    for (int i = 0; i < 32; ++i) { const int kk = 2 * i + (lane >> 5); scr[kk * 33 + (lane & 31)] = PRO_NT ? __builtin_nontemporal_load(W + (size_t)(k0 + kk) * N + n0 + (lane & 31)) : W[(size_t)(k0 + kk) * N + n0 + (lane & 31)]; }
    LDS_WAIT(); asm volatile("" ::: "memory");
    const int c = lane & 7;
#pragma unroll
    for (int j = 0; j < 4; ++j) { const int n = (lane >> 3) + 8 * j; const LAS float* s = scr + (8 * c) * 33 + n;
        v4u o; o.x = pk2(s[0 * 33], s[1 * 33]); o.y = pk2(s[2 * 33], s[3 * 33]); o.z = pk2(s[4 * 33], s[5 * 33]); o.w = pk2(s[6 * 33], s[7 * 33]);
        *(GAS v4u*)(WT + (size_t)(dst_row0 + n) * K + k0 + 8 * c) = o; }
    LDS_WAIT(); asm volatile("" ::: "memory");
}
__device__ __forceinline__ bool p0_matrix(int& it, const float* W, int K, int N, bf16* WT, bool gu, LAS float* scr, int lane) {
    const int nblk = N / 32, items = (K / 64) * nblk;
    if (it >= items) { it -= items; return false; }
    const int kb = it / nblk, nb = it % nblk, n0 = 32 * nb;
    int dst = n0;
    if (gu) { const int half = n0 / FF, w = n0 % FF; dst = (w / 128) * 256 + half * 128 + (w % 128); }
    p0_transpose_item(W, K, N, WT, dst, scr, 64 * kb, n0, lane);
    return true;
}
__device__ __forceinline__ void sincos_pos(float x, float& s, float& c) {
    const float n = rintf(x * 0.63661977236758f);
    float r = fmaf(n, -1.5707962512969971f, x); r = fmaf(n, -7.5497894158615964e-08f, r);
    const float r2 = r * r;
    const float sp = r + r * r2 * (-1.6666667e-1f + r2 * (8.3333333e-3f + r2 * (-1.9841270e-4f + r2 * 2.7557319e-6f)));
    const float cp = 1.0f + r2 * (-0.5f + r2 * (4.1666667e-2f + r2 * (-1.3888889e-3f + r2 * (2.4801587e-5f + r2 * -2.7557319e-7f))));
    const int q = ((int)n) & 3;
    s = (q == 0) ? sp : (q == 1) ? cp : (q == 2) ? -sp : -cp;
    c = (q == 0) ? cp : (q == 1) ? -sp : (q == 2) ? -cp : sp;
}
__device__ __forceinline__ void p0_prologue(const Args& a, Frame& F) {
    relaunder(F);
    LAS float* scr = (LAS float*)(F.lds + F.wave * 9216);
    LAS float* act = (LAS float*)(F.lds + 73728);
    for (int i = F.tid; i < 5 * D; i += NWAVES * 64) { const float v = (i < 4 * D) ? a.in[1][i] : a.in[3][i - 4 * D]; act[i] = v / (1.f + __expf(-v)); }
    __syncthreads();
    const int gw = F.vcu * NWAVES + F.wave, NGW = F.G * NWAVES;
    for (int t = gw; t < DEPTH * 48 * 32; t += NGW) {
        const int layer = t / (48 * 32), rem = t % (48 * 32), cb = rem >> 5, ks = rem & 31;
        const int col = cb * 256 + F.lane * 4;
        const float* wp = a.in[4] + ((size_t)layer * D + ks * 64) * MOD_LD + col;
        f32x4 acc0 = {0.f, 0.f, 0.f, 0.f}, acc1 = acc0, acc2 = acc0, acc3 = acc0, acc4 = acc0;
        for (int kk = 0; kk < 64; kk += 8) {
            f32x4 w[8];
#pragma unroll
            for (int u = 0; u < 8; ++u) w[u] = PRO_NT ? __builtin_nontemporal_load((const GAS f32x4*)(wp + (size_t)(kk + u) * MOD_LD)) : *(const GAS f32x4*)(wp + (size_t)(kk + u) * MOD_LD);
#pragma unroll
            for (int u = 0; u < 8; ++u) { const int k = ks * 64 + kk + u;
                acc0 += act[k] * w[u]; acc1 += act[D + k] * w[u]; acc2 += act[2 * D + k] * w[u]; acc3 += act[3 * D + k] * w[u]; acc4 += act[4 * D + k] * w[u]; }
        }
        if (ks == 0) { const f32x4 bv = *(const GAS f32x4*)(a.in[5] + (size_t)layer * MOD_LD + col); acc0 += bv; acc1 += bv; acc2 += bv; acc3 += bv; acc4 += bv; }
        float* mp = (float*)(a.ws + WS_MOD) + (size_t)layer * 5 * MOD_LD + col;
#pragma unroll
        for (int j = 0; j < 4; ++j) {
            __hip_atomic_fetch_add(mp + j, acc0[j], __ATOMIC_RELAXED, __HIP_MEMORY_SCOPE_AGENT);
            __hip_atomic_fetch_add(mp + MOD_LD + j, acc1[j], __ATOMIC_RELAXED, __HIP_MEMORY_SCOPE_AGENT);
            __hip_atomic_fetch_add(mp + 2 * MOD_LD + j, acc2[j], __ATOMIC_RELAXED, __HIP_MEMORY_SCOPE_AGENT);
            __hip_atomic_fetch_add(mp + 3 * MOD_LD + j, acc3[j], __ATOMIC_RELAXED, __HIP_MEMORY_SCOPE_AGENT);
            __hip_atomic_fetch_add(mp + 4 * MOD_LD + j, acc4[j], __ATOMIC_RELAXED, __HIP_MEMORY_SCOPE_AGENT);
        }
    }
    {
        const int gt = (F.vcu * NWAVES + F.wave) * 64 + F.lane;
        float* tab = (float*)(a.ws + WS_TAB);
        if (gt < 4096) { const int pos = gt >> 6, f = gt & 63; const float inv = expf(-(float)f * (9.210340371976184f / 64.0f)); float s, c; sincos_pos((float)pos * inv, s, c);
            tab[TAB_COS / 4 + gt] = c; tab[TAB_SIN / 4 + gt] = s; }
        else if (gt < 4096 + D) { const int ch = gt - 4096; const float b0 = a.in[14][ch], b1 = a.in[14][D + ch], mx = fmaxf(b0, b1), e0 = __expf(b0 - mx), e1 = __expf(b1 - mx), p0 = e0 / (e0 + e1), p1 = e1 / (e0 + e1);
            tab[TAB_LB / 4 + ch] = p0 - p0; tab[TAB_LB / 4 + D + ch] = (p0 + p1) - p0; }
    }
    for (int rep_ = 0; rep_ < REP_PRO; ++rep_) {
    constexpr int I_RET = 32 * 256 + 32 * 64 + 32 * 352 + 88 * 64, I_HG = 32 * 320 + 32 * 64 + 32 * 352 + 88 * 64;
    for (int it0 = gw; it0 < 2 * (I_RET + I_HG); it0 += NGW) {
        int it = it0; const int lp = it / (I_RET + I_HG); it -= lp * (I_RET + I_HG);
        int layer = 2 * lp; if (it >= I_RET) { it -= I_RET; layer += 1; }
        unsigned char* wb = a.ws + WS_W + (size_t)layer * W_LAYER;
        const int j = layer >> 1;
        if (layer & 1) { if (p0_matrix(it, a.in[11] + (size_t)j * D * 5 * D, D, 5 * D, (bf16*)(wb + W_IN), false, scr, F.lane)) continue;
                         if (p0_matrix(it, a.in[12] + (size_t)j * D * D, D, D, (bf16*)(wb + W_OUT), false, scr, F.lane)) continue; }
        else           { if (p0_matrix(it, a.in[8] + (size_t)j * D * 4 * D, D, 4 * D, (bf16*)(wb + W_IN), false, scr, F.lane)) continue;
                         if (p0_matrix(it, a.in[9] + (size_t)j * D * D, D, D, (bf16*)(wb + W_OUT), false, scr, F.lane)) continue; }
        if (p0_matrix(it, a.in[15] + (size_t)layer * D * 2 * FF, D, 2 * FF, (bf16*)(wb + W_GU), true, scr, F.lane)) continue;
        p0_matrix(it, a.in[16] + (size_t)layer * FF * D, FF, D, (bf16*)(wb + W_DN), false, scr, F.lane);
    }
    }
}

__device__ __forceinline__ void norm_mod_phase(const Args& a, Frame& F, const float* gain, const float* modl, int sh_off, int sc_off, int nrows, const float* slab_gate, const float* xl, const float* xc) {
    relaunder(F);
    const int gw = F.vcu * NWAVES + F.wave, NGW = F.G * NWAVES;
    float* X = (float*)(a.ws + WS_X); bf16* HN = (bf16*)(a.ws + WS_HN);
    for (int r = gw; r < nrows; r += NGW) {
        const int b = (r < ML) ? (r >> 12) : 4;
        const GAS f32x4* xr = (const GAS f32x4*)((r < ML) ? xl + (size_t)r * D : xc + (size_t)(r - ML) * D) + F.lane;
        f32x4 v[8]; float ss = 0.f;
#pragma unroll
        for (int j = 0; j < 8; ++j) v[j] = xr[64 * j];
        if (slab_gate != nullptr && r >= ML) {
            const GAS f32x4* sl = (const GAS f32x4*)((const float*)(a.ws + WS_SLAB) + (size_t)(r - ML) * D) + F.lane;
#pragma unroll
            for (int j = 0; j < 8; ++j) { const f32x4 p = (sl[64 * j] + sl[64 * j + (size_t)MC * D / 4]) + (sl[64 * j + 2 * ((size_t)MC * D / 4)] + sl[64 * j + 3 * ((size_t)MC * D / 4)]);
                v[j] += *(const GAS f32x4*)(slab_gate + 256 * j + 4 * F.lane) * p; ((GAS f32x4*)(X + (size_t)r * D) + F.lane)[64 * j] = v[j]; }
        }
#pragma unroll
        for (int j = 0; j < 8; ++j) ss += (v[j][0] * v[j][0] + v[j][1] * v[j][1]) + (v[j][2] * v[j][2] + v[j][3] * v[j][3]);
        const float rstd = 1.0f / sqrtf(wave_sum(ss) * (1.0f / D) + EPS);
        const float* mb = modl + (size_t)b * MOD_LD;
        GAS v2u* o8 = (GAS v2u*)(HN + (size_t)r * D) + F.lane;
#pragma unroll
        for (int j = 0; j < 8; ++j) { const int c = 256 * j + 4 * F.lane;
            const f32x4 g = *(const GAS f32x4*)(gain + c), sh = *(const GAS f32x4*)(mb + sh_off + c), sc = *(const GAS f32x4*)(mb + sc_off + c);
            const f32x4 y = (v[j] * rstd) * g * (sc + 1.0f) + sh;
            v2u w; w.x = pk2(y[0], y[1]); w.y = pk2(y[2], y[3]); o8[64 * j] = w; }
    }
}
template <bool HG>
__device__ __forceinline__ void readout_phase(const Args& a, Frame& F, const float* gain, int nrows) {
    relaunder(F);
    const int gw = F.vcu * NWAVES + F.wave, NGW = F.G * NWAVES;
    const bf16* OF = (const bf16*)(a.ws + WS_OF); const bf16* OB = (const bf16*)(a.ws + WS_OB);
    const bf16* G = (const bf16*)(a.ws + WS_ACT) + (size_t)(HG ? 6 : 3) * ACT_STRIDE; bf16* HN = (bf16*)(a.ws + WS_HN);
    for (int r = gw; r < nrows; r += NGW) {
        const GAS v2u* f = (const GAS v2u*)(OF + (size_t)r * D) + F.lane; const GAS v2u* bk = (const GAS v2u*)(OB + (size_t)r * D) + F.lane;
        const GAS v2u* g8 = (const GAS v2u*)(G + (size_t)r * D) + F.lane;
        f32x4 v[8]; float ssj[8]; float tot = 0.f;
#pragma unroll
        for (int j = 0; j < 8; ++j) { const v2u fa = f[64 * j], fb = bk[64 * j]; v[j] = (f32x4){bflo(fa.x) + bflo(fb.x), bfhi(fa.x) + bfhi(fb.x), bflo(fa.y) + bflo(fb.y), bfhi(fa.y) + bfhi(fb.y)}; ssj[j] = (v[j][0] * v[j][0] + v[j][1] * v[j][1]) + (v[j][2] * v[j][2] + v[j][3] * v[j][3]); tot += ssj[j]; }
        float rs_all = 0.f;
        if (HG) rs_all = 1.0f / sqrtf(wave_sum(tot) * (1.0f / D) + EPS);
        GAS v2u* o8 = (GAS v2u*)(HN + (size_t)r * D) + F.lane;
#pragma unroll
        for (int j = 0; j < 8; ++j) {
            float rs = rs_all; f32x4 gn = {1.f, 1.f, 1.f, 1.f};
            if (!HG) rs = 1.0f / sqrtf(wave_sum(ssj[j]) * (1.0f / 256.0f) + EPS);
            else gn = *(const GAS f32x4*)(gain + 256 * j + 4 * F.lane);
            const v2u gw2 = g8[64 * j];
            const f32x4 gt = {bflo(gw2.x), bfhi(gw2.x), bflo(gw2.y), bfhi(gw2.y)};
            const f32x4 y = (v[j] * rs) * gn * gt;
            v2u w; w.x = pk2(y[0], y[1]); w.y = pk2(y[2], y[3]); o8[64 * j] = w; }
    }
}
__device__ __forceinline__ void final_norm_phase(const Args& a, Frame& F) {
    relaunder(F);
    const int gw = F.vcu * NWAVES + F.wave, NGW = F.G * NWAVES;
    const float* X = (const float*)(a.ws + WS_X); const float* gain = a.in[17];
    for (int r = gw; r < ML; r += NGW) {
        const GAS f32x4* xr = (const GAS f32x4*)(X + (size_t)r * D) + F.lane;
        f32x4 v[8]; float ss = 0.f;
#pragma unroll
        for (int j = 0; j < 8; ++j) { v[j] = xr[64 * j]; ss += (v[j][0] * v[j][0] + v[j][1] * v[j][1]) + (v[j][2] * v[j][2] + v[j][3] * v[j][3]); }
        const float rstd = 1.0f / sqrtf(wave_sum(ss) * (1.0f / D) + EPS);
        GAS f32x4* o = (GAS f32x4*)(a.out + (size_t)r * D) + F.lane;
#pragma unroll
        for (int j = 0; j < 8; ++j) o[64 * j] = (v[j] * rstd) * *(const GAS f32x4*)(gain + 256 * j + 4 * F.lane);
    }
}

template <bool HG>
__device__ __forceinline__ void mixer_phase(const Args& a, Frame& F, int j_layer, bool ctx_out) {
    relaunder(F);
    constexpr int DPL = HG ? 2 : 4, HD = HG ? 128 : 256, NH = HG ? 16 : 8, NEB = HD / 64, CH = 32;
    constexpr int QB = CH * HD * 2;
    constexpr int NQ = HG ? 3 : 2;
    constexpr int VB_OFF = NQ * QB, BUF = VB_OFF + CH * 128;
    static_assert(2 * BUF <= RING_BYTES, "mixer LDS");
    const bf16* act = (const bf16*)(a.ws + WS_ACT);
    const int lane = F.lane, w = F.wave, tid = F.tid;
    for (int task = F.vcu; task < BATCH * NH * 2 * NEB; task += F.G) {
        const int eb = task % NEB, dir = (task / NEB) & 1, h = (task / (2 * NEB)) % NH, b = task / (2 * NEB * NH);
        bf16* O = (bf16*)(a.ws + (dir ? WS_OB : WS_OF));
        const bf16* src0 = act;
        const bf16* src1 = act + (size_t)(HG ? (1 + 2 * dir) : 1) * ACT_STRIDE;
        const bf16* src2 = act + (size_t)(2 + 2 * dir) * ACT_STRIDE;
        const bf16* srcv = act + (size_t)(HG ? 5 : 2) * ACT_STRIDE;
        float gamma = 0.f;
        if (!HG) { const float lg = a.in[10][(j_layer * 2 + dir) * 8 + h]; gamma = 1.0f / (1.0f + expf(-lg)); }
        float S[DPL][8];
#pragma unroll
        for (int i = 0; i < DPL; ++i)
#pragma unroll
            for (int jj = 0; jj < 8; ++jj) S[i][jj] = 0.f;
        constexpr int NCH = (CTXL + SEQ) / CH;
        constexpr int NPQ = HG ? 1 : 2;
        v4u rq[NQ][NPQ]; v4u rv = {0u, 0u, 0u, 0u};
#define MIX_ROWLO(c) (((c) < CTXL / CH) ? (ML + b * CTXL + (dir ? (CTXL / CH - 1 - (c)) : (c)) * CH) : (b * SEQ + (dir ? (SEQ / CH - 1 - ((c) - CTXL / CH)) : ((c) - CTXL / CH)) * CH))
#define MIX_LOAD(c) do { const int rlo_ = MIX_ROWLO(c); \
        _Pragma("unroll") for (int p_ = 0; p_ < NPQ; ++p_) { const int pc_ = tid + 512 * p_; const int row_ = HG ? (pc_ >> 4) : (pc_ >> 5), cc_ = HG ? (pc_ & 15) : (pc_ & 31); \
            const size_t go_ = (size_t)(rlo_ + row_) * D + h * HD + cc_ * 8; \
            rq[0][p_] = *(const GAS v4u*)(src0 + go_); rq[1][p_] = *(const GAS v4u*)(src1 + go_); if (HG) rq[NQ - 1][p_] = *(const GAS v4u*)(src2 + go_); } \
        if (tid < 256) { const int row_ = tid >> 3, cc_ = tid & 7; rv = *(const GAS v4u*)(srcv + (size_t)(rlo_ + row_) * D + h * HD + eb * 64 + cc_ * 8); } } while (0)
#define MIX_STORE(bufp) do { \
        _Pragma("unroll") for (int p_ = 0; p_ < NPQ; ++p_) { const int pc_ = tid + 512 * p_; \
            _Pragma("unroll") for (int q_ = 0; q_ < NQ; ++q_) *(LAS v4u*)((bufp) + q_ * QB + pc_ * 16) = rq[q_][p_]; } \
        if (tid < 256) *(LAS v4u*)((bufp) + VB_OFF + tid * 16) = rv; } while (0)
        __syncthreads();
        MIX_LOAD(0); MIX_STORE(F.lds);
        __syncthreads();
        for (int c = 0; c < NCH; ++c) {
            LAS unsigned char* cur = F.lds + (c & 1) * BUF; LAS unsigned char* nxt = F.lds + ((c + 1) & 1) * BUF;
            if (c + 1 < NCH) MIX_LOAD(c + 1);
            const int rlo = MIX_ROWLO(c);
            const bool do_out = ctx_out || c >= CTXL / CH;
#pragma unroll 2
            for (int s = 0; s < CH; ++s) {
                const int lrow = dir ? (CH - 1 - s) : s;
                float q[DPL], k[DPL], f[DPL];
                if (HG) {
                    const unsigned qw = *(const LAS unsigned*)(cur + lrow * 256 + lane * 4), lw = *(const LAS unsigned*)(cur + QB + lrow * 256 + lane * 4), kw = *(const LAS unsigned*)(cur + 2 * QB + lrow * 256 + lane * 4);
                    q[0] = bflo(qw); q[1] = bfhi(qw); f[0] = __expf(bflo(lw)); f[1] = __expf(bfhi(lw)); k[0] = bflo(kw); k[1] = bfhi(kw);
                } else {
                    const v2u qw = *(const LAS v2u*)(cur + lrow * 512 + lane * 8), kw = *(const LAS v2u*)(cur + QB + lrow * 512 + lane * 8);
                    q[0] = bflo(qw.x); q[1] = bfhi(qw.x); q[DPL - 2] = bflo(qw.y); q[DPL - 1] = bfhi(qw.y);
                    k[0] = bflo(kw.x); k[1] = bfhi(kw.x); k[DPL - 2] = bflo(kw.y); k[DPL - 1] = bfhi(kw.y);
#pragma unroll
                    for (int i = 0; i < DPL; ++i) f[i] = gamma;
                }
                const v4u vw = *(const LAS v4u*)(cur + VB_OFF + lrow * 128 + w * 16);
                const float v[8] = {bflo(vw.x), bfhi(vw.x), bflo(vw.y), bfhi(vw.y), bflo(vw.z), bfhi(vw.z), bflo(vw.w), bfhi(vw.w)};
                float p[8];
#pragma unroll
                for (int jj = 0; jj < 8; ++jj) {
                    float acc = 0.f;
#pragma unroll
                    for (int i = 0; i < DPL; ++i) { S[i][jj] = fmaf(f[i], S[i][jj], k[i] * v[jj]); acc = fmaf(q[i], S[i][jj], acc); }
                    p[jj] = acc;
                }
                if (do_out) {
                    const bool h1 = (lane & 32) != 0, h2 = (lane & 16) != 0, h3 = (lane & 8) != 0;
                    float a4[4], a2[2];
#pragma unroll
                    for (int jj = 0; jj < 4; ++jj) { const float snd = h1 ? p[jj] : p[jj + 4]; const float rcv = __shfl_xor(snd, 32); a4[jj] = (h1 ? p[jj + 4] : p[jj]) + rcv; }
#pragma unroll
                    for (int jj = 0; jj < 2; ++jj) { const float snd = h2 ? a4[jj] : a4[jj + 2]; const float rcv = __shfl_xor(snd, 16); a2[jj] = (h2 ? a4[jj + 2] : a4[jj]) + rcv; }
                    float r1; { const float snd = h3 ? a2[0] : a2[1]; const float rcv = __shfl_xor(snd, 8); r1 = (h3 ? a2[1] : a2[0]) + rcv; }
                    r1 += __shfl_xor(r1, 4); r1 += __shfl_xor(r1, 2); r1 += __shfl_xor(r1, 1);
                    if ((lane & 7) == 0) O[(size_t)(rlo + lrow) * D + h * HD + eb * 64 + w * 8 + (lane >> 3)] = (bf16)f2bf(r1);
                }
            }
            if (c + 1 < NCH) MIX_STORE(nxt);
            __syncthreads();
        }
#undef MIX_ROWLO
#undef MIX_LOAD
#undef MIX_STORE
    }
}


typedef short mx_bf16x8 __attribute__((ext_vector_type(8)));
typedef short mx_s4 __attribute__((ext_vector_type(4)));
#ifndef MX_SWZ
#define MX_SWZ 0
#endif
constexpr int MX_PS = MX_SWZ ? 128 : 144;
__device__ __forceinline__ int sw16(int row) { return MX_SWZ ? 2 * (row & 3) + 8 * ((row >> 3) & 1) : 0; }
__device__ __forceinline__ int sw8(int row) { return MX_SWZ ? (row >> 1) & 7 : 0; }
__device__ __forceinline__ mx_bf16x8 frag_row(const LAS unsigned char* img, int stride, int row0, int k0, int lane) {
    const int row = row0 + (lane & 15);
    return *(const LAS mx_bf16x8*)(img + row * stride + 16 * (((k0 >> 3) + (lane >> 4)) ^ sw16(row)));
}
__device__ __forceinline__ mx_bf16x8 frag_row8(const LAS unsigned char* img, int row0, int k0, int lane) {
    const int row = row0 + (lane & 15);
    return *(const LAS mx_bf16x8*)(img + row * MX_PS + 16 * (((k0 >> 3) + (lane >> 4)) ^ sw8(row)));
}
__device__ __forceinline__ mx_bf16x8 frag_tr(const LAS unsigned char* img, int stride, int k0, int c0, int lane) {
    const int g = lane >> 4, i = lane & 15, q = i >> 2, p = i & 3;
    const int row = k0 + 8 * g + q;
    const LAS unsigned char* ad = img + row * stride + 16 * (((c0 >> 3) + (p >> 1)) ^ sw16(row)) + 8 * (p & 1);
    const mx_s4 x = __builtin_amdgcn_ds_read_tr16_b64_v4i16((LAS mx_s4*)ad);
    const mx_s4 y = __builtin_amdgcn_ds_read_tr16_b64_v4i16((LAS mx_s4*)(ad + 4 * stride));
    return (mx_bf16x8){x[0], x[1], x[2], x[3], y[0], y[1], y[2], y[3]};
}
#define MX_MFMA(a, b, c) __builtin_amdgcn_mfma_f32_16x16x32_bf16((a), (b), (c), 0, 0, 0)
#define MX_BAR() do { asm volatile("s_waitcnt lgkmcnt(0)" ::: "memory"); __builtin_amdgcn_s_barrier(); if (MXP_BAR > 1) __builtin_amdgcn_s_barrier(); asm volatile("" ::: "memory"); } while (0)

template <bool HG, int VAR = 0>
__device__ __forceinline__ void mixer_mfma(const Args& a, Frame& F, int j_layer, bool ctx_out) {
    relaunder(F);
    float zf_ = 0.f; asm volatile("" : "+v"(zf_));
    const f32x4 ZERO4 = {zf_, zf_, zf_, zf_};
    constexpr int HD = HG ? 128 : 256, NH = HG ? 16 : 8, NEB = HD / 64, C = 64, NCTX = CTXL / C, NCH = (CTXL + SEQ) / C;
    constexpr int KS = HD / 32;
    constexpr int DT = HD / 128;
    constexpr int QS = HD * 2 + (MX_SWZ ? 0 : 16);
    constexpr int IMG = 64 * QS;
    constexpr int PS = MX_PS;
    constexpr int NI = HG ? 4 : 2;
    constexpr int O_VT = NI * IMG, O_P = O_VT + 64 * PS, O_ST = O_P + 64 * PS, O_TOT = O_ST + IMG, O_END = O_TOT + 4 * 128 * 4 + 128 * 4;
    static_assert(O_END <= RING_BYTES, "mixer LDS");
    const int lane = F.lane, w = F.wave, tid = F.tid, g = lane >> 4, i = lane & 15;
    const int rg = w >> 1, cg = w & 1, nq0 = 16 * rg;
    LAS unsigned char* const L = F.lds;
    const bf16* act = (const bf16*)(a.ws + WS_ACT);
    for (int task = F.vcu; task < BATCH * NH * 2 * NEB; task += F.G) {
        const int eb = task % NEB, dir = (task / NEB) & 1, h = (task / (2 * NEB)) % NH, b = task / (2 * NEB * NH);
        bf16* O = (bf16*)(a.ws + (dir ? WS_OB : WS_OF));
        const bf16* src0 = act;
        const bf16* src1 = act + (size_t)(HG ? (2 + 2 * dir) : 1) * ACT_STRIDE;
        const bf16* src2 = act + (size_t)(1 + 2 * dir) * ACT_STRIDE;
        const bf16* srcv = act + (size_t)(HG ? 5 : 2) * ACT_STRIDE;
        float lg2 = 0.f;
        if (!HG) { const float x = a.in[10][(j_layer * 2 + dir) * 8 + h]; lg2 = -log1pf(expf(-x)) * 1.4426950408889634f; }
        const float r1 = HG ? 1.f : exp2f((float)(nq0 + i - 63) * lg2), r2 = HG ? 1.f : exp2f((float)(nq0 + i + 1) * lg2), cdec = HG ? 1.f : exp2f(64.f * lg2);
        const int vrow = tid & 63, vcc = tid >> 6;
        const int vs = dir ? 63 - vrow : vrow;
        const float kdec = HG ? 1.f : exp2f((float)(63 - vs) * lg2);
        f32x4 accS[DT][4];
#pragma unroll
        for (int td = 0; td < DT; ++td)
#pragma unroll
            for (int te = 0; te < 4; ++te) accS[td][te] = ZERO4;
        constexpr int NPQ = HG ? 2 : 4;
        constexpr int PF = HG ? MX_PF_HG : MX_PF_RET;
        static_assert(NCH % PF == 0, "prefetch depth must divide the chunk count");
        v4u rq[PF][HG ? 3 : 2][NPQ]; v4u rv[PF];
#define MX_ROWLO(c) (((c) < NCTX) ? (ML + b * CTXL + (dir ? (NCTX - 1 - (c)) : (c)) * C) : (b * SEQ + (dir ? (SEQ / C - 1 - ((c) - NCTX)) : ((c) - NCTX)) * C))
#define MX_LOAD(c, SET) do { const int rlo_ = (VAR & 1) ? MX_ROWLO(0) : MX_ROWLO(c); \
        _Pragma("unroll") for (int p_ = 0; p_ < NPQ; ++p_) { const int pc_ = tid + 512 * p_; const int row_ = pc_ / (HD / 8), cc_ = pc_ % (HD / 8); \
            const size_t go_ = (size_t)(rlo_ + row_) * D + h * HD + cc_ * 8; \
            rq[SET][0][p_] = *(const GAS v4u*)(src0 + go_); rq[SET][1][p_] = *(const GAS v4u*)(src1 + go_); if (HG) rq[SET][HG ? 2 : 1][p_] = *(const GAS v4u*)(src2 + go_); } \
        rv[SET] = *(const GAS v4u*)(srcv + (size_t)(rlo_ + vrow) * D + h * HD + eb * 64 + vcc * 8); } while (0)
#define MX_STAGE(SET) do { \
        _Pragma("unroll") for (int p_ = 0; p_ < NPQ; ++p_) { const int pc_ = tid + 512 * p_; const int row_ = pc_ / (HD / 8), cc_ = pc_ % (HD / 8); const int s_ = dir ? 63 - row_ : row_; \
            const int so_ = s_ * QS + 16 * (cc_ ^ sw16(s_)); *(LAS v4u*)(L + so_) = rq[SET][0][p_]; *(LAS v4u*)(L + IMG + so_) = rq[SET][1][p_]; if (HG) *(LAS v4u*)(L + 2 * IMG + so_) = rq[SET][HG ? 2 : 1][p_]; } \
        { const unsigned vw_[4] = {rv[SET].x, rv[SET].y, rv[SET].z, rv[SET].w}; \
          _Pragma("unroll") for (int jj_ = 0; jj_ < 4; ++jj_) { \
              *(LAS unsigned short*)(L + O_VT + (vcc * 8 + 2 * jj_) * PS + 16 * ((vs >> 3) ^ sw8(vcc * 8 + 2 * jj_)) + (vs & 7) * 2) = (unsigned short)(pk2(bflo(vw_[jj_]) * kdec, bfhi(vw_[jj_]) * kdec) & 0xffffu); \
              *(LAS unsigned short*)(L + O_VT + (vcc * 8 + 2 * jj_ + 1) * PS + 16 * ((vs >> 3) ^ sw8(vcc * 8 + 2 * jj_ + 1)) + (vs & 7) * 2) = (unsigned short)(pk2(bflo(vw_[jj_]) * kdec, bfhi(vw_[jj_]) * kdec) >> 16); } } } while (0)
        __syncthreads();
        for (int u = tid; u < IMG / 16; u += NWAVES * 64) { const unsigned zu_ = __builtin_bit_cast(unsigned, zf_); *(LAS v4u*)(L + O_ST + u * 16) = (v4u){zu_, zu_, zu_, zu_}; }
#pragma unroll
        for (int u = 0; u < PF; ++u) MX_LOAD(u, u);
        for (int c0 = 0; c0 < NCH; c0 += PF)
#pragma unroll
        for (int u = 0; u < PF; ++u) {
            const int c = c0 + u;
            MX_STAGE(u);
            if (MXP_STG > 1) { asm volatile("" ::: "memory"); MX_STAGE(u); }
            if (HG) {
                MX_BAR();
                const int d = tid & 127, qr = tid >> 7;
                float cl[16], qv[16], kv[16]; float run = 0.f;
#pragma unroll
                for (int ii = 0; ii < 16; ++ii) { const int s = 16 * qr + ii;
                    const int eo = s * QS + 16 * ((d >> 3) ^ sw16(s)) + (d & 7) * 2;
                    run += bflo((unsigned)*(const LAS unsigned short*)(L + 2 * IMG + eo)); cl[ii] = run;
                    qv[ii] = bflo((unsigned)*(const LAS unsigned short*)(L + eo)); kv[ii] = bflo((unsigned)*(const LAS unsigned short*)(L + IMG + eo)); }
                LAS float* tot = (LAS float*)(L + O_TOT);
                tot[qr * 128 + d] = run;
                MX_BAR();
                const float t0 = tot[d], t1 = tot[128 + d], t2 = tot[256 + d], t3 = tot[384 + d];
                const float off = (qr == 0) ? 0.f : (qr == 1) ? t0 : (qr == 2) ? (t0 + t1) : (t0 + t1 + t2);
                const float cref = t0 + t1, cend = (t0 + t1) + (t2 + t3);
                if (qr == 0) tot[512 + d] = cend;
#pragma unroll
                for (int ii = 0; ii < 16; ++ii) { const int s = 16 * qr + ii; const float cm = off + cl[ii]; const int eo = s * QS + 16 * ((d >> 3) ^ sw16(s)) + (d & 7) * 2;
                    const float e1 = __expf(fminf(cm - cref, 80.f)), e2 = __expf(fminf(cref - cm, 80.f)), e3 = __expf(cm), e4 = __expf(cend - cm);
                    const unsigned w12 = pk2(qv[ii] * e1, kv[ii] * e2), w34 = pk2(qv[ii] * e3, kv[ii] * e4);
                    *(LAS unsigned short*)(L + eo) = (unsigned short)(w12 & 0xffffu);
                    *(LAS unsigned short*)(L + IMG + eo) = (unsigned short)(w12 >> 16);
                    *(LAS unsigned short*)(L + 2 * IMG + eo) = (unsigned short)(w34 & 0xffffu);
                    *(LAS unsigned short*)(L + 3 * IMG + eo) = (unsigned short)(w34 >> 16); }
            }
            MX_BAR();
            { const int cn = (c + PF < NCH) ? c + PF : NCH - 1; MX_LOAD(cn, u); }
            if (MXP_SLEEP > 0) __builtin_amdgcn_s_sleep(MXP_SLEEP);
            const int rlo = MX_ROWLO(c);
            const bool do_out = ctx_out || c >= NCTX;
            mx_bf16x8 aq[KS];
            if (do_out) {
#pragma unroll
                for (int ks = 0; ks < KS; ++ks) aq[ks] = frag_row(L, QS, nq0, 32 * ks, lane);
                for (int rep1 = 0; rep1 < MXP_S1; ++rep1) {
                f32x4 pt0 = ZERO4, pt1 = ZERO4;
#pragma unroll
                for (int kb = 0; kb < KS; kb += 4) {
                    mx_bf16x8 kf[2][4];
#pragma unroll
                    for (int ks = 0; ks < 4; ++ks) { kf[0][ks] = frag_row(L + IMG, QS, 32 * cg, 32 * (kb + ks), lane); kf[1][ks] = frag_row(L + IMG, QS, 32 * cg + 16, 32 * (kb + ks), lane); }
                    __builtin_amdgcn_sched_barrier(0);
#pragma unroll
                    for (int ks = 0; ks < 4; ++ks) { pt0 = MX_MFMA(kf[0][ks], aq[kb + ks], pt0); pt1 = MX_MFMA(kf[1][ks], aq[kb + ks], pt1); }
                    __builtin_amdgcn_sched_barrier(0);
                }
                const int m0 = 32 * cg + 4 * g, n = nq0 + i;
                v2u pw; pw.x = pk2((m0 <= n) ? pt0[0] : 0.f, (m0 + 1 <= n) ? pt0[1] : 0.f); pw.y = pk2((m0 + 2 <= n) ? pt0[2] : 0.f, (m0 + 3 <= n) ? pt0[3] : 0.f);
                *(LAS v2u*)(L + O_P + n * PS + 16 * ((m0 >> 3) ^ sw8(n)) + (m0 & 7) * 2) = pw;
                const int m1 = m0 + 16;
                pw.x = pk2((m1 <= n) ? pt1[0] : 0.f, (m1 + 1 <= n) ? pt1[1] : 0.f); pw.y = pk2((m1 + 2 <= n) ? pt1[2] : 0.f, (m1 + 3 <= n) ? pt1[3] : 0.f);
                *(LAS v2u*)(L + O_P + n * PS + 16 * ((m1 >> 3) ^ sw8(n)) + (m1 & 7) * 2) = pw;
                }
            }
            {
                mx_bf16x8 vt[4][2], ak[DT][2]; f32x4 dec[DT];
#pragma unroll
                for (int te = 0; te < 4; ++te) { vt[te][0] = frag_row8(L + O_VT, 16 * te, 0, lane); vt[te][1] = frag_row8(L + O_VT, 16 * te, 32, lane); }
#pragma unroll
                for (int td = 0; td < DT; ++td) { const int d0 = 16 * (DT * w + td);
                    ak[td][0] = frag_tr(L + (HG ? 3 : 1) * IMG, QS, 0, d0, lane); ak[td][1] = frag_tr(L + (HG ? 3 : 1) * IMG, QS, 32, d0, lane);
                    dec[td] = (f32x4){cdec, cdec, cdec, cdec};
                    if (HG) { const f32x4 ce = *(const LAS f32x4*)(L + O_TOT + 2048 + (d0 + 4 * g) * 4); dec[td] = (f32x4){__expf(ce[0]), __expf(ce[1]), __expf(ce[2]), __expf(ce[3])}; } }
                __builtin_amdgcn_sched_barrier(0);
#pragma unroll
                for (int td = 0; td < DT; ++td)
#pragma unroll
                    for (int te = 0; te < 4; ++te) accS[td][te] = MX_MFMA(ak[td][0], vt[te][0], accS[td][te] * dec[td]);
#pragma unroll
                for (int td = 0; td < DT; ++td)
#pragma unroll
                    for (int te = 0; te < 4; ++te) accS[td][te] = MX_MFMA(ak[td][1], vt[te][1], accS[td][te]);
            }
            MX_BAR();
            if (do_out) {
                if (HG) {
#pragma unroll
                    for (int ks = 0; ks < KS; ++ks) aq[ks] = frag_row(L + 2 * IMG, QS, nq0, 32 * ks, lane);
                }
                mx_bf16x8 vo[2][2];
                const mx_bf16x8 bp0 = frag_row8(L + O_P, nq0, 0, lane), bp1 = frag_row8(L + O_P, nq0, 32, lane);
#pragma unroll
                for (int te = 0; te < 2; ++te) { vo[te][0] = frag_row8(L + O_VT, 32 * cg + 16 * te, 0, lane); vo[te][1] = frag_row8(L + O_VT, 32 * cg + 16 * te, 32, lane); }
                const int grow = rlo + (dir ? 63 - (nq0 + i) : (nq0 + i));
                for (int rep2 = 0; rep2 < MXP_S2; ++rep2) {
                f32x4 o1a = ZERO4, o1b = o1a, o2a = o1a, o2b = o1a;
#pragma unroll
                for (int kb = 0; kb < KS; kb += 4) {
                    mx_bf16x8 st[2][4];
#pragma unroll
                    for (int ks = 0; ks < 4; ++ks) { st[0][ks] = frag_row(L + O_ST, QS, 32 * cg, 32 * (kb + ks), lane); st[1][ks] = frag_row(L + O_ST, QS, 32 * cg + 16, 32 * (kb + ks), lane); }
                    __builtin_amdgcn_sched_barrier(0);
                    if (kb == 0) { o1a = MX_MFMA(vo[0][0], bp0, o1a); o1b = MX_MFMA(vo[1][0], bp0, o1b); o1a = MX_MFMA(vo[0][1], bp1, o1a); o1b = MX_MFMA(vo[1][1], bp1, o1b); }
#pragma unroll
                    for (int ks = 0; ks < 4; ++ks) { o2a = MX_MFMA(st[0][ks], aq[kb + ks], o2a); o2b = MX_MFMA(st[1][ks], aq[kb + ks], o2b); }
                    __builtin_amdgcn_sched_barrier(0);
                }
                bf16* op = O + (size_t)grow * D + h * HD + eb * 64 + 32 * cg + 4 * g;
                if (!(VAR & 2)) { const f32x4 ya = o1a * r1 + o2a * r2, yb = o1b * r1 + o2b * r2; v2u wa, wb; wa.x = pk2(ya[0], ya[1]); wa.y = pk2(ya[2], ya[3]); wb.x = pk2(yb[0], yb[1]); wb.y = pk2(yb[2], yb[3]);
                    *(GAS v2u*)(op) = wa; *(GAS v2u*)(op + 16) = wb; }
                else { asm volatile("" :: "v"(o1a), "v"(o1b), "v"(o2a), "v"(o2b)); }
                }
            }
            MX_BAR();
#pragma unroll
            for (int td = 0; td < DT; ++td)
#pragma unroll
                for (int te = 0; te < 4; ++te) { const int d0 = 16 * (DT * w + td); const f32x4 s = accS[td][te];
                    v2u sw; sw.x = pk2(s[0], s[1]); sw.y = pk2(s[2], s[3]);
                    *(LAS v2u*)(L + O_ST + (16 * te + i) * QS + 16 * (((d0 + 4 * g) >> 3) ^ sw16(16 * te + i)) + ((d0 + 4 * g) & 7) * 2) = sw; }
        }
#undef MX_ROWLO
#undef MX_LOAD
#undef MX_STAGE
    }
}

__device__ __forceinline__ void mixer_hg2(const Args& a, Frame& F, bool ctx_out) {
    relaunder(F);
    float zf_ = 0.f; asm volatile("" : "+v"(zf_));
    const f32x4 ZERO4 = {zf_, zf_, zf_, zf_};
    constexpr int HD = 128, NH = 16, NEB = 2, C = 64, NCTX = CTXL / C, NCH = (CTXL + SEQ) / C, KS = HD / 32;
    constexpr int QS = HD * 2 + 16, IMG = 64 * QS, PS = MX_PS;
    constexpr int O_VT = 3 * IMG, O_P = O_VT + 64 * PS, O_ST = O_P + 64 * PS, O_END = O_ST + IMG;
    static_assert(O_END <= RING_BYTES && MX_SWZ == 0, "mixer_hg2 LDS (padded images)");
    const int lane = F.lane, w = F.wave, tid = F.tid, g = lane >> 4, i = lane & 15;
    const int rg = w >> 1, cg = w & 1, nq0 = 16 * rg;
    LAS unsigned char* const L = F.lds;
    const bf16* act = (const bf16*)(a.ws + WS_ACT);
    mx_bf16x8 bt0, bt1;
#pragma unroll
    for (int j = 0; j < 8; ++j) { bt0[j] = (8 * g + j <= i) ? (short)0x3F80 : (short)0; bt1[j] = (8 * g + j <= 16 + i) ? (short)0x3F80 : (short)0; }
    for (int task = F.vcu; task < BATCH * NH * 2 * NEB; task += F.G) {
        const int eb = task % NEB, dir = (task / NEB) & 1, h = (task / (2 * NEB)) % NH, b = task / (2 * NEB * NH);
        bf16* O = (bf16*)(a.ws + (dir ? WS_OB : WS_OF));
        const bf16* src0 = act;
        const bf16* src1 = act + (size_t)(2 + 2 * dir) * ACT_STRIDE;
        const bf16* src2 = act + (size_t)(1 + 2 * dir) * ACT_STRIDE;
        const bf16* srcv = act + (size_t)5 * ACT_STRIDE;
        const int vrow = tid & 63, vcc = tid >> 6, vs = dir ? 63 - vrow : vrow;
        f32x4 accS[4];
#pragma unroll
        for (int te = 0; te < 4; ++te) accS[te] = ZERO4;
        constexpr int PF = MX_PF_HG;
        static_assert(NCH % PF == 0, "prefetch depth must divide the chunk count");
        v4u rq[PF][3][2]; v4u rv[PF];
#define H2_ROWLO(c) (((c) < NCTX) ? (ML + b * CTXL + (dir ? (NCTX - 1 - (c)) : (c)) * C) : (b * SEQ + (dir ? (SEQ / C - 1 - ((c) - NCTX)) : ((c) - NCTX)) * C))
#define H2_LOAD(c, SET) do { const int rlo_ = H2_ROWLO(c); \
        _Pragma("unroll") for (int p_ = 0; p_ < 2; ++p_) { const int pc_ = tid + 512 * p_; const size_t go_ = (size_t)(rlo_ + (pc_ >> 4)) * D + h * HD + (pc_ & 15) * 8; \
            rq[SET][0][p_] = *(const GAS v4u*)(src0 + go_); rq[SET][1][p_] = *(const GAS v4u*)(src1 + go_); rq[SET][2][p_] = *(const GAS v4u*)(src2 + go_); } \
        rv[SET] = *(const GAS v4u*)(srcv + (size_t)(rlo_ + vrow) * D + h * HD + eb * 64 + vcc * 8); } while (0)
#define H2_STAGE(SET) do { \
        _Pragma("unroll") for (int p_ = 0; p_ < 2; ++p_) { const int pc_ = tid + 512 * p_; const int row_ = pc_ >> 4; const int s_ = dir ? 63 - row_ : row_; const int so_ = s_ * QS + (pc_ & 15) * 16; \
            *(LAS v4u*)(L + so_) = rq[SET][0][p_]; *(LAS v4u*)(L + IMG + so_) = rq[SET][1][p_]; *(LAS v4u*)(L + 2 * IMG + so_) = rq[SET][2][p_]; } \
        { const unsigned vw_[4] = {rv[SET].x, rv[SET].y, rv[SET].z, rv[SET].w}; \
          _Pragma("unroll") for (int jj_ = 0; jj_ < 4; ++jj_) { \
              *(LAS unsigned short*)(L + O_VT + (vcc * 8 + 2 * jj_) * PS + vs * 2) = (unsigned short)(vw_[jj_] & 0xffffu); \
              *(LAS unsigned short*)(L + O_VT + (vcc * 8 + 2 * jj_ + 1) * PS + vs * 2) = (unsigned short)(vw_[jj_] >> 16); } } } while (0)
        __syncthreads();
#pragma unroll
        for (int u = 0; u < PF; ++u) H2_LOAD(u, u);
        for (int c0 = 0; c0 < NCH; c0 += PF)
#pragma unroll
        for (int u = 0; u < PF; ++u) {
            const int c = c0 + u;
            H2_STAGE(u);
            MX_BAR();
            { const int cn = (c + PF < NCH) ? c + PF : NCH - 1; H2_LOAD(cn, u); }
            f32x4 fe, fu;
            {
                unsigned one2_ = 0x3F803F80u; asm volatile("" : "+v"(one2_));
                typedef unsigned u4_ __attribute__((ext_vector_type(4)));
                const mx_bf16x8 ones = __builtin_bit_cast(mx_bf16x8, (u4_){one2_, one2_, one2_, one2_});
                const mx_bf16x8 a0 = frag_tr(L + 2 * IMG, QS, 0, 16 * w, lane), a1 = frag_tr(L + 2 * IMG, QS, 32, 16 * w, lane);
                const f32x4 z = ZERO4;
                f32x4 ct[4];
                ct[0] = MX_MFMA(a0, bt0, z); ct[1] = MX_MFMA(a0, bt1, z);
                const f32x4 cref = MX_MFMA(a0, ones, z);
                ct[2] = MX_MFMA(a1, bt0, cref); ct[3] = MX_MFMA(a1, bt1, cref);
                const f32x4 cend = MX_MFMA(a1, ones, cref);
                fe = (f32x4){__expf(cend[0]), __expf(cend[1]), __expf(cend[2]), __expf(cend[3])};
                fu = (f32x4){__expf(cend[0] - cref[0]), __expf(cend[1] - cref[1]), __expf(cend[2] - cref[2]), __expf(cend[3] - cref[3])};
                const f32x4 fs = {__expf(cref[0]), __expf(cref[1]), __expf(cref[2]), __expf(cref[3])};
#pragma unroll
                for (int te = 0; te < 4; ++te) { const f32x4 s = accS[te] * fs; v2u sw; sw.x = pk2(s[0], s[1]); sw.y = pk2(s[2], s[3]);
                    *(LAS v2u*)(L + O_ST + (16 * te + i) * QS + (16 * w + 4 * g) * 2) = sw; }
#pragma unroll
                for (int t = 0; t < 4; ++t) {
                    LAS unsigned char* pq = L + (16 * t + i) * QS + (16 * w + 4 * g) * 2;
                    const v2u qw = *(const LAS v2u*)pq, kw = *(const LAS v2u*)(pq + IMG);
                    f32x4 e1;
#pragma unroll
                    for (int r = 0; r < 4; ++r) e1[r] = __expf(fminf(fmaxf(ct[t][r] - cref[r], -80.f), 80.f));
                    const f32x4 e2 = {__builtin_amdgcn_rcpf(e1[0]), __builtin_amdgcn_rcpf(e1[1]), __builtin_amdgcn_rcpf(e1[2]), __builtin_amdgcn_rcpf(e1[3])};
                    v2u qo, ko;
                    qo.x = pk2(bflo(qw.x) * e1[0], bfhi(qw.x) * e1[1]); qo.y = pk2(bflo(qw.y) * e1[2], bfhi(qw.y) * e1[3]);
                    ko.x = pk2(bflo(kw.x) * e2[0], bfhi(kw.x) * e2[1]); ko.y = pk2(bflo(kw.y) * e2[2], bfhi(kw.y) * e2[3]);
                    *(LAS v2u*)pq = qo; *(LAS v2u*)(pq + IMG) = ko;
                }
            }
            MX_BAR();
            const int rlo = H2_ROWLO(c);
            const bool do_out = ctx_out || c >= NCTX;
            mx_bf16x8 aq[KS];
            {
                mx_bf16x8 kf[2][KS], vt[4][2];
                if (do_out) {
#pragma unroll
                    for (int ks = 0; ks < KS; ++ks) { aq[ks] = frag_row(L, QS, nq0, 32 * ks, lane); kf[0][ks] = frag_row(L + IMG, QS, 32 * cg, 32 * ks, lane); kf[1][ks] = frag_row(L + IMG, QS, 32 * cg + 16, 32 * ks, lane); }
                }
#pragma unroll
                for (int te = 0; te < 4; ++te) { vt[te][0] = frag_row8(L + O_VT, 16 * te, 0, lane); vt[te][1] = frag_row8(L + O_VT, 16 * te, 32, lane); }
                const mx_bf16x8 ak0 = frag_tr(L + IMG, QS, 0, 16 * w, lane), ak1 = frag_tr(L + IMG, QS, 32, 16 * w, lane);
                __builtin_amdgcn_sched_barrier(0);
                f32x4 pt0 = ZERO4, pt1 = ZERO4;
                if (do_out) {
#pragma unroll
                    for (int ks = 0; ks < KS; ++ks) { pt0 = MX_MFMA(kf[0][ks], aq[ks], pt0); pt1 = MX_MFMA(kf[1][ks], aq[ks], pt1); }
                }
                f32x4 uu[4];
#pragma unroll
                for (int te = 0; te < 4; ++te) { const f32x4 z4 = ZERO4; uu[te] = MX_MFMA(ak0, vt[te][0], z4); }
#pragma unroll
                for (int te = 0; te < 4; ++te) uu[te] = MX_MFMA(ak1, vt[te][1], uu[te]);
                __builtin_amdgcn_sched_barrier(0);
                if (do_out) {
                    const int m0 = 32 * cg + 4 * g, m1 = m0 + 16, n = nq0 + i;
                    v2u pw; pw.x = pk2((m0 <= n) ? pt0[0] : 0.f, (m0 + 1 <= n) ? pt0[1] : 0.f); pw.y = pk2((m0 + 2 <= n) ? pt0[2] : 0.f, (m0 + 3 <= n) ? pt0[3] : 0.f);
                    *(LAS v2u*)(L + O_P + n * PS + m0 * 2) = pw;
                    pw.x = pk2((m1 <= n) ? pt1[0] : 0.f, (m1 + 1 <= n) ? pt1[1] : 0.f); pw.y = pk2((m1 + 2 <= n) ? pt1[2] : 0.f, (m1 + 3 <= n) ? pt1[3] : 0.f);
                    *(LAS v2u*)(L + O_P + n * PS + m1 * 2) = pw;
                }
#pragma unroll
                for (int te = 0; te < 4; ++te) accS[te] = accS[te] * fe + uu[te] * fu;
            }
            MX_BAR();
            if (do_out) {
                mx_bf16x8 st[2][KS], vo[2][2];
                const mx_bf16x8 bp0 = frag_row8(L + O_P, nq0, 0, lane), bp1 = frag_row8(L + O_P, nq0, 32, lane);
#pragma unroll
                for (int te = 0; te < 2; ++te) { vo[te][0] = frag_row8(L + O_VT, 32 * cg + 16 * te, 0, lane); vo[te][1] = frag_row8(L + O_VT, 32 * cg + 16 * te, 32, lane);
#pragma unroll
                    for (int ks = 0; ks < KS; ++ks) st[te][ks] = frag_row(L + O_ST, QS, 32 * cg + 16 * te, 32 * ks, lane); }
                __builtin_amdgcn_sched_barrier(0);
                f32x4 oa = ZERO4, ob = oa;
                oa = MX_MFMA(vo[0][0], bp0, oa); ob = MX_MFMA(vo[1][0], bp0, ob);
#pragma unroll
                for (int ks = 0; ks < KS; ++ks) { oa = MX_MFMA(st[0][ks], aq[ks], oa); ob = MX_MFMA(st[1][ks], aq[ks], ob); }
                oa = MX_MFMA(vo[0][1], bp1, oa); ob = MX_MFMA(vo[1][1], bp1, ob);
                bf16* op = O + (size_t)(rlo + (dir ? 63 - (nq0 + i) : (nq0 + i))) * D + h * HD + eb * 64 + 32 * cg + 4 * g;
                v2u wa, wb; wa.x = pk2(oa[0], oa[1]); wa.y = pk2(oa[2], oa[3]); wb.x = pk2(ob[0], ob[1]); wb.y = pk2(ob[2], ob[3]);
                *(GAS v2u*)(op) = wa; *(GAS v2u*)(op + 16) = wb;
            }
            MX_BAR();
        }
#undef H2_ROWLO
#undef H2_LOAD
#undef H2_STAGE
    }
}

__device__ __forceinline__ void mixer_ret3(const Args& a, Frame& F, int j_layer, bool ctx_out) {
    relaunder(F);
    float zf_ = 0.f; asm volatile("" : "+v"(zf_));
    const f32x4 ZERO4 = {zf_, zf_, zf_, zf_};
    constexpr int HD = 256, NH = 8, NEB = 4, C = 64, NCTX = CTXL / C, NCH = (CTXL + SEQ) / C, KS = HD / 32;
    constexpr int QS = HD * 2 + 16, IMG = 64 * QS, PS = MX_PS, VTB = 64 * PS;
    constexpr int O_VT = 2 * IMG, O_P = O_VT + 2 * VTB, O_ST = O_P + VTB, O_END = O_ST + IMG;
    static_assert(O_END <= RING_BYTES && MX_SWZ == 0, "mixer_ret3 LDS (padded images)");
    const int lane = F.lane, w = F.wave, tid = F.tid, g = lane >> 4, i = lane & 15;
    const int rg = w >> 1, cg = w & 1, nq0 = 16 * rg;
    LAS unsigned char* const L = F.lds;
    const bf16* act = (const bf16*)(a.ws + WS_ACT);
    for (int task = F.vcu; task < BATCH * NH * 2 * NEB; task += F.G) {
        const int eb = task % NEB, dir = (task / NEB) & 1, h = (task / (2 * NEB)) % NH, b = task / (2 * NEB * NH);
        bf16* O = (bf16*)(a.ws + (dir ? WS_OB : WS_OF));
        const bf16* src0 = act; const bf16* src1 = act + ACT_STRIDE; const bf16* srcv = act + (size_t)2 * ACT_STRIDE;
        const float x = a.in[10][(j_layer * 2 + dir) * 8 + h];
        const float lg2 = -log1pf(expf(-x)) * 1.4426950408889634f;
        const float r1 = exp2f((float)(nq0 + i - 63) * lg2), r2 = exp2f((float)(nq0 + i + 1) * lg2), cdec = exp2f(64.f * lg2);
        const int vrow = tid & 63, vcc = tid >> 6, vs = dir ? 63 - vrow : vrow;
        const float kdec = exp2f((float)(63 - vs) * lg2);
        f32x4 accS[2][4];
#pragma unroll
        for (int td = 0; td < 2; ++td)
#pragma unroll
            for (int te = 0; te < 4; ++te) accS[td][te] = ZERO4;
        v4u rq[2][4]; v4u rv;
#define R3_ROWLO(c) (((c) < NCTX) ? (ML + b * CTXL + (dir ? (NCTX - 1 - (c)) : (c)) * C) : (b * SEQ + (dir ? (SEQ / C - 1 - ((c) - NCTX)) : ((c) - NCTX)) * C))
#define R3_LOAD(c) do { const int rlo_ = R3_ROWLO(c); \
        _Pragma("unroll") for (int p_ = 0; p_ < 4; ++p_) { const int pc_ = tid + 512 * p_; const size_t go_ = (size_t)(rlo_ + (pc_ >> 5)) * D + h * HD + (pc_ & 31) * 8; \
            rq[0][p_] = *(const GAS v4u*)(src0 + go_); rq[1][p_] = *(const GAS v4u*)(src1 + go_); } \
        rv = *(const GAS v4u*)(srcv + (size_t)(rlo_ + vrow) * D + h * HD + eb * 64 + vcc * 8); } while (0)
#define R3_STAGE(vb) do { \
        _Pragma("unroll") for (int p_ = 0; p_ < 4; ++p_) { const int pc_ = tid + 512 * p_; const int row_ = pc_ >> 5; const int s_ = dir ? 63 - row_ : row_; const int so_ = s_ * QS + (pc_ & 31) * 16; \
            *(LAS v4u*)(L + so_) = rq[0][p_]; *(LAS v4u*)(L + IMG + so_) = rq[1][p_]; } \
        { const unsigned vw_[4] = {rv.x, rv.y, rv.z, rv.w}; \
          _Pragma("unroll") for (int jj_ = 0; jj_ < 4; ++jj_) { const unsigned pw_ = pk2(bflo(vw_[jj_]) * kdec, bfhi(vw_[jj_]) * kdec); \
              *(LAS unsigned short*)(L + O_VT + (vb) * VTB + (vcc * 8 + 2 * jj_) * PS + vs * 2) = (unsigned short)(pw_ & 0xffffu); \
              *(LAS unsigned short*)(L + O_VT + (vb) * VTB + (vcc * 8 + 2 * jj_ + 1) * PS + vs * 2) = (unsigned short)(pw_ >> 16); } } } while (0)
        __syncthreads();
        { const unsigned zu_ = __builtin_bit_cast(unsigned, zf_); for (int u = tid; u < IMG / 16; u += NWAVES * 64) *(LAS v4u*)(L + O_ST + u * 16) = (v4u){zu_, zu_, zu_, zu_}; }
        R3_LOAD(0);
        R3_STAGE(0);
        R3_LOAD(1);
        MX_BAR();
        for (int c = 0; c < NCH; ++c) {
            const int vb = c & 1;
            LAS unsigned char* const Vc = L + O_VT + vb * VTB;
            const int rlo = R3_ROWLO(c);
            const bool do_out = ctx_out || c >= NCTX;
            if (c > 0) {
#pragma unroll
                for (int td = 0; td < 2; ++td)
#pragma unroll
                    for (int te = 0; te < 4; ++te) { const int d0 = 16 * (2 * w + td); const f32x4 s = accS[td][te];
                        v2u sw; sw.x = pk2(s[0], s[1]); sw.y = pk2(s[2], s[3]);
                        *(LAS v2u*)(L + O_ST + (16 * te + i) * QS + (d0 + 4 * g) * 2) = sw; }
            }
            mx_bf16x8 aq[KS];
            if (do_out) {
#pragma unroll
                for (int ks = 0; ks < KS; ++ks) aq[ks] = frag_row(L, QS, nq0, 32 * ks, lane);
                f32x4 pt0 = ZERO4, pt1 = ZERO4;
#pragma unroll
                for (int kb = 0; kb < KS; kb += 4) {
                    mx_bf16x8 kf[2][4];
#pragma unroll
                    for (int ks = 0; ks < 4; ++ks) { kf[0][ks] = frag_row(L + IMG, QS, 32 * cg, 32 * (kb + ks), lane); kf[1][ks] = frag_row(L + IMG, QS, 32 * cg + 16, 32 * (kb + ks), lane); }
                    __builtin_amdgcn_sched_barrier(0);
#pragma unroll
                    for (int ks = 0; ks < 4; ++ks) { pt0 = MX_MFMA(kf[0][ks], aq[kb + ks], pt0); pt1 = MX_MFMA(kf[1][ks], aq[kb + ks], pt1); }
                    __builtin_amdgcn_sched_barrier(0);
                }
                const int m0 = 32 * cg + 4 * g, m1 = m0 + 16, n = nq0 + i;
                v2u pw; pw.x = pk2((m0 <= n) ? pt0[0] : 0.f, (m0 + 1 <= n) ? pt0[1] : 0.f); pw.y = pk2((m0 + 2 <= n) ? pt0[2] : 0.f, (m0 + 3 <= n) ? pt0[3] : 0.f);
                *(LAS v2u*)(L + O_P + n * PS + m0 * 2) = pw;
                pw.x = pk2((m1 <= n) ? pt1[0] : 0.f, (m1 + 1 <= n) ? pt1[1] : 0.f); pw.y = pk2((m1 + 2 <= n) ? pt1[2] : 0.f, (m1 + 3 <= n) ? pt1[3] : 0.f);
                *(LAS v2u*)(L + O_P + n * PS + m1 * 2) = pw;
            }
            {
                mx_bf16x8 vt[4][2], ak[2][2];
#pragma unroll
                for (int te = 0; te < 4; ++te) { vt[te][0] = frag_row8(Vc, 16 * te, 0, lane); vt[te][1] = frag_row8(Vc, 16 * te, 32, lane); }
#pragma unroll
                for (int td = 0; td < 2; ++td) { ak[td][0] = frag_tr(L + IMG, QS, 0, 16 * (2 * w + td), lane); ak[td][1] = frag_tr(L + IMG, QS, 32, 16 * (2 * w + td), lane); }
                __builtin_amdgcn_sched_barrier(0);
#pragma unroll
                for (int td = 0; td < 2; ++td)
#pragma unroll
                    for (int te = 0; te < 4; ++te) accS[td][te] = MX_MFMA(ak[td][0], vt[te][0], accS[td][te] * cdec);
#pragma unroll
                for (int td = 0; td < 2; ++td)
#pragma unroll
                    for (int te = 0; te < 4; ++te) accS[td][te] = MX_MFMA(ak[td][1], vt[te][1], accS[td][te]);
            }
            MX_BAR();
            if (do_out) {
                mx_bf16x8 vo[2][2];
                const mx_bf16x8 bp0 = frag_row8(L + O_P, nq0, 0, lane), bp1 = frag_row8(L + O_P, nq0, 32, lane);
#pragma unroll
                for (int te = 0; te < 2; ++te) { vo[te][0] = frag_row8(Vc, 32 * cg + 16 * te, 0, lane); vo[te][1] = frag_row8(Vc, 32 * cg + 16 * te, 32, lane); }
                f32x4 o1a = ZERO4, o1b = ZERO4, o2a = ZERO4, o2b = ZERO4;
#pragma unroll
                for (int kb = 0; kb < KS; kb += 4) {
                    mx_bf16x8 st[2][4];
#pragma unroll
                    for (int ks = 0; ks < 4; ++ks) { st[0][ks] = frag_row(L + O_ST, QS, 32 * cg, 32 * (kb + ks), lane); st[1][ks] = frag_row(L + O_ST, QS, 32 * cg + 16, 32 * (kb + ks), lane); }
                    __builtin_amdgcn_sched_barrier(0);
                    if (kb == 0) { o1a = MX_MFMA(vo[0][0], bp0, o1a); o1b = MX_MFMA(vo[1][0], bp0, o1b); o1a = MX_MFMA(vo[0][1], bp1, o1a); o1b = MX_MFMA(vo[1][1], bp1, o1b); }
#pragma unroll
                    for (int ks = 0; ks < 4; ++ks) { o2a = MX_MFMA(st[0][ks], aq[kb + ks], o2a); o2b = MX_MFMA(st[1][ks], aq[kb + ks], o2b); }
                    __builtin_amdgcn_sched_barrier(0);
                }
                bf16* op = O + (size_t)(rlo + (dir ? 63 - (nq0 + i) : (nq0 + i))) * D + h * HD + eb * 64 + 32 * cg + 4 * g;
                const f32x4 ya = o1a * r1 + o2a * r2, yb = o1b * r1 + o2b * r2; v2u wa, wb; wa.x = pk2(ya[0], ya[1]); wa.y = pk2(ya[2], ya[3]); wb.x = pk2(yb[0], yb[1]); wb.y = pk2(yb[2], yb[3]);
                *(GAS v2u*)(op) = wa; *(GAS v2u*)(op + 16) = wb;
            }
            if (c + 1 < NCH) R3_STAGE(vb ^ 1);
            { const int cn = (c + 2 < NCH) ? c + 2 : NCH - 1; R3_LOAD(cn); }
            MX_BAR();
        }
#undef R3_ROWLO
#undef R3_LOAD
#undef R3_STAGE
    }
}
#ifndef MIX_MFMA_RET
#define MIX_MFMA_RET 1
#endif
#ifndef MIX_RET_V3
#define MIX_RET_V3 0
#endif
#ifndef MIX_HG_V2
#define MIX_HG_V2 1
#endif
#ifndef MIX_MFMA_HG
#define MIX_MFMA_HG 1
#endif
#ifndef REP_NORM
#define REP_NORM 1
#endif
#ifndef REP_GEMM_IN
#define REP_GEMM_IN 1
#endif
#ifndef REP_MIX_RET
#define REP_MIX_RET 1
#endif
#ifndef REP_MIX_HG
#define REP_MIX_HG 1
#endif
#ifndef REP_READ
#define REP_READ 1
#endif
#ifndef REP_GU
#define REP_GU 1
#endif
__global__ void __launch_bounds__(NWAVES * 64, 2) fwd_kernel(Args args) {
    extern __shared__ __attribute__((aligned(16))) unsigned char lds[];
    Frame F;
    F.lds = (LAS unsigned char*)lds;
    volatile LAS unsigned* MISC = (volatile LAS unsigned*)(F.lds + MISC_OFF);
    F.tid = threadIdx.x; F.lane = F.tid & 63; F.wave = __builtin_amdgcn_readfirstlane(F.tid >> 6);
    F.G = gridDim.x; { const int bx = blockIdx.x; F.vcu = (F.G % 8 == 0) ? (bx % 8) * (F.G / 8) + bx / 8 : bx; }
    unsigned char* ws = args.ws;
    F.ctl = (gu32*)(ws + WS_CTL);
    for (int u = F.tid; u < (LDS_BYTES - LDSCTL_OFF) / 4; u += NWAVES * 64) ((LAS unsigned*)(F.lds + LDSCTL_OFF))[u] = 0u;
    __syncthreads();
    XcdBarrier bar; bar.bar = (unsigned*)(F.ctl + CW_BAR); bar.x = 0; bar.st = nullptr;
    if (MK_N_LAUNCHES == 1) bar = xcd_barrier_post((unsigned*)(F.ctl + CW_BAR), MISC + 8);
    const int lo = args.ph_lo, hi = args.ph_hi;
#define IN(k) (lo <= (k) && (k) < hi)
#define SEAM(k) do { if (IN(k) && IN((k) + 1)) { xcd_barrier(bar); if (REP_BAR > 1) xcd_barrier(bar); } } while (0)
    const float* MOD = (const float*)(ws + WS_MOD);
    const float* TAB = (const float*)(ws + WS_TAB);
    float* X = (float*)(ws + WS_X);
    bf16* HN = (bf16*)(ws + WS_HN);
    bf16* ACT = (bf16*)(ws + WS_ACT);

    if (IN(0)) { p0_prologue(args, F); }
    SEAM(0);

    for (int layer = 0; layer < DEPTH; ++layer) {
        const int pb = 1 + 8 * layer;
        const bool last = (layer == DEPTH - 1), hg = (layer & 1) != 0;
        const int j = layer >> 1;
        const int Mr = last ? ML : M;
        const float* modl = MOD + (size_t)layer * 5 * MOD_LD;
        unsigned char* wb = ws + WS_W + (size_t)layer * W_LAYER;
        if (IN(pb + 0)) for (int rep = 0; rep < REP_NORM; ++rep) norm_mod_phase(args, F, args.in[6] + (size_t)layer * D, modl, 0, D, M, layer > 0 ? (modl - 5 * MOD_LD) + 4 * MOD_LD + 5 * D : nullptr, layer > 0 ? X : args.in[0], layer > 0 ? X + (size_t)ML * D : args.in[2]);
        SEAM(pb + 0);
        if (!hg) {
            if (IN(pb + 1)) {
                pg8::Gemm g{HN, (const bf16*)(wb + W_IN), M, 4 * D, D, D, D}; pg8::StaticOrder S; S.init(M, 4 * D, F.G, (int)blockIdx.x);
                pg8::EpiRetIn E{ACT, ACT_STRIDE, TAB + TAB_COS / 4, TAB + TAB_SIN / 4, NLP};
                for (int rep = 0; rep < REP_GEMM_IN; ++rep) pg8::gemm_phase<pg8::EpiRetIn, pg8::StaticOrder, GEMM_ALIGN, GEMM_SP2>(F.lds, g, S, E);
            }
            SEAM(pb + 1);
            if (IN(pb + 2)) for (int rep = 0; rep < REP_MIX_RET; ++rep) { if (MIX_RET_V3) mixer_ret3(args, F, j, !last); else if (MIX_MFMA_RET) mixer_mfma<false>(args, F, j, !last); else mixer_phase<false>(args, F, j, !last); if (MXV_RET) mixer_mfma<false, MXV_RET>(args, F, j, !last); }
            SEAM(pb + 2);
            if (IN(pb + 3)) for (int rep = 0; rep < REP_READ; ++rep) readout_phase<false>(args, F, nullptr, Mr);
            SEAM(pb + 3);
        } else {
            if (IN(pb + 1)) {
                pg8::Gemm g{HN, (const bf16*)(wb + W_IN), M, 5 * D, D, D, D}; pg8::StaticOrder S; S.init(M, 5 * D, F.G, (int)blockIdx.x);
                pg8::EpiHgIn E{ACT, ACT_STRIDE, TAB + TAB_LB / 4 + (size_t)j * D};
                for (int rep = 0; rep < REP_GEMM_IN; ++rep) pg8::gemm_phase<pg8::EpiHgIn, pg8::StaticOrder, GEMM_ALIGN, GEMM_SP2>(F.lds, g, S, E);
            }
            SEAM(pb + 1);
            if (IN(pb + 2)) for (int rep = 0; rep < REP_MIX_HG; ++rep) { if (MIX_HG_V2) mixer_hg2(args, F, !last); else if (MIX_MFMA_HG) mixer_mfma<true>(args, F, j, !last); else mixer_phase<true>(args, F, j, !last); if (MXV_HG) mixer_mfma<true, MXV_HG>(args, F, j, !last); }
            SEAM(pb + 2);
            if (IN(pb + 3)) for (int rep = 0; rep < REP_READ; ++rep) readout_phase<true>(args, F, args.in[13] + (size_t)j * D, Mr);
            SEAM(pb + 3);
        }
        if (IN(pb + 4)) {
            pg8::Gemm g{HN, (const bf16*)(wb + W_OUT), ML, D, D, D, D}; pg8::StaticOrder S; S.init(ML, D, F.G, (int)blockIdx.x);
            pg8::EpiResid E{X, layer > 0 ? X : args.in[0], modl + 2 * D, MOD_LD, NLP};
            if (REP_RESID > 1) { pg8::EpiResid E0{X, X, (const float*)(ws + WS_CTL + 512 * 1024), 0, NLP}; pg8::gemm_phase<pg8::EpiResid, pg8::StaticOrder, RESID_ALIGN, GEMM_SP2>(F.lds, g, S, E0); }
            pg8::gemm_phase<pg8::EpiResid, pg8::StaticOrder, RESID_ALIGN, GEMM_SP2>(F.lds, g, S, E);
            if (!last) {
                pg8::Gemm g2{HN, (const bf16*)(wb + W_OUT), M, D, D / 4, D, D}; pg8::SplitKOrder S2{F.G, (int)blockIdx.x, NLP, D / 4};
                pg8::EpiSlab E2{(float*)(ws + WS_SLAB), NLP, D / 4, (size_t)MC * D};
                pg8::gemm_phase<pg8::EpiSlab, pg8::SplitKOrder, true, true>(F.lds, g2, S2, E2);
            }
        }
        SEAM(pb + 4);
        if (IN(pb + 5)) for (int rep = 0; rep < REP_NORM; ++rep) norm_mod_phase(args, F, args.in[7] + (size_t)layer * D, modl, 3 * D, 4 * D, Mr, last ? nullptr : modl + 4 * MOD_LD + 2 * D, X, layer > 0 ? X + (size_t)ML * D : args.in[2]);
        SEAM(pb + 5);
        if (IN(pb + 6)) {
            pg8::Gemm g{HN, (const bf16*)(wb + W_GU), Mr, 2 * FF, D, D, D}; pg8::StaticOrder S; S.init(Mr, 2 * FF, F.G, (int)blockIdx.x, GU_WGM);
            if (KPROBE_GU) { pg8::TwiceOrder S2; S2.init(Mr, 2 * FF, F.G, (int)blockIdx.x); pg8::EpiGateUp E{ACT, FF, 0.5f}; pg8::gemm_phase<pg8::EpiGateUp, pg8::TwiceOrder, true, true>(F.lds, g, S2, E); }
            else { pg8::EpiGateUp E{ACT, FF, 1.0f};
            for (int rep = 0; rep < REP_GU; ++rep) pg8::gemm_phase<pg8::EpiGateUp, pg8::StaticOrder, GEMM_ALIGN, GEMM_SP2>(F.lds, g, S, E); }
        }
        SEAM(pb + 6);
        if (IN(pb + 7)) {
            pg8::Gemm g{ACT, (const bf16*)(wb + W_DN), ML, D, FF, FF, FF}; pg8::StaticOrder S; S.init(ML, D, F.G, (int)blockIdx.x);
            pg8::EpiResid E{X, X, modl + 5 * D, MOD_LD, NLP};
            if (REP_RESID > 1) { pg8::EpiResid E0{X, X, (const float*)(ws + WS_CTL + 512 * 1024), 0, NLP}; pg8::gemm_phase<pg8::EpiResid, pg8::StaticOrder, RESID_ALIGN, GEMM_SP2>(F.lds, g, S, E0); }
            pg8::gemm_phase<pg8::EpiResid, pg8::StaticOrder, RESID_ALIGN, GEMM_SP2>(F.lds, g, S, E);
            if (!last) {
                pg8::Gemm g2{ACT, (const bf16*)(wb + W_DN), M, D, FF / 4, FF, FF}; pg8::SplitKOrder S2{F.G, (int)blockIdx.x, NLP, FF / 4};
                pg8::EpiSlab E2{(float*)(ws + WS_SLAB), NLP, FF / 4, (size_t)MC * D};
                pg8::gemm_phase<pg8::EpiSlab, pg8::SplitKOrder, true, true>(F.lds, g2, S2, E2);
            }
        }
        SEAM(pb + 7);
    }
    if (IN(N_PHASES - 1)) final_norm_phase(args, F);
#undef IN
#undef SEAM
}

extern "C" void kernel_launch(void* const* d_in, const int* in_sizes, int n_in, void* d_out, int out_size, void* d_ws, size_t ws_size, hipStream_t stream) {
    static int grid = 0;
    if (grid == 0) {
        if (n_in != 18 || in_sizes[0] != ML * D || out_size != ML * D || ws_size < WS_END) { fprintf(stderr, "kernel_launch: unexpected shapes (n_in %d, in0 %d, out %d, ws %zu < %zu); nothing launched\n", n_in, n_in > 0 ? in_sizes[0] : -1, out_size, ws_size, (size_t)WS_END); grid = -1; return; }
        int dev = 0, cus = 0, per_cu = 0;
        if (hipGetDevice(&dev) != hipSuccess || hipDeviceGetAttribute(&cus, hipDeviceAttributeMultiprocessorCount, dev) != hipSuccess) { grid = -1; return; }
        if (hipFuncSetAttribute((const void*)fwd_kernel, hipFuncAttributeMaxDynamicSharedMemorySize, LDS_BYTES) != hipSuccess) { fprintf(stderr, "kernel_launch: hipFuncSetAttribute failed\n"); grid = -1; return; }
        if (hipOccupancyMaxActiveBlocksPerMultiprocessor(&per_cu, (const void*)fwd_kernel, NWAVES * 64, LDS_BYTES) != hipSuccess || per_cu < 1) { fprintf(stderr, "kernel_launch: occupancy query says %d blocks per CU\n", per_cu); (void)hipGetLastError(); grid = -1; return; }
        grid = cus;
    }
    if (grid < 0) return;
    if (hipMemsetAsync((char*)d_ws, 0, ZERO_BYTES, stream) != hipSuccess) return;
    Args a{};
    for (int i = 0; i < 18; ++i) a.in[i] = (const float*)d_in[i];
    a.out = (float*)d_out; a.ws = (unsigned char*)d_ws;
    if (MK_N_LAUNCHES == 1) {
        a.ph_lo = 0; a.ph_hi = N_PHASES;
        hipLaunchKernelGGL(fwd_kernel, dim3(grid), dim3(NWAVES * 64), LDS_BYTES, stream, a);
    } else {
        for (int p = 0; p < N_PHASES; ++p) { a.ph_lo = p; a.ph_hi = p + 1; hipLaunchKernelGGL(fwd_kernel, dim3(grid), dim3(NWAVES * 64), LDS_BYTES, stream, a); }
    }
}
```

```cpp
#include <hip/hip_runtime.h>
#include <cstdio>
#include <cstdint>
#ifndef REP_EPI
#define REP_EPI 1
#endif
#ifndef REP_PRO
#define REP_PRO 1
#endif
#ifndef REP_BAR
#define REP_BAR 1
#endif
#ifndef RESID_ATOMIC
#define RESID_ATOMIC 1
#endif
#ifndef REP_RESID
#define REP_RESID 1
#endif
#ifndef MXP_STG
#define MXP_STG 1
#endif
#ifndef MXP_S1
#define MXP_S1 1
#endif
#ifndef MXP_S2
#define MXP_S2 1
#endif
#ifndef MX_PF_HG
#define MX_PF_HG 1
#endif
#ifndef MX_PF_RET
#define MX_PF_RET 1
#endif
#ifndef MXP_SLEEP
#define MXP_SLEEP 0
#endif
#ifndef MXP_BAR
#define MXP_BAR 1
#endif
#ifndef MXV_RET
#define MXV_RET 0
#endif
#ifndef MXV_HG
#define MXV_HG 0
#endif
#ifndef REP_BIAS
#define REP_BIAS 1
#endif
#ifndef KPROBE_GU
#define KPROBE_GU 0
#endif
#ifndef STEAL_TICKS_UNIT
#define STEAL_TICKS_UNIT 4000u
#endif
#ifndef STEAL_TICKS_OUT
#define STEAL_TICKS_OUT 900u
#endif
#ifndef STEAL_TICKS_DOWN
#define STEAL_TICKS_DOWN 2800u
#endif
#ifndef STEAL_BATCH
#define STEAL_BATCH 4
#endif
#ifndef RESID_ALIGN
#define RESID_ALIGN false
#endif
#ifndef GEMM_ALIGN
#define GEMM_ALIGN true
#endif
#ifndef PG8_WGM
#define PG8_WGM 4
#endif
#ifndef GEMM_SP2
#define GEMM_SP2 true
#endif
#ifndef PG8_ROUND_MAJOR
#define PG8_ROUND_MAJOR 1
#endif
#ifndef PRO_NT
#define PRO_NT 1
#endif
#ifndef WT_STORES
#define WT_STORES 0
#endif
#ifndef GU_WGM
#define GU_WGM 8
#endif
#ifndef EW_NT
#define EW_NT 1
#endif
namespace pg8 {
#define PG8_LAS __attribute__((address_space(3)))
typedef unsigned short bf16_t;
typedef short bf16x8 __attribute__((ext_vector_type(8)));
typedef float f32x4 __attribute__((ext_vector_type(4)));
typedef unsigned u32x4 __attribute__((ext_vector_type(4)));
constexpr int BM = 256, BK = 64, HALF = 128, HTB = HALF * BK * 2  , STAGE_BYTES = 8 * HTB, NXCD = 8, WGM = PG8_WGM;

__host__ __device__ __forceinline__ int lds_byte(int r, int c) { const int st = (r >> 4) * 2 + (c >> 5), rr = r & 15, cc = c & 31, ob = rr * 64 + cc * 2; return st * 1024 + (ob ^ (((ob >> 9) & 1) << 5)); }
__host__ __device__ __forceinline__ void stage_rc(int b, int& R, int& C) { const int st = b / 1024, sb = b % 1024, swz = sb ^ (((sb >> 9) & 1) << 5); R = (st >> 1) * 16 + swz / 64; C = (st & 1) * 32 + (swz % 64) / 2; }
__host__ __device__ __forceinline__ int perm32(int rho) { const int n = rho >> 4, i = rho & 15; return 8 * (i >> 2) + 4 * n + (i & 3); }

struct Unit { int pm, pn, k0; };
struct Gemm { const bf16_t* A; const bf16_t* Bt; int M, N, K, lda, ldb; };

struct StaticOrder {
    static constexpr bool KTWICE = false;
    int nM, nN, nwg, G, c, wgm;
    __host__ __device__ void init(int M, int N, int G_, int c_, int wgm_ = WGM) { nM = M / BM; nN = N / BM; nwg = nM * nN; G = G_; c = c_; wgm = wgm_; }
    __host__ __device__ bool next(int i, Unit& u) const {
        const long L = (long)i * G + c; if (!(PG8_ROUND_MAJOR && G % NXCD == 0) && L >= nwg) return false; if ((long)i * G >= nwg) return false;
        int wgid = (int)L;
        if (PG8_ROUND_MAJOR && G % NXCD == 0) { const int per = G / NXCD; wgid = ((i * NXCD) + (c % NXCD)) * per + (c / NXCD); if (wgid >= nwg) return false; }
        else { const int q = nwg / NXCD, r = nwg % NXCD, xcd = wgid % NXCD, off = wgid / NXCD; wgid = (xcd < r ? xcd * (q + 1) : r * (q + 1) + (xcd - r) * q) + off; }
        const int nig = wgm * nN, gid = wgid / nig, fm = gid * wgm, gsz = (nM - fm) < wgm ? (nM - fm) : wgm;
        u.pm = fm + ((wgid % nig) % gsz); u.pn = (wgid % nig) / gsz; u.k0 = 0; return true;
    }
    __device__ __forceinline__ void a_ready(const Unit&) const {}
    __device__ __forceinline__ void done(const Unit&) const {}
};
struct TwiceOrder : StaticOrder {
    static constexpr bool KTWICE = true;
    __host__ __device__ bool next(int i, Unit& u) const { return StaticOrder::next(i >> 1, u); }
};
struct SplitKOrder {
    static constexpr bool KTWICE = false;
    int G, c, pm0, ksub;
    __device__ __forceinline__ bool next(int i, Unit& u) const { const int s = i * G + c; if (s >= 128) return false; const int t = s >> 2; u.pm = pm0 + (t & 3); u.pn = t >> 2; u.k0 = (s & 3) * ksub; return true; }
    __device__ __forceinline__ void a_ready(const Unit&) const {}
    __device__ __forceinline__ void done(const Unit&) const {}
};
__device__ __forceinline__ unsigned cvt_pk_bf16(float lo, float hi) { unsigned r; asm volatile("v_cvt_pk_bf16_f32 %0, %1, %2" : "=v"(r) : "v"(lo), "v"(hi)); return r; }
__device__ __forceinline__ float fast_sigmoid(float x) { return __builtin_amdgcn_rcpf(1.0f + __expf(-x)); }
__device__ __forceinline__ f32x4 silu4(f32x4 v) { f32x4 o; o[0] = v[0] * fast_sigmoid(v[0]); o[1] = v[1] * fast_sigmoid(v[1]); o[2] = v[2] * fast_sigmoid(v[2]); o[3] = v[3] * fast_sigmoid(v[3]); return o; }
__device__ __forceinline__ f32x4 sigm4(f32x4 v) { f32x4 o; o[0] = fast_sigmoid(v[0]); o[1] = fast_sigmoid(v[1]); o[2] = fast_sigmoid(v[2]); o[3] = fast_sigmoid(v[3]); return o; }
template <typename T> __device__ __forceinline__ void st16(T* base, size_t elem_off, u32x4 v) {
#if WT_STORES
    const __amdgpu_buffer_rsrc_t r = __builtin_amdgcn_make_buffer_rsrc(base, 0, 0x7fffffff, 0x00020000);
    __builtin_amdgcn_raw_buffer_store_b128(v, r, (int)(elem_off * sizeof(T)), 0, 16);
#else
    *(u32x4*)(base + elem_off) = v;
#endif
}
__device__ __forceinline__ u32x4 pack8(f32x4 v0, f32x4 v1) { u32x4 w; w.x = cvt_pk_bf16(v0[0], v0[1]); w.y = cvt_pk_bf16(v0[2], v0[3]); w.z = cvt_pk_bf16(v1[0], v1[1]); w.w = cvt_pk_bf16(v1[2], v1[3]); return w; }

struct EpiRetIn {
    static constexpr bool PERM = true, AFTER_DRAIN = false, REP2 = false;
    bf16_t* act; size_t tstride; const float* cosT; const float* sinT; int n_lat_panels;
    __device__ __forceinline__ void store_rows(const f32x4& a0, const f32x4& a1, const f32x4& b0, const f32x4& b1, int type, bf16_t* base, size_t off) const {
        f32x4 x0 = a0, x1 = a1, y0 = b0, y1 = b1;
        if (type == 1) { x0 = x0 * 0.0625f; x1 = x1 * 0.0625f; y0 = y0 * 0.0625f; y1 = y1 * 0.0625f; }
        if (type == 3) { x0 = silu4(x0); x1 = silu4(x1); y0 = silu4(y0); y1 = silu4(y1); }
        st16(base, off, pack8(x0, x1));
        st16(base, off + HALF, pack8(y0, y1));
    }
    __device__ __forceinline__ void operator()(const f32x4 (&acc)[2][2][4][2], const Unit& u, int wr, int wc, int fr, int fq) const {
        const int type = u.pn >> 3, head = u.pn & 7;
        bf16_t* base = act + (size_t)type * tstride; const size_t coff = head * 256 + wc * 32 + 8 * fq;
        const int row0 = u.pm * BM + wr * 64 + fr;
        const bool rope = (type < 2) && (u.pm < n_lat_panels);
        const int fidx = (wc & 1) * 32 + 8 * fq;
        if (!rope) {
#pragma unroll
            for (int ai = 0; ai < 2; ++ai)
#pragma unroll
                for (int m = 0; m < 4; ++m) store_rows(acc[ai][0][m][0], acc[ai][0][m][1], acc[ai][1][m][0], acc[ai][1][m][1], type, base, (size_t)(row0 + ai * HALF + m * 16) * 2048 + coff);
        } else if (wc < 2) {
#pragma unroll
            for (int ai = 0; ai < 2; ++ai) {
                const int pos = (4 * u.pm + 2 * ai + wr) & 63;
                const f32x4 c0 = *(const f32x4*)(cosT + pos * 64 + fidx), c1 = *(const f32x4*)(cosT + pos * 64 + fidx + 4), s0 = *(const f32x4*)(sinT + pos * 64 + fidx), s1 = *(const f32x4*)(sinT + pos * 64 + fidx + 4);
#pragma unroll
                for (int m = 0; m < 4; ++m) { const f32x4 a0 = acc[ai][0][m][0], a1 = acc[ai][0][m][1], b0 = acc[ai][1][m][0], b1 = acc[ai][1][m][1];
                    store_rows(a0 * c0 - b0 * s0, a1 * c1 - b1 * s1, a0 * s0 + b0 * c0, a1 * s1 + b1 * c1, type, base, (size_t)(row0 + ai * HALF + m * 16) * 2048 + coff); }
            }
        } else {
#pragma unroll
            for (int m = 0; m < 4; ++m) {
                const int pos = 16 * m + fr;
                const f32x4 c0 = *(const f32x4*)(cosT + pos * 64 + fidx), c1 = *(const f32x4*)(cosT + pos * 64 + fidx + 4), s0 = *(const f32x4*)(sinT + pos * 64 + fidx), s1 = *(const f32x4*)(sinT + pos * 64 + fidx + 4);
#pragma unroll
                for (int ai = 0; ai < 2; ++ai) { const f32x4 a0 = acc[ai][0][m][0], a1 = acc[ai][0][m][1], b0 = acc[ai][1][m][0], b1 = acc[ai][1][m][1];
                    store_rows(a0 * c0 - b0 * s0, a1 * c1 - b1 * s1, a0 * s0 + b0 * c0, a1 * s1 + b1 * c1, type, base, (size_t)(row0 + ai * HALF + m * 16) * 2048 + coff); }
            }
        }
    }
};

struct EpiHgIn {
    static constexpr bool PERM = true, AFTER_DRAIN = false, REP2 = false;
    bf16_t* act; size_t tstride; const float* lb;
    __device__ __forceinline__ void operator()(const f32x4 (&acc)[2][2][4][2], const Unit& u, int wr, int wc, int fr, int fq) const {
        const int type = u.pn >> 3, cb = (u.pn & 7) * 256 + wc * 32 + 8 * fq;
        const int row0 = u.pm * BM + wr * 64 + fr;
        const int slot = (type == 0) ? 0 : (type == 1) ? 1 : (type == 2) ? 3 : (type == 3) ? 5 : 6;
        bf16_t* base = act + (size_t)slot * tstride;
        f32x4 lbv[2][2];
#pragma unroll
        for (int bj = 0; bj < 2; ++bj)
#pragma unroll
            for (int n = 0; n < 2; ++n) lbv[bj][n] = (type == 1 || type == 2) ? *(const f32x4*)(lb + cb + bj * HALF + 4 * n) : (f32x4){0.f, 0.f, 0.f, 0.f};
#pragma unroll
        for (int ai = 0; ai < 2; ++ai)
#pragma unroll
            for (int m = 0; m < 4; ++m) {
                const int r = row0 + ai * HALF + m * 16;
                const size_t roff = (size_t)r * 2048 + cb;
#pragma unroll
                for (int bj = 0; bj < 2; ++bj) {
                    f32x4 v0 = acc[ai][bj][m][0], v1 = acc[ai][bj][m][1];
                    if (type == 0) { v0 = silu4(v0); v1 = silu4(v1); }
                    if (type == 4) { v0 = sigm4(v0); v1 = sigm4(v1); }
                    if (type == 1 || type == 2) {
                        f32x4 k0, k1;
#pragma unroll
                        for (int j = 0; j < 4; ++j) {
                            { const float z = fminf(fmaxf(v0[j], -80.f), 80.f), e = __expf(-z), sg = __builtin_amdgcn_rcpf(1.0f + e), l = lbv[bj][0][j];
                              v0[j] = __logf(l + (1.0f - l) * sg); k0[j] = (1.0f - l) * (e * sg); }
                            { const float z = fminf(fmaxf(v1[j], -80.f), 80.f), e = __expf(-z), sg = __builtin_amdgcn_rcpf(1.0f + e), l = lbv[bj][1][j];
                              v1[j] = __logf(l + (1.0f - l) * sg); k1[j] = (1.0f - l) * (e * sg); }
                        }
                        st16(base + tstride, roff + bj * HALF, pack8(k0, k1));
                    }
                    st16(base, roff + bj * HALF, pack8(v0, v1));
                }
            }
    }
};

struct EpiResid {
    static constexpr bool PERM = false, AFTER_DRAIN = false, REP2 = false;
    float* X; const float* Xin; const float* gate; int gstride; int n_lat_panels;
    __device__ __forceinline__ void operator()(const f32x4 (&acc)[2][2][4][2], const Unit& u, int wr, int wc, int fr, int fq) const {
        const int row0 = u.pm * BM + wr * 64 + fr, col0 = u.pn * BM + wc * 32 + 4 * fq;
        const int b = (u.pm < n_lat_panels) ? (u.pm >> 4) : 4;
        const float* g = gate + (size_t)b * gstride + col0;
        float* xb = X + (size_t)row0 * 2048 + col0; const float* xi = Xin + (size_t)row0 * 2048 + col0;
        f32x4 gv[2][2];
#pragma unroll
        for (int bj = 0; bj < 2; ++bj)
#pragma unroll
            for (int n = 0; n < 2; ++n) gv[bj][n] = *(const f32x4*)(g + bj * HALF + n * 16);
        f32x4 xa[2][2][2], xc[2][2][2];
#define ER_LOAD(dst, ai, mp) do { _Pragma("unroll") for (int mm = 0; mm < 2; ++mm) _Pragma("unroll") for (int bj = 0; bj < 2; ++bj) _Pragma("unroll") for (int n = 0; n < 2; ++n) \
            dst[mm][bj][n] = *(const f32x4*)(xi + (size_t)((ai) * HALF + (2 * (mp) + mm) * 16) * 2048 + bj * HALF + n * 16); } while (0)
#define ER_STORE(src, ai, mp) do { _Pragma("unroll") for (int mm = 0; mm < 2; ++mm) _Pragma("unroll") for (int bj = 0; bj < 2; ++bj) _Pragma("unroll") for (int n = 0; n < 2; ++n) \
            *(f32x4*)(xb + (size_t)((ai) * HALF + (2 * (mp) + mm) * 16) * 2048 + bj * HALF + n * 16) = src[mm][bj][n] + gv[bj][n] * acc[ai][bj][2 * (mp) + mm][n]; } while (0)
        ER_LOAD(xa, 0, 0); ER_LOAD(xc, 0, 1);
        ER_STORE(xa, 0, 0); ER_LOAD(xa, 1, 0);
        ER_STORE(xc, 0, 1); ER_LOAD(xc, 1, 1);
        ER_STORE(xa, 1, 0); ER_STORE(xc, 1, 1);
#undef ER_LOAD
#undef ER_STORE
    }
};

struct EpiGateUp {
    static constexpr bool PERM = true, AFTER_DRAIN = false, REP2 = true;
    bf16_t* H; int ldh; float pre;
    __device__ __forceinline__ void operator()(const f32x4 (&acc)[2][2][4][2], const Unit& u, int wr, int wc, int fr, int fq) const {
        const int row0 = u.pm * BM + wr * 64 + fr, col0 = u.pn * HALF + wc * 32 + 8 * fq;
#pragma unroll
        for (int ai = 0; ai < 2; ++ai)
#pragma unroll
            for (int m = 0; m < 4; ++m) {
                const f32x4 h0 = silu4(acc[ai][0][m][0] * pre) * (acc[ai][1][m][0] * pre), h1 = silu4(acc[ai][0][m][1] * pre) * (acc[ai][1][m][1] * pre);
                st16(H, (size_t)(row0 + ai * HALF + m * 16) * ldh + col0, pack8(h0, h1));
            }
    }
};


struct EpiSlab {
    static constexpr bool PERM = false, AFTER_DRAIN = false, REP2 = false;
    float* slab; int pm0, ksub; size_t kstride;
    __device__ __forceinline__ void operator()(const f32x4 (&acc)[2][2][4][2], const Unit& u, int wr, int wc, int fr, int fq) const {
        float* base = slab + (size_t)(u.k0 / ksub) * kstride + (size_t)((u.pm - pm0) * BM + wr * 64 + fr) * 2048 + u.pn * BM + wc * 32 + 4 * fq;
#pragma unroll
        for (int ai = 0; ai < 2; ++ai)
#pragma unroll
            for (int m = 0; m < 4; ++m) { float* rowp = base + (size_t)(ai * HALF + m * 16) * 2048;
#pragma unroll
                for (int bj = 0; bj < 2; ++bj)
#pragma unroll
                    for (int n = 0; n < 2; ++n) *(f32x4*)(rowp + bj * HALF + n * 16) = acc[ai][bj][m][n]; }
    }
};
template <class Epi, class Sched, bool ALIGN_EPI = false, bool SP2 = false>
__device__ __forceinline__ void gemm_phase(PG8_LAS unsigned char* lds, const Gemm g, const Sched& S, const Epi& E) {
    int tid_ = threadIdx.x; asm volatile("" : "+v"(tid_));
    const int tid = tid_, wid = __builtin_amdgcn_readfirstlane(tid >> 6), lane = tid & 63, wr = wid >> 2, wc = wid & 3, fr = lane & 15, fq = lane >> 4;
    const int K = g.K, nt = K / BK;
    unsigned voffA[2], voffB[2];
#pragma unroll
    for (int i = 0; i < 2; ++i) { int R, C; stage_rc(tid * 16 + i * 8192, R, C); const int Rb = Epi::PERM ? ((R & ~31) + perm32(R & 31)) : R;
        voffA[i] = (unsigned)(R * g.lda + C) * 2u; voffB[i] = (unsigned)(Rb * g.ldb + C) * 2u; }
    const size_t kstep = (size_t)(BK * 2);
    const size_t hsA = (size_t)HALF * g.lda * 2, hsB = (size_t)HALF * g.ldb * 2;
    const size_t tsA = 2 * hsA, tsB = 2 * hsB;
    const unsigned ldsw = (unsigned)wid * 1024u;
    const int aoff = lds_byte(wr * 64 + fr, fq * 8), boff = lds_byte(wc * 32 + fr, fq * 8);
#define PG8_SA(b, h) (((b) * 2 + (h)) * HTB)
#define PG8_SB(b, h) ((4 + (b) * 2 + (h)) * HTB)
#define PG8_STAGE(bufoff, gbase, voff) do { _Pragma("unroll") for (int _i = 0; _i < 2; ++_i) \
        __builtin_amdgcn_global_load_lds((const unsigned*)((const char*)(gbase) + (voff)[_i]), (PG8_LAS unsigned*)(lds + (bufoff) + ldsw + _i * 8192), 16, 0, 0); } while (0)
#define PG8_LDA(dst, b, h) do { _Pragma("unroll") for (int m = 0; m < 4; ++m) _Pragma("unroll") for (int k = 0; k < 2; ++k) dst[m][k] = *(const PG8_LAS bf16x8*)(lds + PG8_SA(b, h) + aoff + m * 2048 + k * 1024); } while (0)
#define PG8_LDB(dst, b, h) do { _Pragma("unroll") for (int n = 0; n < 2; ++n) _Pragma("unroll") for (int k = 0; k < 2; ++k) dst[n][k] = *(const PG8_LAS bf16x8*)(lds + PG8_SB(b, h) + boff + n * 2048 + k * 1024); } while (0)
#define PG8_MMA(ai, bj, At, Bt) do { __builtin_amdgcn_s_setprio(1); _Pragma("unroll") for (int m = 0; m < 4; ++m) _Pragma("unroll") for (int n = 0; n < 2; ++n) _Pragma("unroll") for (int k = 0; k < 2; ++k) \
        acc[ai][bj][m][n] = __builtin_amdgcn_mfma_f32_16x16x32_bf16(Bt[n][k], At[m][k], acc[ai][bj][m][n], 0, 0, 0); __builtin_amdgcn_s_setprio(0); } while (0)
#define PG8_WAIT_V(n) asm volatile("s_waitcnt vmcnt(" #n ")" ::: "memory")
#define PG8_WAIT_L(n) asm volatile("s_waitcnt lgkmcnt(" #n ")" ::: "memory")
#define PG8_BAR __builtin_amdgcn_s_barrier()
#define PG8_SCHED __builtin_amdgcn_sched_barrier(0)
    Unit cur, nxt; int ui = 0;
    if (!S.next(0, cur)) return;
    f32x4 acc[2][2][4][2];
#pragma unroll
    for (int a = 0; a < 2; ++a)
#pragma unroll
        for (int b = 0; b < 2; ++b)
#pragma unroll
            for (int m = 0; m < 4; ++m)
#pragma unroll
                for (int n = 0; n < 2; ++n) acc[a][b][m][n] = (f32x4){0.f, 0.f, 0.f, 0.f};
    bf16x8 At[4][2], B0[2][2], B1[2][2];
    const char* cA = (const char*)g.A + (size_t)cur.pm * tsA + (size_t)cur.k0 * 2; const char* cB = (const char*)g.Bt + (size_t)cur.pn * tsB + (size_t)cur.k0 * 2;
    S.a_ready(cur);
    if constexpr (SP2) {
        PG8_STAGE(PG8_SB(0, 0), cB, voffB); PG8_STAGE(PG8_SB(0, 1), cB + hsB, voffB); PG8_STAGE(PG8_SA(0, 0), cA, voffA); PG8_STAGE(PG8_SA(0, 1), cA + hsA, voffA);
        if (wr == 1) PG8_BAR;
        PG8_WAIT_V(2); PG8_BAR;
        PG8_STAGE(PG8_SB(1, 0), cB + kstep, voffB); PG8_STAGE(PG8_SA(1, 0), cA + kstep, voffA); PG8_STAGE(PG8_SB(1, 1), cB + hsB + kstep, voffB);
        PG8_WAIT_V(6); PG8_BAR;
    } else {
        PG8_STAGE(PG8_SB(0, 0), cB, voffB); PG8_STAGE(PG8_SA(0, 0), cA, voffA); PG8_STAGE(PG8_SB(0, 1), cB + hsB, voffB); PG8_STAGE(PG8_SA(0, 1), cA + hsA, voffA);
        if (wr == 1) PG8_BAR;
        PG8_WAIT_V(4); PG8_BAR;
        PG8_STAGE(PG8_SB(1, 0), cB + kstep, voffB); PG8_STAGE(PG8_SA(1, 0), cA + kstep, voffA); PG8_STAGE(PG8_SB(1, 1), cB + hsB + kstep, voffB);
        PG8_WAIT_V(6); PG8_BAR;
    }
    for (;;) {
        const bool has_next = S.next(ui + 1, nxt);
        const char* nA = has_next ? (const char*)g.A + (size_t)nxt.pm * tsA + (size_t)nxt.k0 * 2 : cA; const char* nB = has_next ? (const char*)g.Bt + (size_t)nxt.pn * tsB + (size_t)nxt.k0 * 2 : cB;
        for (int t = 0; t < nt; t += 2) {
            const bool last = (t == nt - 2);
            const char* a1 = cA + (size_t)(t + 1) * kstep;
            const char* a2 = last ? nA : cA + (size_t)(t + 2) * kstep; const char* b2 = last ? nB : cB + (size_t)(t + 2) * kstep;
            const char* a3 = a2 + kstep; const char* b3 = b2 + kstep;
            if (last && has_next) S.a_ready(nxt);
            if constexpr (SP2) {
            PG8_LDB(B0, 0, 0); PG8_LDB(B1, 0, 1); PG8_SCHED; PG8_LDA(At, 0, 0); PG8_STAGE(PG8_SA(1, 1), a1 + hsA, voffA);
            PG8_WAIT_V(8); PG8_WAIT_L(0); PG8_BAR; PG8_MMA(0, 0, At, B0); PG8_MMA(0, 1, At, B1); PG8_BAR; PG8_SCHED;
            PG8_LDA(At, 0, 1); PG8_STAGE(PG8_SB(0, 0), b2, voffB); PG8_STAGE(PG8_SB(0, 1), b2 + hsB, voffB); PG8_STAGE(PG8_SA(0, 0), a2, voffA);
            PG8_WAIT_V(8); PG8_WAIT_L(0); PG8_BAR; PG8_MMA(1, 0, At, B0); PG8_MMA(1, 1, At, B1); PG8_BAR; PG8_SCHED;
            PG8_LDB(B0, 1, 0); PG8_LDB(B1, 1, 1); PG8_SCHED; PG8_LDA(At, 1, 0); PG8_STAGE(PG8_SA(0, 1), a2 + hsA, voffA);
            PG8_WAIT_V(8); PG8_WAIT_L(0); PG8_BAR; PG8_MMA(0, 0, At, B0); PG8_MMA(0, 1, At, B1); PG8_BAR; PG8_SCHED;
            PG8_LDA(At, 1, 1); PG8_STAGE(PG8_SB(1, 0), b3, voffB); PG8_STAGE(PG8_SB(1, 1), b3 + hsB, voffB); PG8_STAGE(PG8_SA(1, 0), a3, voffA);
            PG8_WAIT_V(8); PG8_WAIT_L(0); PG8_BAR; PG8_MMA(1, 0, At, B0); PG8_MMA(1, 1, At, B1); PG8_BAR; PG8_SCHED;
            } else {
            PG8_LDB(B0, 0, 0); PG8_SCHED; PG8_LDA(At, 0, 0); PG8_STAGE(PG8_SA(1, 1), a1 + hsA, voffA);
            PG8_WAIT_L(8); PG8_BAR; PG8_WAIT_L(0); PG8_MMA(0, 0, At, B0); PG8_BAR; PG8_SCHED;
            PG8_LDB(B1, 0, 1); PG8_STAGE(PG8_SB(0, 0), b2, voffB);
            PG8_BAR; PG8_WAIT_L(0); PG8_MMA(0, 1, At, B1); PG8_BAR;
            PG8_LDA(At, 0, 1); PG8_STAGE(PG8_SA(0, 0), a2, voffA);
            PG8_BAR; PG8_WAIT_L(0); PG8_MMA(1, 0, At, B0); PG8_BAR; PG8_SCHED;
            PG8_STAGE(PG8_SB(0, 1), b2 + hsB, voffB);
            PG8_WAIT_V(6); PG8_BAR; PG8_MMA(1, 1, At, B1); PG8_BAR;
            PG8_LDB(B0, 1, 0); PG8_SCHED; PG8_LDA(At, 1, 0); PG8_STAGE(PG8_SA(0, 1), a2 + hsA, voffA);
            PG8_WAIT_L(8); PG8_BAR; PG8_WAIT_L(0); PG8_MMA(0, 0, At, B0); PG8_BAR; PG8_SCHED;
            PG8_LDB(B1, 1, 1); PG8_STAGE(PG8_SB(1, 0), b3, voffB);
            PG8_BAR; PG8_WAIT_L(0); PG8_MMA(0, 1, At, B1); PG8_BAR;
            PG8_LDA(At, 1, 1); PG8_STAGE(PG8_SA(1, 0), a3, voffA);
            PG8_BAR; PG8_WAIT_L(0); PG8_MMA(1, 0, At, B0); PG8_BAR; PG8_SCHED;
            PG8_STAGE(PG8_SB(1, 1), b3 + hsB, voffB);
            PG8_WAIT_V(6); PG8_BAR; PG8_MMA(1, 1, At, B1); PG8_BAR;
            }
        }
        const bool kp_first = Sched::KTWICE && ((ui & 1) == 0);
        if constexpr (ALIGN_EPI) { if (wr == 0) PG8_BAR; }
        if (!kp_first) if constexpr (!Epi::AFTER_DRAIN) { E(acc, cur, wr, wc, fr, fq); if constexpr (REP_EPI > 1 && Epi::REP2) { asm volatile("" ::: "memory"); E(acc, cur, wr, wc, fr, fq); } S.done(cur); }
        if (!has_next) break;
        if (!kp_first)
#pragma unroll
        for (int a = 0; a < 2; ++a)
#pragma unroll
            for (int b = 0; b < 2; ++b)
#pragma unroll
                for (int m = 0; m < 4; ++m)
#pragma unroll
                    for (int n = 0; n < 2; ++n) acc[a][b][m][n] = (f32x4){0.f, 0.f, 0.f, 0.f};
        cur = nxt; cA = nA; cB = nB; ++ui;
        if constexpr (ALIGN_EPI) { if (wr == 1) PG8_BAR; }
    }
    PG8_WAIT_V(0);
    if constexpr (!ALIGN_EPI) { if (wr == 0) PG8_BAR; }
    PG8_BAR;
    if constexpr (Epi::AFTER_DRAIN) { E.fused(acc, cur, wr, wc, fr, fq, lds, wid, lane); S.done(cur); }
#undef PG8_SA
#undef PG8_SB
#undef PG8_STAGE
#undef PG8_LDA
#undef PG8_LDB
#undef PG8_MMA
#undef PG8_WAIT_V
#undef PG8_WAIT_L
#undef PG8_BAR
#undef PG8_SCHED
}
}

#ifndef MK_N_LAUNCHES
#define MK_N_LAUNCHES 1
#endif
constexpr int NWAVES = 8;
constexpr int D = 2048, BATCH = 4, SEQ = 4096, CTXL = 256, DEPTH = 4, FF = 5632;
constexpr int ML = BATCH * SEQ, MC = BATCH * CTXL, M = ML + MC;
constexpr int NLP = ML / 256;
constexpr int MOD_LD = 6 * D;
constexpr float EPS = 1e-6f;
constexpr int N_PHASES = 2 + 8 * DEPTH;

constexpr size_t MiB = 1u << 20;
constexpr size_t WS_CTL = 0, WS_MOD = 1 * MiB, ZERO_BYTES = 2 * MiB;
constexpr size_t WS_TAB = 2 * MiB;
constexpr size_t TAB_COS = 0, TAB_SIN = 16384, TAB_LB = 32768;
constexpr size_t WS_X = 4 * MiB;
constexpr size_t WS_HN = 140 * MiB;
constexpr size_t WS_ACT = 208 * MiB;
constexpr size_t ACT_STRIDE = (size_t)M * D;
constexpr size_t WS_OF = 684 * MiB, WS_OB = 820 * MiB;
constexpr size_t WS_W = 956 * MiB, W_LAYER = 114 * MiB;
constexpr size_t W_IN = 0, W_OUT = 40 * MiB, W_GU = 48 * MiB, W_DN = 92 * MiB;
constexpr size_t WS_SLAB = WS_W + 4 * W_LAYER;
constexpr size_t WS_END = WS_SLAB + 32 * MiB;
constexpr int CW_BAR = 4096;

constexpr int RING_BYTES = 131072;
constexpr int LDSCTL_OFF = RING_BYTES, MISC_OFF = LDSCTL_OFF + 320;
constexpr int LDS_BYTES = 147456;

#define GAS __attribute__((address_space(1)))
#define LAS __attribute__((address_space(3)))
typedef unsigned short bf16;
typedef unsigned v4u __attribute__((ext_vector_type(4)));
typedef unsigned v2u __attribute__((ext_vector_type(2)));
typedef float f32x4 __attribute__((ext_vector_type(4)));
typedef GAS unsigned gu32;
#define LDS_WAIT() asm volatile("s_waitcnt lgkmcnt(0)" ::: "memory")
__device__ __forceinline__ unsigned f2bf(float f) { unsigned u = __builtin_bit_cast(unsigned, f); return (u + 0x7fffu + ((u >> 16) & 1u)) >> 16; }
typedef float f32x2_t __attribute__((ext_vector_type(2)));
typedef __bf16 bf16x2_t __attribute__((ext_vector_type(2)));
__device__ __forceinline__ unsigned pk2(float lo, float hi) { const f32x2_t v = {lo, hi}; const bf16x2_t b = __builtin_convertvector(v, bf16x2_t); return __builtin_bit_cast(unsigned, b); }
__device__ __forceinline__ float bflo(unsigned w) { return __builtin_bit_cast(float, w << 16); }
__device__ __forceinline__ float bfhi(unsigned w) { return __builtin_bit_cast(float, w & 0xffff0000u); }
template <int CTRL> __device__ __forceinline__ float dpp_mov(float v) { return __builtin_bit_cast(float, __builtin_amdgcn_update_dpp(0, __builtin_bit_cast(int, v), CTRL, 0xF, 0xF, true)); }
__device__ __forceinline__ float wave_sum(float v) {
    v += dpp_mov<0xB1>(v);
    v += dpp_mov<0x4E>(v);
    v += dpp_mov<0x141>(v);
    v += dpp_mov<0x140>(v);
    const int iv = __builtin_bit_cast(int, v);
    const float a = __builtin_bit_cast(float, __builtin_amdgcn_readlane(iv, 0)), b = __builtin_bit_cast(float, __builtin_amdgcn_readlane(iv, 16));
    const float c = __builtin_bit_cast(float, __builtin_amdgcn_readlane(iv, 32)), d = __builtin_bit_cast(float, __builtin_amdgcn_readlane(iv, 48));
    return (a + b) + (c + d);
}
#define XB_TMO      128
#define XB_XCNT(j)  (256  + 64 * (j))
#define XB_XSUB(j)  (1280 + 64 * (j))
#define XB_XGEN(j)  (2304 + 64 * (j))
#define XB_TOP      3328
#define XB_TOPGEN   3392
#define XCD_BAR_WORDS 3456
#define XB_SPIN_CAP (1u << 18)

__device__ __forceinline__ unsigned xb_ld(unsigned* p)              { return __hip_atomic_load(p, __ATOMIC_RELAXED, __HIP_MEMORY_SCOPE_AGENT); }
__device__ __forceinline__ unsigned xb_add(unsigned* p, unsigned v) { return __hip_atomic_fetch_add(p, v, __ATOMIC_RELAXED, __HIP_MEMORY_SCOPE_AGENT); }
__device__ __forceinline__ unsigned xb_xcc_id() { return (unsigned)__builtin_amdgcn_s_getreg((3 << 11) | 20) & 0xFu; }
#define XB_SPIN(cond, bar) do { unsigned _sp = 0; while (cond) { __builtin_amdgcn_s_sleep(1); \
    if ((++_sp & 255u) == 0u) { if (xb_ld(&(bar)[XB_TMO])) break; if (_sp > XB_SPIN_CAP) { atomicAdd(&(bar)[XB_TMO], 1u); break; } } } } while (0)

struct XcdBarrier {
    unsigned* bar; unsigned x;
    volatile LAS unsigned* st;
};

__device__ __forceinline__ XcdBarrier xcd_barrier_post(unsigned* bar, volatile LAS unsigned* st) {
    XcdBarrier b; b.bar = bar; b.x = xb_xcc_id(); b.st = st;
    if (threadIdx.x == 0) (void)xb_add(&bar[XB_XCNT(b.x)], 1u);
    return b;
}
__device__ __forceinline__ void xcd_barrier_complete(unsigned* bar, unsigned x, unsigned& nloc, unsigned& nx) {
    const unsigned G = gridDim.x * gridDim.y * gridDim.z;
    unsigned sum, cnt, mine, sp = 0u;
    for (;;) {
        sum = 0u; cnt = 0u; mine = 0u;
#pragma unroll
        for (unsigned j = 0; j < 16; ++j) { const unsigned c = xb_ld(&bar[XB_XCNT(j)]); sum += c; cnt += (c > 0u) ? 1u : 0u; mine = (j == x) ? c : mine; }
        if (sum == G) break;
        __builtin_amdgcn_s_sleep(1);
        if ((++sp & 255u) == 0u) { if (xb_ld(&bar[XB_TMO])) break; if (sp > XB_SPIN_CAP) { atomicAdd(&bar[XB_TMO], 1u); break; } }
    }
    nloc = mine > 0u ? mine : 1u; nx = cnt > 0u ? cnt : 1u;
}

__device__ __forceinline__ void xcd_barrier(const XcdBarrier& b) {
    asm volatile("s_waitcnt vmcnt(0)" ::: "memory");
    __syncthreads();
    if (threadIdx.x == 0) {
        unsigned* bar = b.bar;
        __builtin_amdgcn_s_waitcnt(0);
        unsigned nloc = b.st[0], nx = b.st[1];
        if (nloc == 0u) { xcd_barrier_complete(bar, b.x, nloc, nx); b.st[0] = nloc; b.st[1] = nx; }
        const unsigned old = xb_add(&bar[XB_XSUB(b.x)], 1u);
        const unsigned gen = old / nloc;
        if (old + 1u == (gen + 1u) * nloc) {
            __builtin_amdgcn_fence(__ATOMIC_RELEASE, "agent");
            asm volatile("s_waitcnt vmcnt(0)" ::: "memory");
            const unsigned og = xb_add(&bar[XB_TOP], 1u);
            const unsigned tg = og / nx;
            if (og + 1u == (tg + 1u) * nx) xb_add(&bar[XB_TOPGEN], 1u);
            else XB_SPIN(xb_ld(&bar[XB_TOPGEN]) == tg, bar);
            __builtin_amdgcn_fence(__ATOMIC_ACQUIRE, "agent");
            xb_add(&bar[XB_XGEN(b.x)], 1u);
            asm volatile("s_waitcnt vmcnt(0)" ::: "memory");
        } else {
            XB_SPIN(xb_ld(&bar[XB_XGEN(b.x)]) == gen, bar);
            __builtin_amdgcn_fence(__ATOMIC_ACQUIRE, "agent");
            asm volatile("s_waitcnt vmcnt(0)" ::: "memory");
        }
    }
    __syncthreads();
}

struct Args { const float* in[18]; float* out; unsigned char* ws; int ph_lo, ph_hi; };
struct Frame {
    LAS unsigned char* lds;
    gu32* ctl;
    int tid, lane, wave, vcu, G;
};
__device__ __forceinline__ void relaunder(Frame& F) { int t = threadIdx.x; asm volatile("" : "+v"(t)); F.tid = t; F.lane = t & 63; F.wave = __builtin_amdgcn_readfirstlane(t >> 6); }

__device__ __forceinline__ void p0_transpose_item(const float* W, int K, int N, bf16* WT, int dst_row0, LAS float* scr, int k0, int n0, int lane) {
#pragma unroll 8
    for (int i = 0; i < 32; ++i) { const int kk = 2 * i + (lane >> 5); scr[kk * 33 + (lane & 31)] = PRO_NT ? __builtin_nontemporal_load(W + (size_t)(k0 + kk) * N + n0 + (lane & 31)) : W[(size_t)(k0 + kk) * N + n0 + (lane & 31)]; }
    LDS_WAIT(); asm volatile("" ::: "memory");
    const int c = lane & 7;
#pragma unroll
    for (int j = 0; j < 4; ++j) { const int n = (lane >> 3) + 8 * j; const LAS float* s = scr + (8 * c) * 33 + n;
        v4u o; o.x = pk2(s[0 * 33], s[1 * 33]); o.y = pk2(s[2 * 33], s[3 * 33]); o.z = pk2(s[4 * 33], s[5 * 33]); o.w = pk2(s[6 * 33], s[7 * 33]);
        *(GAS v4u*)(WT + (size_t)(dst_row0 + n) * K + k0 + 8 * c) = o; }
    LDS_WAIT(); asm volatile("" ::: "memory");
}
__device__ __forceinline__ bool p0_matrix(int& it, const float* W, int K, int N, bf16* WT, bool gu, LAS float* scr, int lane) {
    const int nblk = N / 32, items = (K / 64) * nblk;
    if (it >= items) { it -= items; return false; }
    const int kb = it / nblk, nb = it % nblk, n0 = 32 * nb;
    int dst = n0;
    if (gu) { const int half = n0 / FF, w = n0 % FF; dst = (w / 128) * 256 + half * 128 + (w % 128); }
    p0_transpose_item(W, K, N, WT, dst, scr, 64 * kb, n0, lane);
    return true;
}
__device__ __forceinline__ void sincos_pos(float x, float& s, float& c) {
    const float n = rintf(x * 0.63661977236758f);
    float r = fmaf(n, -1.5707962512969971f, x); r = fmaf(n, -7.5497894158615964e-08f, r);
    const float r2 = r * r;
    const float sp = r + r * r2 * (-1.6666667e-1f + r2 * (8.3333333e-3f + r2 * (-1.9841270e-4f + r2 * 2.7557319e-6f)));
    const float cp = 1.0f + r2 * (-0.5f + r2 * (4.1666667e-2f + r2 * (-1.3888889e-3f + r2 * (2.4801587e-5f + r2 * -2.7557319e-7f))));
    const int q = ((int)n) & 3;
    s = (q == 0) ? sp : (q == 1) ? cp : (q == 2) ? -sp : -cp;
    c = (q == 0) ? cp : (q == 1) ? -sp : (q == 2) ? -cp : sp;
}
__device__ __forceinline__ void p0_prologue(const Args& a, Frame& F) {
    relaunder(F);
    LAS float* scr = (LAS float*)(F.lds + F.wave * 9216);
    LAS float* act = (LAS float*)(F.lds + 73728);
    for (int i = F.tid; i < 5 * D; i += NWAVES * 64) { const float v = (i < 4 * D) ? a.in[1][i] : a.in[3][i - 4 * D]; act[i] = v / (1.f + __expf(-v)); }
    __syncthreads();
    const int gw = F.vcu * NWAVES + F.wave, NGW = F.G * NWAVES;
    for (int t = gw; t < DEPTH * 48 * 32; t += NGW) {
        const int layer = t / (48 * 32), rem = t % (48 * 32), cb = rem >> 5, ks = rem & 31;
        const int col = cb * 256 + F.lane * 4;
        const float* wp = a.in[4] + ((size_t)layer * D + ks * 64) * MOD_LD + col;
        f32x4 acc0 = {0.f, 0.f, 0.f, 0.f}, acc1 = acc0, acc2 = acc0, acc3 = acc0, acc4 = acc0;
        for (int kk = 0; kk < 64; kk += 8) {
            f32x4 w[8];
#pragma unroll
            for (int u = 0; u < 8; ++u) w[u] = PRO_NT ? __builtin_nontemporal_load((const GAS f32x4*)(wp + (size_t)(kk + u) * MOD_LD)) : *(const GAS f32x4*)(wp + (size_t)(kk + u) * MOD_LD);
#pragma unroll
            for (int u = 0; u < 8; ++u) { const int k = ks * 64 + kk + u;
                acc0 += act[k] * w[u]; acc1 += act[D + k] * w[u]; acc2 += act[2 * D + k] * w[u]; acc3 += act[3 * D + k] * w[u]; acc4 += act[4 * D + k] * w[u]; }
        }
        if (ks == 0) { const f32x4 bv = *(const GAS f32x4*)(a.in[5] + (size_t)layer * MOD_LD + col); acc0 += bv; acc1 += bv; acc2 += bv; acc3 += bv; acc4 += bv; }
        float* mp = (float*)(a.ws + WS_MOD) + (size_t)layer * 5 * MOD_LD + col;
#pragma unroll
        for (int j = 0; j < 4; ++j) {
            __hip_atomic_fetch_add(mp + j, acc0[j], __ATOMIC_RELAXED, __HIP_MEMORY_SCOPE_AGENT);
            __hip_atomic_fetch_add(mp + MOD_LD + j, acc1[j], __ATOMIC_RELAXED, __HIP_MEMORY_SCOPE_AGENT);
            __hip_atomic_fetch_add(mp + 2 * MOD_LD + j, acc2[j], __ATOMIC_RELAXED, __HIP_MEMORY_SCOPE_AGENT);
            __hip_atomic_fetch_add(mp + 3 * MOD_LD + j, acc3[j], __ATOMIC_RELAXED, __HIP_MEMORY_SCOPE_AGENT);
            __hip_atomic_fetch_add(mp + 4 * MOD_LD + j, acc4[j], __ATOMIC_RELAXED, __HIP_MEMORY_SCOPE_AGENT);
        }
    }
    {
        const int gt = (F.vcu * NWAVES + F.wave) * 64 + F.lane;
        float* tab = (float*)(a.ws + WS_TAB);
        if (gt < 4096) { const int pos = gt >> 6, f = gt & 63; const float inv = expf(-(float)f * (9.210340371976184f / 64.0f)); float s, c; sincos_pos((float)pos * inv, s, c);
            tab[TAB_COS / 4 + gt] = c; tab[TAB_SIN / 4 + gt] = s; }
        else if (gt < 4096 + D) { const int ch = gt - 4096; const float b0 = a.in[14][ch], b1 = a.in[14][D + ch], mx = fmaxf(b0, b1), e0 = __expf(b0 - mx), e1 = __expf(b1 - mx), p0 = e0 / (e0 + e1), p1 = e1 / (e0 + e1);
            tab[TAB_LB / 4 + ch] = p0 - p0; tab[TAB_LB / 4 + D + ch] = (p0 + p1) - p0; }
    }
    for (int rep_ = 0; rep_ < REP_PRO; ++rep_) {
    constexpr int I_RET = 32 * 256 + 32 * 64 + 32 * 352 + 88 * 64, I_HG = 32 * 320 + 32 * 64 + 32 * 352 + 88 * 64;
    for (int it0 = gw; it0 < 2 * (I_RET + I_HG); it0 += NGW) {
        int it = it0; const int lp = it / (I_RET + I_HG); it -= lp * (I_RET + I_HG);
        int layer = 2 * lp; if (it >= I_RET) { it -= I_RET; layer += 1; }
        unsigned char* wb = a.ws + WS_W + (size_t)layer * W_LAYER;
        const int j = layer >> 1;
        if (layer & 1) { if (p0_matrix(it, a.in[11] + (size_t)j * D * 5 * D, D, 5 * D, (bf16*)(wb + W_IN), false, scr, F.lane)) continue;
                         if (p0_matrix(it, a.in[12] + (size_t)j * D * D, D, D, (bf16*)(wb + W_OUT), false, scr, F.lane)) continue; }
        else           { if (p0_matrix(it, a.in[8] + (size_t)j * D * 4 * D, D, 4 * D, (bf16*)(wb + W_IN), false, scr, F.lane)) continue;
                         if (p0_matrix(it, a.in[9] + (size_t)j * D * D, D, D, (bf16*)(wb + W_OUT), false, scr, F.lane)) continue; }
        if (p0_matrix(it, a.in[15] + (size_t)layer * D * 2 * FF, D, 2 * FF, (bf16*)(wb + W_GU), true, scr, F.lane)) continue;
        p0_matrix(it, a.in[16] + (size_t)layer * FF * D, FF, D, (bf16*)(wb + W_DN), false, scr, F.lane);
    }
    }
}

__device__ __forceinline__ void norm_mod_phase(const Args& a, Frame& F, const float* gain, const float* modl, int sh_off, int sc_off, int nrows, const float* slab_gate, const float* xl, const float* xc) {
    relaunder(F);
    const int gw = F.vcu * NWAVES + F.wave, NGW = F.G * NWAVES;
    float* X = (float*)(a.ws + WS_X); bf16* HN = (bf16*)(a.ws + WS_HN);
    for (int r = gw; r < nrows; r += NGW) {
        const int b = (r < ML) ? (r >> 12) : 4;
        const GAS f32x4* xr = (const GAS f32x4*)((r < ML) ? xl + (size_t)r * D : xc + (size_t)(r - ML) * D) + F.lane;
        f32x4 v[8]; float ss = 0.f;
#pragma unroll
        for (int j = 0; j < 8; ++j) v[j] = EW_NT ? __builtin_nontemporal_load(xr + 64 * j) : xr[64 * j];
        if (slab_gate != nullptr && r >= ML) {
            const GAS f32x4* sl = (const GAS f32x4*)((const float*)(a.ws + WS_SLAB) + (size_t)(r - ML) * D) + F.lane;
#pragma unroll
            for (int j = 0; j < 8; ++j) { const f32x4 p = (sl[64 * j] + sl[64 * j + (size_t)MC * D / 4]) + (sl[64 * j + 2 * ((size_t)MC * D / 4)] + sl[64 * j + 3 * ((size_t)MC * D / 4)]);
                v[j] += *(const GAS f32x4*)(slab_gate + 256 * j + 4 * F.lane) * p; ((GAS f32x4*)(X + (size_t)r * D) + F.lane)[64 * j] = v[j]; }
        }
#pragma unroll
        for (int j = 0; j < 8; ++j) ss += (v[j][0] * v[j][0] + v[j][1] * v[j][1]) + (v[j][2] * v[j][2] + v[j][3] * v[j][3]);
        const float rstd = 1.0f / sqrtf(wave_sum(ss) * (1.0f / D) + EPS);
        const float* mb = modl + (size_t)b * MOD_LD;
        GAS v2u* o8 = (GAS v2u*)(HN + (size_t)r * D) + F.lane;
#pragma unroll
        for (int j = 0; j < 8; ++j) { const int c = 256 * j + 4 * F.lane;
            const f32x4 g = *(const GAS f32x4*)(gain + c), sh = *(const GAS f32x4*)(mb + sh_off + c), sc = *(const GAS f32x4*)(mb + sc_off + c);
            const f32x4 y = (v[j] * rstd) * g * (sc + 1.0f) + sh;
            v2u w; w.x = pk2(y[0], y[1]); w.y = pk2(y[2], y[3]); o8[64 * j] = w; }
    }
}
template <bool HG>
__device__ __forceinline__ void readout_phase(const Args& a, Frame& F, const float* gain, int nrows) {
    relaunder(F);
    const int gw = F.vcu * NWAVES + F.wave, NGW = F.G * NWAVES;
    const bf16* OF = (const bf16*)(a.ws + WS_OF); const bf16* OB = (const bf16*)(a.ws + WS_OB);
    const bf16* G = (const bf16*)(a.ws + WS_ACT) + (size_t)(HG ? 6 : 3) * ACT_STRIDE; bf16* HN = (bf16*)(a.ws + WS_HN);
    for (int r = gw; r < nrows; r += NGW) {
        const GAS v2u* f = (const GAS v2u*)(OF + (size_t)r * D) + F.lane; const GAS v2u* bk = (const GAS v2u*)(OB + (size_t)r * D) + F.lane;
        const GAS v2u* g8 = (const GAS v2u*)(G + (size_t)r * D) + F.lane;
        f32x4 v[8]; float ssj[8]; float tot = 0.f;
#pragma unroll
        for (int j = 0; j < 8; ++j) { const v2u fa = EW_NT ? __builtin_nontemporal_load(f + 64 * j) : f[64 * j], fb = EW_NT ? __builtin_nontemporal_load(bk + 64 * j) : bk[64 * j]; v[j] = (f32x4){bflo(fa.x) + bflo(fb.x), bfhi(fa.x) + bfhi(fb.x), bflo(fa.y) + bflo(fb.y), bfhi(fa.y) + bfhi(fb.y)}; ssj[j] = (v[j][0] * v[j][0] + v[j][1] * v[j][1]) + (v[j][2] * v[j][2] + v[j][3] * v[j][3]); tot += ssj[j]; }
        float rs_all = 0.f;
        if (HG) rs_all = 1.0f / sqrtf(wave_sum(tot) * (1.0f / D) + EPS);
        GAS v2u* o8 = (GAS v2u*)(HN + (size_t)r * D) + F.lane;
#pragma unroll
        for (int j = 0; j < 8; ++j) {
            float rs = rs_all; f32x4 gn = {1.f, 1.f, 1.f, 1.f};
            if (!HG) rs = 1.0f / sqrtf(wave_sum(ssj[j]) * (1.0f / 256.0f) + EPS);
            else gn = *(const GAS f32x4*)(gain + 256 * j + 4 * F.lane);
            const v2u gw2 = EW_NT ? __builtin_nontemporal_load(g8 + 64 * j) : g8[64 * j];
            const f32x4 gt = {bflo(gw2.x), bfhi(gw2.x), bflo(gw2.y), bfhi(gw2.y)};
            const f32x4 y = (v[j] * rs) * gn * gt;
            v2u w; w.x = pk2(y[0], y[1]); w.y = pk2(y[2], y[3]); o8[64 * j] = w; }
    }
}
__device__ __forceinline__ void final_norm_phase(const Args& a, Frame& F) {
    relaunder(F);
    const int gw = F.vcu * NWAVES + F.wave, NGW = F.G * NWAVES;
    const float* X = (const float*)(a.ws + WS_X); const float* gain = a.in[17];
    for (int r = gw; r < ML; r += NGW) {
        const GAS f32x4* xr = (const GAS f32x4*)(X + (size_t)r * D) + F.lane;
        f32x4 v[8]; float ss = 0.f;
#pragma unroll
        for (int j = 0; j < 8; ++j) { v[j] = EW_NT ? __builtin_nontemporal_load(xr + 64 * j) : xr[64 * j]; ss += (v[j][0] * v[j][0] + v[j][1] * v[j][1]) + (v[j][2] * v[j][2] + v[j][3] * v[j][3]); }
        const float rstd = 1.0f / sqrtf(wave_sum(ss) * (1.0f / D) + EPS);
        GAS f32x4* o = (GAS f32x4*)(a.out + (size_t)r * D) + F.lane;
#pragma unroll
        for (int j = 0; j < 8; ++j) o[64 * j] = (v[j] * rstd) * *(const GAS f32x4*)(gain + 256 * j + 4 * F.lane);
    }
}

template <bool HG>
__device__ __forceinline__ void mixer_phase(const Args& a, Frame& F, int j_layer, bool ctx_out) {
    relaunder(F);
    constexpr int DPL = HG ? 2 : 4, HD = HG ? 128 : 256, NH = HG ? 16 : 8, NEB = HD / 64, CH = 32;
    constexpr int QB = CH * HD * 2;
    constexpr int NQ = HG ? 3 : 2;
    constexpr int VB_OFF = NQ * QB, BUF = VB_OFF + CH * 128;
    static_assert(2 * BUF <= RING_BYTES, "mixer LDS");
    const bf16* act = (const bf16*)(a.ws + WS_ACT);
    const int lane = F.lane, w = F.wave, tid = F.tid;
    for (int task = F.vcu; task < BATCH * NH * 2 * NEB; task += F.G) {
        const int eb = task % NEB, dir = (task / NEB) & 1, h = (task / (2 * NEB)) % NH, b = task / (2 * NEB * NH);
        bf16* O = (bf16*)(a.ws + (dir ? WS_OB : WS_OF));
        const bf16* src0 = act;
        const bf16* src1 = act + (size_t)(HG ? (1 + 2 * dir) : 1) * ACT_STRIDE;
        const bf16* src2 = act + (size_t)(2 + 2 * dir) * ACT_STRIDE;
        const bf16* srcv = act + (size_t)(HG ? 5 : 2) * ACT_STRIDE;
        float gamma = 0.f;
        if (!HG) { const float lg = a.in[10][(j_layer * 2 + dir) * 8 + h]; gamma = 1.0f / (1.0f + expf(-lg)); }
        float S[DPL][8];
#pragma unroll
        for (int i = 0; i < DPL; ++i)
#pragma unroll
            for (int jj = 0; jj < 8; ++jj) S[i][jj] = 0.f;
        constexpr int NCH = (CTXL + SEQ) / CH;
        constexpr int NPQ = HG ? 1 : 2;
        v4u rq[NQ][NPQ]; v4u rv = {0u, 0u, 0u, 0u};
#define MIX_ROWLO(c) (((c) < CTXL / CH) ? (ML + b * CTXL + (dir ? (CTXL / CH - 1 - (c)) : (c)) * CH) : (b * SEQ + (dir ? (SEQ / CH - 1 - ((c) - CTXL / CH)) : ((c) - CTXL / CH)) * CH))
#define MIX_LOAD(c) do { const int rlo_ = MIX_ROWLO(c); \
        _Pragma("unroll") for (int p_ = 0; p_ < NPQ; ++p_) { const int pc_ = tid + 512 * p_; const int row_ = HG ? (pc_ >> 4) : (pc_ >> 5), cc_ = HG ? (pc_ & 15) : (pc_ & 31); \
            const size_t go_ = (size_t)(rlo_ + row_) * D + h * HD + cc_ * 8; \
            rq[0][p_] = *(const GAS v4u*)(src0 + go_); rq[1][p_] = *(const GAS v4u*)(src1 + go_); if (HG) rq[NQ - 1][p_] = *(const GAS v4u*)(src2 + go_); } \
        if (tid < 256) { const int row_ = tid >> 3, cc_ = tid & 7; rv = *(const GAS v4u*)(srcv + (size_t)(rlo_ + row_) * D + h * HD + eb * 64 + cc_ * 8); } } while (0)
#define MIX_STORE(bufp) do { \
        _Pragma("unroll") for (int p_ = 0; p_ < NPQ; ++p_) { const int pc_ = tid + 512 * p_; \
            _Pragma("unroll") for (int q_ = 0; q_ < NQ; ++q_) *(LAS v4u*)((bufp) + q_ * QB + pc_ * 16) = rq[q_][p_]; } \
        if (tid < 256) *(LAS v4u*)((bufp) + VB_OFF + tid * 16) = rv; } while (0)
        __syncthreads();
        MIX_LOAD(0); MIX_STORE(F.lds);
        __syncthreads();
        for (int c = 0; c < NCH; ++c) {
            LAS unsigned char* cur = F.lds + (c & 1) * BUF; LAS unsigned char* nxt = F.lds + ((c + 1) & 1) * BUF;
            if (c + 1 < NCH) MIX_LOAD(c + 1);
            const int rlo = MIX_ROWLO(c);
            const bool do_out = ctx_out || c >= CTXL / CH;
#pragma unroll 2
            for (int s = 0; s < CH; ++s) {
                const int lrow = dir ? (CH - 1 - s) : s;
                float q[DPL], k[DPL], f[DPL];
                if (HG) {
                    const unsigned qw = *(const LAS unsigned*)(cur + lrow * 256 + lane * 4), lw = *(const LAS unsigned*)(cur + QB + lrow * 256 + lane * 4), kw = *(const LAS unsigned*)(cur + 2 * QB + lrow * 256 + lane * 4);
                    q[0] = bflo(qw); q[1] = bfhi(qw); f[0] = __expf(bflo(lw)); f[1] = __expf(bfhi(lw)); k[0] = bflo(kw); k[1] = bfhi(kw);
                } else {
                    const v2u qw = *(const LAS v2u*)(cur + lrow * 512 + lane * 8), kw = *(const LAS v2u*)(cur + QB + lrow * 512 + lane * 8);
                    q[0] = bflo(qw.x); q[1] = bfhi(qw.x); q[DPL - 2] = bflo(qw.y); q[DPL - 1] = bfhi(qw.y);
                    k[0] = bflo(kw.x); k[1] = bfhi(kw.x); k[DPL - 2] = bflo(kw.y); k[DPL - 1] = bfhi(kw.y);
#pragma unroll
                    for (int i = 0; i < DPL; ++i) f[i] = gamma;
                }
                const v4u vw = *(const LAS v4u*)(cur + VB_OFF + lrow * 128 + w * 16);
                const float v[8] = {bflo(vw.x), bfhi(vw.x), bflo(vw.y), bfhi(vw.y), bflo(vw.z), bfhi(vw.z), bflo(vw.w), bfhi(vw.w)};
                float p[8];
#pragma unroll
                for (int jj = 0; jj < 8; ++jj) {
                    float acc = 0.f;
#pragma unroll
                    for (int i = 0; i < DPL; ++i) { S[i][jj] = fmaf(f[i], S[i][jj], k[i] * v[jj]); acc = fmaf(q[i], S[i][jj], acc); }
                    p[jj] = acc;
                }
                if (do_out) {
                    const bool h1 = (lane & 32) != 0, h2 = (lane & 16) != 0, h3 = (lane & 8) != 0;
                    float a4[4], a2[2];
#pragma unroll
                    for (int jj = 0; jj < 4; ++jj) { const float snd = h1 ? p[jj] : p[jj + 4]; const float rcv = __shfl_xor(snd, 32); a4[jj] = (h1 ? p[jj + 4] : p[jj]) + rcv; }
#pragma unroll
                    for (int jj = 0; jj < 2; ++jj) { const float snd = h2 ? a4[jj] : a4[jj + 2]; const float rcv = __shfl_xor(snd, 16); a2[jj] = (h2 ? a4[jj + 2] : a4[jj]) + rcv; }
                    float r1; { const float snd = h3 ? a2[0] : a2[1]; const float rcv = __shfl_xor(snd, 8); r1 = (h3 ? a2[1] : a2[0]) + rcv; }
                    r1 += __shfl_xor(r1, 4); r1 += __shfl_xor(r1, 2); r1 += __shfl_xor(r1, 1);
                    if ((lane & 7) == 0) O[(size_t)(rlo + lrow) * D + h * HD + eb * 64 + w * 8 + (lane >> 3)] = (bf16)f2bf(r1);
                }
            }
            if (c + 1 < NCH) MIX_STORE(nxt);
            __syncthreads();
        }
#undef MIX_ROWLO
#undef MIX_LOAD
#undef MIX_STORE
    }
}


typedef short mx_bf16x8 __attribute__((ext_vector_type(8)));
typedef short mx_s4 __attribute__((ext_vector_type(4)));
#ifndef MX_SWZ
#define MX_SWZ 0
#endif
constexpr int MX_PS = MX_SWZ ? 128 : 144;
__device__ __forceinline__ int sw16(int row) { return MX_SWZ ? 2 * (row & 3) + 8 * ((row >> 3) & 1) : 0; }
__device__ __forceinline__ int sw8(int row) { return MX_SWZ ? (row >> 1) & 7 : 0; }
__device__ __forceinline__ mx_bf16x8 frag_row(const LAS unsigned char* img, int stride, int row0, int k0, int lane) {
    const int row = row0 + (lane & 15);
    return *(const LAS mx_bf16x8*)(img + row * stride + 16 * (((k0 >> 3) + (lane >> 4)) ^ sw16(row)));
}
__device__ __forceinline__ mx_bf16x8 frag_row8(const LAS unsigned char* img, int row0, int k0, int lane) {
    const int row = row0 + (lane & 15);
    return *(const LAS mx_bf16x8*)(img + row * MX_PS + 16 * (((k0 >> 3) + (lane >> 4)) ^ sw8(row)));
}
__device__ __forceinline__ mx_bf16x8 frag_tr(const LAS unsigned char* img, int stride, int k0, int c0, int lane) {
    const int g = lane >> 4, i = lane & 15, q = i >> 2, p = i & 3;
    const int row = k0 + 8 * g + q;
    const LAS unsigned char* ad = img + row * stride + 16 * (((c0 >> 3) + (p >> 1)) ^ sw16(row)) + 8 * (p & 1);
    const mx_s4 x = __builtin_amdgcn_ds_read_tr16_b64_v4i16((LAS mx_s4*)ad);
    const mx_s4 y = __builtin_amdgcn_ds_read_tr16_b64_v4i16((LAS mx_s4*)(ad + 4 * stride));
    return (mx_bf16x8){x[0], x[1], x[2], x[3], y[0], y[1], y[2], y[3]};
}
#define MX_MFMA(a, b, c) __builtin_amdgcn_mfma_f32_16x16x32_bf16((a), (b), (c), 0, 0, 0)
#define MX_BAR() do { asm volatile("s_waitcnt lgkmcnt(0)" ::: "memory"); __builtin_amdgcn_s_barrier(); if (MXP_BAR > 1) __builtin_amdgcn_s_barrier(); asm volatile("" ::: "memory"); } while (0)

template <bool HG, int VAR = 0>
__device__ __forceinline__ void mixer_mfma(const Args& a, Frame& F, int j_layer, bool ctx_out) {
    relaunder(F);
    float zf_ = 0.f; asm volatile("" : "+v"(zf_));
    const f32x4 ZERO4 = {zf_, zf_, zf_, zf_};
    constexpr int HD = HG ? 128 : 256, NH = HG ? 16 : 8, NEB = HD / 64, C = 64, NCTX = CTXL / C, NCH = (CTXL + SEQ) / C;
    constexpr int KS = HD / 32;
    constexpr int DT = HD / 128;
    constexpr int QS = HD * 2 + (MX_SWZ ? 0 : 16);
    constexpr int IMG = 64 * QS;
    constexpr int PS = MX_PS;
    constexpr int NI = HG ? 4 : 2;
    constexpr int O_VT = NI * IMG, O_P = O_VT + 64 * PS, O_ST = O_P + 64 * PS, O_TOT = O_ST + IMG, O_END = O_TOT + 4 * 128 * 4 + 128 * 4;
    static_assert(O_END <= RING_BYTES, "mixer LDS");
    const int lane = F.lane, w = F.wave, tid = F.tid, g = lane >> 4, i = lane & 15;
    const int rg = w >> 1, cg = w & 1, nq0 = 16 * rg;
    LAS unsigned char* const L = F.lds;
    const bf16* act = (const bf16*)(a.ws + WS_ACT);
    for (int task = F.vcu; task < BATCH * NH * 2 * NEB; task += F.G) {
        const int eb = task % NEB, dir = (task / NEB) & 1, h = (task / (2 * NEB)) % NH, b = task / (2 * NEB * NH);
        bf16* O = (bf16*)(a.ws + (dir ? WS_OB : WS_OF));
        const bf16* src0 = act;
        const bf16* src1 = act + (size_t)(HG ? (2 + 2 * dir) : 1) * ACT_STRIDE;
        const bf16* src2 = act + (size_t)(1 + 2 * dir) * ACT_STRIDE;
        const bf16* srcv = act + (size_t)(HG ? 5 : 2) * ACT_STRIDE;
        float lg2 = 0.f;
        if (!HG) { const float x = a.in[10][(j_layer * 2 + dir) * 8 + h]; lg2 = -log1pf(expf(-x)) * 1.4426950408889634f; }
        const float r1 = HG ? 1.f : exp2f((float)(nq0 + i - 63) * lg2), r2 = HG ? 1.f : exp2f((float)(nq0 + i + 1) * lg2), cdec = HG ? 1.f : exp2f(64.f * lg2);
        const int vrow = tid & 63, vcc = tid >> 6;
        const int vs = dir ? 63 - vrow : vrow;
        const float kdec = HG ? 1.f : exp2f((float)(63 - vs) * lg2);
        f32x4 accS[DT][4];
#pragma unroll
        for (int td = 0; td < DT; ++td)
#pragma unroll
            for (int te = 0; te < 4; ++te) accS[td][te] = ZERO4;
        constexpr int NPQ = HG ? 2 : 4;
        constexpr int PF = HG ? MX_PF_HG : MX_PF_RET;
        static_assert(NCH % PF == 0, "prefetch depth must divide the chunk count");
        v4u rq[PF][HG ? 3 : 2][NPQ]; v4u rv[PF];
#define MX_ROWLO(c) (((c) < NCTX) ? (ML + b * CTXL + (dir ? (NCTX - 1 - (c)) : (c)) * C) : (b * SEQ + (dir ? (SEQ / C - 1 - ((c) - NCTX)) : ((c) - NCTX)) * C))
#define MX_LOAD(c, SET) do { const int rlo_ = (VAR & 1) ? MX_ROWLO(0) : MX_ROWLO(c); \
        _Pragma("unroll") for (int p_ = 0; p_ < NPQ; ++p_) { const int pc_ = tid + 512 * p_; const int row_ = pc_ / (HD / 8), cc_ = pc_ % (HD / 8); \
            const size_t go_ = (size_t)(rlo_ + row_) * D + h * HD + cc_ * 8; \
            rq[SET][0][p_] = *(const GAS v4u*)(src0 + go_); rq[SET][1][p_] = *(const GAS v4u*)(src1 + go_); if (HG) rq[SET][HG ? 2 : 1][p_] = *(const GAS v4u*)(src2 + go_); } \
        rv[SET] = *(const GAS v4u*)(srcv + (size_t)(rlo_ + vrow) * D + h * HD + eb * 64 + vcc * 8); } while (0)
#define MX_STAGE(SET) do { \
        _Pragma("unroll") for (int p_ = 0; p_ < NPQ; ++p_) { const int pc_ = tid + 512 * p_; const int row_ = pc_ / (HD / 8), cc_ = pc_ % (HD / 8); const int s_ = dir ? 63 - row_ : row_; \
            const int so_ = s_ * QS + 16 * (cc_ ^ sw16(s_)); *(LAS v4u*)(L + so_) = rq[SET][0][p_]; *(LAS v4u*)(L + IMG + so_) = rq[SET][1][p_]; if (HG) *(LAS v4u*)(L + 2 * IMG + so_) = rq[SET][HG ? 2 : 1][p_]; } \
        { const unsigned vw_[4] = {rv[SET].x, rv[SET].y, rv[SET].z, rv[SET].w}; \
          _Pragma("unroll") for (int jj_ = 0; jj_ < 4; ++jj_) { \
              *(LAS unsigned short*)(L + O_VT + (vcc * 8 + 2 * jj_) * PS + 16 * ((vs >> 3) ^ sw8(vcc * 8 + 2 * jj_)) + (vs & 7) * 2) = (unsigned short)(pk2(bflo(vw_[jj_]) * kdec, bfhi(vw_[jj_]) * kdec) & 0xffffu); \
              *(LAS unsigned short*)(L + O_VT + (vcc * 8 + 2 * jj_ + 1) * PS + 16 * ((vs >> 3) ^ sw8(vcc * 8 + 2 * jj_ + 1)) + (vs & 7) * 2) = (unsigned short)(pk2(bflo(vw_[jj_]) * kdec, bfhi(vw_[jj_]) * kdec) >> 16); } } } while (0)
        __syncthreads();
        for (int u = tid; u < IMG / 16; u += NWAVES * 64) { const unsigned zu_ = __builtin_bit_cast(unsigned, zf_); *(LAS v4u*)(L + O_ST + u * 16) = (v4u){zu_, zu_, zu_, zu_}; }
#pragma unroll
        for (int u = 0; u < PF; ++u) MX_LOAD(u, u);
        for (int c0 = 0; c0 < NCH; c0 += PF)
#pragma unroll
        for (int u = 0; u < PF; ++u) {
            const int c = c0 + u;
            MX_STAGE(u);
            if (MXP_STG > 1) { asm volatile("" ::: "memory"); MX_STAGE(u); }
            if (HG) {
                MX_BAR();
                const int d = tid & 127, qr = tid >> 7;
                float cl[16], qv[16], kv[16]; float run = 0.f;
#pragma unroll
                for (int ii = 0; ii < 16; ++ii) { const int s = 16 * qr + ii;
                    const int eo = s * QS + 16 * ((d >> 3) ^ sw16(s)) + (d & 7) * 2;
                    run += bflo((unsigned)*(const LAS unsigned short*)(L + 2 * IMG + eo)); cl[ii] = run;
                    qv[ii] = bflo((unsigned)*(const LAS unsigned short*)(L + eo)); kv[ii] = bflo((unsigned)*(const LAS unsigned short*)(L + IMG + eo)); }
                LAS float* tot = (LAS float*)(L + O_TOT);
                tot[qr * 128 + d] = run;
                MX_BAR();
                const float t0 = tot[d], t1 = tot[128 + d], t2 = tot[256 + d], t3 = tot[384 + d];
                const float off = (qr == 0) ? 0.f : (qr == 1) ? t0 : (qr == 2) ? (t0 + t1) : (t0 + t1 + t2);
                const float cref = t0 + t1, cend = (t0 + t1) + (t2 + t3);
                if (qr == 0) tot[512 + d] = cend;
#pragma unroll
                for (int ii = 0; ii < 16; ++ii) { const int s = 16 * qr + ii; const float cm = off + cl[ii]; const int eo = s * QS + 16 * ((d >> 3) ^ sw16(s)) + (d & 7) * 2;
                    const float e1 = __expf(fminf(cm - cref, 80.f)), e2 = __expf(fminf(cref - cm, 80.f)), e3 = __expf(cm), e4 = __expf(cend - cm);
                    const unsigned w12 = pk2(qv[ii] * e1, kv[ii] * e2), w34 = pk2(qv[ii] * e3, kv[ii] * e4);
                    *(LAS unsigned short*)(L + eo) = (unsigned short)(w12 & 0xffffu);
                    *(LAS unsigned short*)(L + IMG + eo) = (unsigned short)(w12 >> 16);
                    *(LAS unsigned short*)(L + 2 * IMG + eo) = (unsigned short)(w34 & 0xffffu);
                    *(LAS unsigned short*)(L + 3 * IMG + eo) = (unsigned short)(w34 >> 16); }
            }
            MX_BAR();
            { const int cn = (c + PF < NCH) ? c + PF : NCH - 1; MX_LOAD(cn, u); }
            if (MXP_SLEEP > 0) __builtin_amdgcn_s_sleep(MXP_SLEEP);
            const int rlo = MX_ROWLO(c);
            const bool do_out = ctx_out || c >= NCTX;
            mx_bf16x8 aq[KS];
            if (do_out) {
#pragma unroll
                for (int ks = 0; ks < KS; ++ks) aq[ks] = frag_row(L, QS, nq0, 32 * ks, lane);
                for (int rep1 = 0; rep1 < MXP_S1; ++rep1) {
                f32x4 pt0 = ZERO4, pt1 = ZERO4;
#pragma unroll
                for (int kb = 0; kb < KS; kb += 4) {
                    mx_bf16x8 kf[2][4];
#pragma unroll
                    for (int ks = 0; ks < 4; ++ks) { kf[0][ks] = frag_row(L + IMG, QS, 32 * cg, 32 * (kb + ks), lane); kf[1][ks] = frag_row(L + IMG, QS, 32 * cg + 16, 32 * (kb + ks), lane); }
                    __builtin_amdgcn_sched_barrier(0);
#pragma unroll
                    for (int ks = 0; ks < 4; ++ks) { pt0 = MX_MFMA(kf[0][ks], aq[kb + ks], pt0); pt1 = MX_MFMA(kf[1][ks], aq[kb + ks], pt1); }
                    __builtin_amdgcn_sched_barrier(0);
                }
                const int m0 = 32 * cg + 4 * g, n = nq0 + i;
                v2u pw; pw.x = pk2((m0 <= n) ? pt0[0] : 0.f, (m0 + 1 <= n) ? pt0[1] : 0.f); pw.y = pk2((m0 + 2 <= n) ? pt0[2] : 0.f, (m0 + 3 <= n) ? pt0[3] : 0.f);
                *(LAS v2u*)(L + O_P + n * PS + 16 * ((m0 >> 3) ^ sw8(n)) + (m0 & 7) * 2) = pw;
                const int m1 = m0 + 16;
                pw.x = pk2((m1 <= n) ? pt1[0] : 0.f, (m1 + 1 <= n) ? pt1[1] : 0.f); pw.y = pk2((m1 + 2 <= n) ? pt1[2] : 0.f, (m1 + 3 <= n) ? pt1[3] : 0.f);
                *(LAS v2u*)(L + O_P + n * PS + 16 * ((m1 >> 3) ^ sw8(n)) + (m1 & 7) * 2) = pw;
                }
            }
            {
                mx_bf16x8 vt[4][2], ak[DT][2]; f32x4 dec[DT];
#pragma unroll
                for (int te = 0; te < 4; ++te) { vt[te][0] = frag_row8(L + O_VT, 16 * te, 0, lane); vt[te][1] = frag_row8(L + O_VT, 16 * te, 32, lane); }
#pragma unroll
                for (int td = 0; td < DT; ++td) { const int d0 = 16 * (DT * w + td);
                    ak[td][0] = frag_tr(L + (HG ? 3 : 1) * IMG, QS, 0, d0, lane); ak[td][1] = frag_tr(L + (HG ? 3 : 1) * IMG, QS, 32, d0, lane);
                    dec[td] = (f32x4){cdec, cdec, cdec, cdec};
                    if (HG) { const f32x4 ce = *(const LAS f32x4*)(L + O_TOT + 2048 + (d0 + 4 * g) * 4); dec[td] = (f32x4){__expf(ce[0]), __expf(ce[1]), __expf(ce[2]), __expf(ce[3])}; } }
                __builtin_amdgcn_sched_barrier(0);
#pragma unroll
                for (int td = 0; td < DT; ++td)
#pragma unroll
                    for (int te = 0; te < 4; ++te) accS[td][te] = MX_MFMA(ak[td][0], vt[te][0], accS[td][te] * dec[td]);
#pragma unroll
                for (int td = 0; td < DT; ++td)
#pragma unroll
                    for (int te = 0; te < 4; ++te) accS[td][te] = MX_MFMA(ak[td][1], vt[te][1], accS[td][te]);
            }
            MX_BAR();
            if (do_out) {
                if (HG) {
#pragma unroll
                    for (int ks = 0; ks < KS; ++ks) aq[ks] = frag_row(L + 2 * IMG, QS, nq0, 32 * ks, lane);
                }
                mx_bf16x8 vo[2][2];
                const mx_bf16x8 bp0 = frag_row8(L + O_P, nq0, 0, lane), bp1 = frag_row8(L + O_P, nq0, 32, lane);
#pragma unroll
                for (int te = 0; te < 2; ++te) { vo[te][0] = frag_row8(L + O_VT, 32 * cg + 16 * te, 0, lane); vo[te][1] = frag_row8(L + O_VT, 32 * cg + 16 * te, 32, lane); }
                const int grow = rlo + (dir ? 63 - (nq0 + i) : (nq0 + i));
                for (int rep2 = 0; rep2 < MXP_S2; ++rep2) {
                f32x4 o1a = ZERO4, o1b = o1a, o2a = o1a, o2b = o1a;
#pragma unroll
                for (int kb = 0; kb < KS; kb += 4) {
                    mx_bf16x8 st[2][4];
#pragma unroll
                    for (int ks = 0; ks < 4; ++ks) { st[0][ks] = frag_row(L + O_ST, QS, 32 * cg, 32 * (kb + ks), lane); st[1][ks] = frag_row(L + O_ST, QS, 32 * cg + 16, 32 * (kb + ks), lane); }
                    __builtin_amdgcn_sched_barrier(0);
                    if (kb == 0) { o1a = MX_MFMA(vo[0][0], bp0, o1a); o1b = MX_MFMA(vo[1][0], bp0, o1b); o1a = MX_MFMA(vo[0][1], bp1, o1a); o1b = MX_MFMA(vo[1][1], bp1, o1b); }
#pragma unroll
                    for (int ks = 0; ks < 4; ++ks) { o2a = MX_MFMA(st[0][ks], aq[kb + ks], o2a); o2b = MX_MFMA(st[1][ks], aq[kb + ks], o2b); }
                    __builtin_amdgcn_sched_barrier(0);
                }
                bf16* op = O + (size_t)grow * D + h * HD + eb * 64 + 32 * cg + 4 * g;
                if (!(VAR & 2)) { const f32x4 ya = o1a * r1 + o2a * r2, yb = o1b * r1 + o2b * r2; v2u wa, wb; wa.x = pk2(ya[0], ya[1]); wa.y = pk2(ya[2], ya[3]); wb.x = pk2(yb[0], yb[1]); wb.y = pk2(yb[2], yb[3]);
                    *(GAS v2u*)(op) = wa; *(GAS v2u*)(op + 16) = wb; }
                else { asm volatile("" :: "v"(o1a), "v"(o1b), "v"(o2a), "v"(o2b)); }
                }
            }
            MX_BAR();
#pragma unroll
            for (int td = 0; td < DT; ++td)
#pragma unroll
                for (int te = 0; te < 4; ++te) { const int d0 = 16 * (DT * w + td); const f32x4 s = accS[td][te];
                    v2u sw; sw.x = pk2(s[0], s[1]); sw.y = pk2(s[2], s[3]);
                    *(LAS v2u*)(L + O_ST + (16 * te + i) * QS + 16 * (((d0 + 4 * g) >> 3) ^ sw16(16 * te + i)) + ((d0 + 4 * g) & 7) * 2) = sw; }
        }
#undef MX_ROWLO
#undef MX_LOAD
#undef MX_STAGE
    }
}

__device__ __forceinline__ void mixer_hg2(const Args& a, Frame& F, bool ctx_out) {
    relaunder(F);
    float zf_ = 0.f; asm volatile("" : "+v"(zf_));
    const f32x4 ZERO4 = {zf_, zf_, zf_, zf_};
    constexpr int HD = 128, NH = 16, NEB = 2, C = 64, NCTX = CTXL / C, NCH = (CTXL + SEQ) / C, KS = HD / 32;
    constexpr int QS = HD * 2 + 16, IMG = 64 * QS, PS = MX_PS;
    constexpr int O_VT = 3 * IMG, O_P = O_VT + 64 * PS, O_ST = O_P + 64 * PS, O_END = O_ST + IMG;
    static_assert(O_END <= RING_BYTES && MX_SWZ == 0, "mixer_hg2 LDS (padded images)");
    const int lane = F.lane, w = F.wave, tid = F.tid, g = lane >> 4, i = lane & 15;
    const int rg = w >> 1, cg = w & 1, nq0 = 16 * rg;
    LAS unsigned char* const L = F.lds;
    const bf16* act = (const bf16*)(a.ws + WS_ACT);
    mx_bf16x8 bt0, bt1;
#pragma unroll
    for (int j = 0; j < 8; ++j) { bt0[j] = (8 * g + j <= i) ? (short)0x3F80 : (short)0; bt1[j] = (8 * g + j <= 16 + i) ? (short)0x3F80 : (short)0; }
    for (int task = F.vcu; task < BATCH * NH * 2 * NEB; task += F.G) {
        const int eb = task % NEB, dir = (task / NEB) & 1, h = (task / (2 * NEB)) % NH, b = task / (2 * NEB * NH);
        bf16* O = (bf16*)(a.ws + (dir ? WS_OB : WS_OF));
        const bf16* src0 = act;
        const bf16* src1 = act + (size_t)(2 + 2 * dir) * ACT_STRIDE;
        const bf16* src2 = act + (size_t)(1 + 2 * dir) * ACT_STRIDE;
        const bf16* srcv = act + (size_t)5 * ACT_STRIDE;
        const int vrow = tid & 63, vcc = tid >> 6, vs = dir ? 63 - vrow : vrow;
        f32x4 accS[4];
#pragma unroll
        for (int te = 0; te < 4; ++te) accS[te] = ZERO4;
        constexpr int PF = MX_PF_HG;
        static_assert(NCH % PF == 0, "prefetch depth must divide the chunk count");
        v4u rq[PF][3][2]; v4u rv[PF];
#define H2_ROWLO(c) (((c) < NCTX) ? (ML + b * CTXL + (dir ? (NCTX - 1 - (c)) : (c)) * C) : (b * SEQ + (dir ? (SEQ / C - 1 - ((c) - NCTX)) : ((c) - NCTX)) * C))
#define H2_LOAD(c, SET) do { const int rlo_ = H2_ROWLO(c); \
        _Pragma("unroll") for (int p_ = 0; p_ < 2; ++p_) { const int pc_ = tid + 512 * p_; const size_t go_ = (size_t)(rlo_ + (pc_ >> 4)) * D + h * HD + (pc_ & 15) * 8; \
            rq[SET][0][p_] = *(const GAS v4u*)(src0 + go_); rq[SET][1][p_] = *(const GAS v4u*)(src1 + go_); rq[SET][2][p_] = *(const GAS v4u*)(src2 + go_); } \
        rv[SET] = *(const GAS v4u*)(srcv + (size_t)(rlo_ + vrow) * D + h * HD + eb * 64 + vcc * 8); } while (0)
#define H2_STAGE(SET) do { \
        _Pragma("unroll") for (int p_ = 0; p_ < 2; ++p_) { const int pc_ = tid + 512 * p_; const int row_ = pc_ >> 4; const int s_ = dir ? 63 - row_ : row_; const int so_ = s_ * QS + (pc_ & 15) * 16; \
            *(LAS v4u*)(L + so_) = rq[SET][0][p_]; *(LAS v4u*)(L + IMG + so_) = rq[SET][1][p_]; *(LAS v4u*)(L + 2 * IMG + so_) = rq[SET][2][p_]; } \
        { const unsigned vw_[4] = {rv[SET].x, rv[SET].y, rv[SET].z, rv[SET].w}; \
          _Pragma("unroll") for (int jj_ = 0; jj_ < 4; ++jj_) { \
              *(LAS unsigned short*)(L + O_VT + (vcc * 8 + 2 * jj_) * PS + vs * 2) = (unsigned short)(vw_[jj_] & 0xffffu); \
              *(LAS unsigned short*)(L + O_VT + (vcc * 8 + 2 * jj_ + 1) * PS + vs * 2) = (unsigned short)(vw_[jj_] >> 16); } } } while (0)
        __syncthreads();
#pragma unroll
        for (int u = 0; u < PF; ++u) H2_LOAD(u, u);
        for (int c0 = 0; c0 < NCH; c0 += PF)
#pragma unroll
        for (int u = 0; u < PF; ++u) {
            const int c = c0 + u;
            H2_STAGE(u);
            MX_BAR();
            { const int cn = (c + PF < NCH) ? c + PF : NCH - 1; H2_LOAD(cn, u); }
            f32x4 fe, fu;
            {
                unsigned one2_ = 0x3F803F80u; asm volatile("" : "+v"(one2_));
                typedef unsigned u4_ __attribute__((ext_vector_type(4)));
                const mx_bf16x8 ones = __builtin_bit_cast(mx_bf16x8, (u4_){one2_, one2_, one2_, one2_});
                const mx_bf16x8 a0 = frag_tr(L + 2 * IMG, QS, 0, 16 * w, lane), a1 = frag_tr(L + 2 * IMG, QS, 32, 16 * w, lane);
                const f32x4 z = ZERO4;
                f32x4 ct[4];
                ct[0] = MX_MFMA(a0, bt0, z); ct[1] = MX_MFMA(a0, bt1, z);
                const f32x4 cref = MX_MFMA(a0, ones, z);
                ct[2] = MX_MFMA(a1, bt0, cref); ct[3] = MX_MFMA(a1, bt1, cref);
                const f32x4 cend = MX_MFMA(a1, ones, cref);
                fe = (f32x4){__expf(cend[0]), __expf(cend[1]), __expf(cend[2]), __expf(cend[3])};
                fu = (f32x4){__expf(cend[0] - cref[0]), __expf(cend[1] - cref[1]), __expf(cend[2] - cref[2]), __expf(cend[3] - cref[3])};
                const f32x4 fs = {__expf(cref[0]), __expf(cref[1]), __expf(cref[2]), __expf(cref[3])};
#pragma unroll
                for (int te = 0; te < 4; ++te) { const f32x4 s = accS[te] * fs; v2u sw; sw.x = pk2(s[0], s[1]); sw.y = pk2(s[2], s[3]);
                    *(LAS v2u*)(L + O_ST + (16 * te + i) * QS + (16 * w + 4 * g) * 2) = sw; }
#pragma unroll
                for (int t = 0; t < 4; ++t) {
                    LAS unsigned char* pq = L + (16 * t + i) * QS + (16 * w + 4 * g) * 2;
                    const v2u qw = *(const LAS v2u*)pq, kw = *(const LAS v2u*)(pq + IMG);
                    f32x4 e1;
#pragma unroll
                    for (int r = 0; r < 4; ++r) e1[r] = __expf(fminf(fmaxf(ct[t][r] - cref[r], -80.f), 80.f));
                    const f32x4 e2 = {__builtin_amdgcn_rcpf(e1[0]), __builtin_amdgcn_rcpf(e1[1]), __builtin_amdgcn_rcpf(e1[2]), __builtin_amdgcn_rcpf(e1[3])};
                    v2u qo, ko;
                    qo.x = pk2(bflo(qw.x) * e1[0], bfhi(qw.x) * e1[1]); qo.y = pk2(bflo(qw.y) * e1[2], bfhi(qw.y) * e1[3]);
                    ko.x = pk2(bflo(kw.x) * e2[0], bfhi(kw.x) * e2[1]); ko.y = pk2(bflo(kw.y) * e2[2], bfhi(kw.y) * e2[3]);
                    *(LAS v2u*)pq = qo; *(LAS v2u*)(pq + IMG) = ko;
                }
            }
            MX_BAR();
            const int rlo = H2_ROWLO(c);
            const bool do_out = ctx_out || c >= NCTX;
            mx_bf16x8 aq[KS];
            {
                mx_bf16x8 kf[2][KS], vt[4][2];
                if (do_out) {
#pragma unroll
                    for (int ks = 0; ks < KS; ++ks) { aq[ks] = frag_row(L, QS, nq0, 32 * ks, lane); kf[0][ks] = frag_row(L + IMG, QS, 32 * cg, 32 * ks, lane); kf[1][ks] = frag_row(L + IMG, QS, 32 * cg + 16, 32 * ks, lane); }
                }
#pragma unroll
                for (int te = 0; te < 4; ++te) { vt[te][0] = frag_row8(L + O_VT, 16 * te, 0, lane); vt[te][1] = frag_row8(L + O_VT, 16 * te, 32, lane); }
                const mx_bf16x8 ak0 = frag_tr(L + IMG, QS, 0, 16 * w, lane), ak1 = frag_tr(L + IMG, QS, 32, 16 * w, lane);
                __builtin_amdgcn_sched_barrier(0);
                f32x4 pt0 = ZERO4, pt1 = ZERO4;
                if (do_out) {
#pragma unroll
                    for (int ks = 0; ks < KS; ++ks) { pt0 = MX_MFMA(kf[0][ks], aq[ks], pt0); pt1 = MX_MFMA(kf[1][ks], aq[ks], pt1); }
                }
                f32x4 uu[4];
#pragma unroll
                for (int te = 0; te < 4; ++te) { const f32x4 z4 = ZERO4; uu[te] = MX_MFMA(ak0, vt[te][0], z4); }
#pragma unroll
                for (int te = 0; te < 4; ++te) uu[te] = MX_MFMA(ak1, vt[te][1], uu[te]);
                __builtin_amdgcn_sched_barrier(0);
                if (do_out) {
                    const int m0 = 32 * cg + 4 * g, m1 = m0 + 16, n = nq0 + i;
                    v2u pw; pw.x = pk2((m0 <= n) ? pt0[0] : 0.f, (m0 + 1 <= n) ? pt0[1] : 0.f); pw.y = pk2((m0 + 2 <= n) ? pt0[2] : 0.f, (m0 + 3 <= n) ? pt0[3] : 0.f);
                    *(LAS v2u*)(L + O_P + n * PS + m0 * 2) = pw;
                    pw.x = pk2((m1 <= n) ? pt1[0] : 0.f, (m1 + 1 <= n) ? pt1[1] : 0.f); pw.y = pk2((m1 + 2 <= n) ? pt1[2] : 0.f, (m1 + 3 <= n) ? pt1[3] : 0.f);
                    *(LAS v2u*)(L + O_P + n * PS + m1 * 2) = pw;
                }
#pragma unroll
                for (int te = 0; te < 4; ++te) accS[te] = accS[te] * fe + uu[te] * fu;
            }
            MX_BAR();
            if (do_out) {
                mx_bf16x8 st[2][KS], vo[2][2];
                const mx_bf16x8 bp0 = frag_row8(L + O_P, nq0, 0, lane), bp1 = frag_row8(L + O_P, nq0, 32, lane);
#pragma unroll
                for (int te = 0; te < 2; ++te) { vo[te][0] = frag_row8(L + O_VT, 32 * cg + 16 * te, 0, lane); vo[te][1] = frag_row8(L + O_VT, 32 * cg + 16 * te, 32, lane);
#pragma unroll
                    for (int ks = 0; ks < KS; ++ks) st[te][ks] = frag_row(L + O_ST, QS, 32 * cg + 16 * te, 32 * ks, lane); }
                __builtin_amdgcn_sched_barrier(0);
                f32x4 oa = ZERO4, ob = oa;
                oa = MX_MFMA(vo[0][0], bp0, oa); ob = MX_MFMA(vo[1][0], bp0, ob);
#pragma unroll
                for (int ks = 0; ks < KS; ++ks) { oa = MX_MFMA(st[0][ks], aq[ks], oa); ob = MX_MFMA(st[1][ks], aq[ks], ob); }
                oa = MX_MFMA(vo[0][1], bp1, oa); ob = MX_MFMA(vo[1][1], bp1, ob);
                bf16* op = O + (size_t)(rlo + (dir ? 63 - (nq0 + i) : (nq0 + i))) * D + h * HD + eb * 64 + 32 * cg + 4 * g;
                v2u wa, wb; wa.x = pk2(oa[0], oa[1]); wa.y = pk2(oa[2], oa[3]); wb.x = pk2(ob[0], ob[1]); wb.y = pk2(ob[2], ob[3]);
                *(GAS v2u*)(op) = wa; *(GAS v2u*)(op + 16) = wb;
            }
            MX_BAR();
        }
#undef H2_ROWLO
#undef H2_LOAD
#undef H2_STAGE
    }
}

__device__ __forceinline__ void mixer_ret3(const Args& a, Frame& F, int j_layer, bool ctx_out) {
    relaunder(F);
    float zf_ = 0.f; asm volatile("" : "+v"(zf_));
    const f32x4 ZERO4 = {zf_, zf_, zf_, zf_};
    constexpr int HD = 256, NH = 8, NEB = 4, C = 64, NCTX = CTXL / C, NCH = (CTXL + SEQ) / C, KS = HD / 32;
    constexpr int QS = HD * 2 + 16, IMG = 64 * QS, PS = MX_PS, VTB = 64 * PS;
    constexpr int O_VT = 2 * IMG, O_P = O_VT + 2 * VTB, O_ST = O_P + VTB, O_END = O_ST + IMG;
    static_assert(O_END <= RING_BYTES && MX_SWZ == 0, "mixer_ret3 LDS (padded images)");
    const int lane = F.lane, w = F.wave, tid = F.tid, g = lane >> 4, i = lane & 15;
    const int rg = w >> 1, cg = w & 1, nq0 = 16 * rg;
    LAS unsigned char* const L = F.lds;
    const bf16* act = (const bf16*)(a.ws + WS_ACT);
    for (int task = F.vcu; task < BATCH * NH * 2 * NEB; task += F.G) {
        const int eb = task % NEB, dir = (task / NEB) & 1, h = (task / (2 * NEB)) % NH, b = task / (2 * NEB * NH);
        bf16* O = (bf16*)(a.ws + (dir ? WS_OB : WS_OF));
        const bf16* src0 = act; const bf16* src1 = act + ACT_STRIDE; const bf16* srcv = act + (size_t)2 * ACT_STRIDE;
        const float x = a.in[10][(j_layer * 2 + dir) * 8 + h];
        const float lg2 = -log1pf(expf(-x)) * 1.4426950408889634f;
        const float r1 = exp2f((float)(nq0 + i - 63) * lg2), r2 = exp2f((float)(nq0 + i + 1) * lg2), cdec = exp2f(64.f * lg2);
        const int vrow = tid & 63, vcc = tid >> 6, vs = dir ? 63 - vrow : vrow;
        const float kdec = exp2f((float)(63 - vs) * lg2);
        f32x4 accS[2][4];
#pragma unroll
        for (int td = 0; td < 2; ++td)
#pragma unroll
            for (int te = 0; te < 4; ++te) accS[td][te] = ZERO4;
        v4u rq[2][4]; v4u rv;
#define R3_ROWLO(c) (((c) < NCTX) ? (ML + b * CTXL + (dir ? (NCTX - 1 - (c)) : (c)) * C) : (b * SEQ + (dir ? (SEQ / C - 1 - ((c) - NCTX)) : ((c) - NCTX)) * C))
#define R3_LOAD(c) do { const int rlo_ = R3_ROWLO(c); \
        _Pragma("unroll") for (int p_ = 0; p_ < 4; ++p_) { const int pc_ = tid + 512 * p_; const size_t go_ = (size_t)(rlo_ + (pc_ >> 5)) * D + h * HD + (pc_ & 31) * 8; \
            rq[0][p_] = *(const GAS v4u*)(src0 + go_); rq[1][p_] = *(const GAS v4u*)(src1 + go_); } \
        rv = *(const GAS v4u*)(srcv + (size_t)(rlo_ + vrow) * D + h * HD + eb * 64 + vcc * 8); } while (0)
#define R3_STAGE(vb) do { \
        _Pragma("unroll") for (int p_ = 0; p_ < 4; ++p_) { const int pc_ = tid + 512 * p_; const int row_ = pc_ >> 5; const int s_ = dir ? 63 - row_ : row_; const int so_ = s_ * QS + (pc_ & 31) * 16; \
            *(LAS v4u*)(L + so_) = rq[0][p_]; *(LAS v4u*)(L + IMG + so_) = rq[1][p_]; } \
        { const unsigned vw_[4] = {rv.x, rv.y, rv.z, rv.w}; \
          _Pragma("unroll") for (int jj_ = 0; jj_ < 4; ++jj_) { const unsigned pw_ = pk2(bflo(vw_[jj_]) * kdec, bfhi(vw_[jj_]) * kdec); \
              *(LAS unsigned short*)(L + O_VT + (vb) * VTB + (vcc * 8 + 2 * jj_) * PS + vs * 2) = (unsigned short)(pw_ & 0xffffu); \
              *(LAS unsigned short*)(L + O_VT + (vb) * VTB + (vcc * 8 + 2 * jj_ + 1) * PS + vs * 2) = (unsigned short)(pw_ >> 16); } } } while (0)
        __syncthreads();
        { const unsigned zu_ = __builtin_bit_cast(unsigned, zf_); for (int u = tid; u < IMG / 16; u += NWAVES * 64) *(LAS v4u*)(L + O_ST + u * 16) = (v4u){zu_, zu_, zu_, zu_}; }
        R3_LOAD(0);
        R3_STAGE(0);
        R3_LOAD(1);
        MX_BAR();
        for (int c = 0; c < NCH; ++c) {
            const int vb = c & 1;
            LAS unsigned char* const Vc = L + O_VT + vb * VTB;
            const int rlo = R3_ROWLO(c);
            const bool do_out = ctx_out || c >= NCTX;
            if (c > 0) {
#pragma unroll
                for (int td = 0; td < 2; ++td)
#pragma unroll
                    for (int te = 0; te < 4; ++te) { const int d0 = 16 * (2 * w + td); const f32x4 s = accS[td][te];
                        v2u sw; sw.x = pk2(s[0], s[1]); sw.y = pk2(s[2], s[3]);
                        *(LAS v2u*)(L + O_ST + (16 * te + i) * QS + (d0 + 4 * g) * 2) = sw; }
            }
            mx_bf16x8 aq[KS];
            if (do_out) {
#pragma unroll
                for (int ks = 0; ks < KS; ++ks) aq[ks] = frag_row(L, QS, nq0, 32 * ks, lane);
                f32x4 pt0 = ZERO4, pt1 = ZERO4;
#pragma unroll
                for (int kb = 0; kb < KS; kb += 4) {
                    mx_bf16x8 kf[2][4];
#pragma unroll
                    for (int ks = 0; ks < 4; ++ks) { kf[0][ks] = frag_row(L + IMG, QS, 32 * cg, 32 * (kb + ks), lane); kf[1][ks] = frag_row(L + IMG, QS, 32 * cg + 16, 32 * (kb + ks), lane); }
                    __builtin_amdgcn_sched_barrier(0);
#pragma unroll
                    for (int ks = 0; ks < 4; ++ks) { pt0 = MX_MFMA(kf[0][ks], aq[kb + ks], pt0); pt1 = MX_MFMA(kf[1][ks], aq[kb + ks], pt1); }
                    __builtin_amdgcn_sched_barrier(0);
                }
                const int m0 = 32 * cg + 4 * g, m1 = m0 + 16, n = nq0 + i;
                v2u pw; pw.x = pk2((m0 <= n) ? pt0[0] : 0.f, (m0 + 1 <= n) ? pt0[1] : 0.f); pw.y = pk2((m0 + 2 <= n) ? pt0[2] : 0.f, (m0 + 3 <= n) ? pt0[3] : 0.f);
                *(LAS v2u*)(L + O_P + n * PS + m0 * 2) = pw;
                pw.x = pk2((m1 <= n) ? pt1[0] : 0.f, (m1 + 1 <= n) ? pt1[1] : 0.f); pw.y = pk2((m1 + 2 <= n) ? pt1[2] : 0.f, (m1 + 3 <= n) ? pt1[3] : 0.f);
                *(LAS v2u*)(L + O_P + n * PS + m1 * 2) = pw;
            }
            {
                mx_bf16x8 vt[4][2], ak[2][2];
#pragma unroll
                for (int te = 0; te < 4; ++te) { vt[te][0] = frag_row8(Vc, 16 * te, 0, lane); vt[te][1] = frag_row8(Vc, 16 * te, 32, lane); }
#pragma unroll
                for (int td = 0; td < 2; ++td) { ak[td][0] = frag_tr(L + IMG, QS, 0, 16 * (2 * w + td), lane); ak[td][1] = frag_tr(L + IMG, QS, 32, 16 * (2 * w + td), lane); }
                __builtin_amdgcn_sched_barrier(0);
#pragma unroll
                for (int td = 0; td < 2; ++td)
#pragma unroll
                    for (int te = 0; te < 4; ++te) accS[td][te] = MX_MFMA(ak[td][0], vt[te][0], accS[td][te] * cdec);
#pragma unroll
                for (int td = 0; td < 2; ++td)
#pragma unroll
                    for (int te = 0; te < 4; ++te) accS[td][te] = MX_MFMA(ak[td][1], vt[te][1], accS[td][te]);
            }
            MX_BAR();
            if (do_out) {
                mx_bf16x8 vo[2][2];
                const mx_bf16x8 bp0 = frag_row8(L + O_P, nq0, 0, lane), bp1 = frag_row8(L + O_P, nq0, 32, lane);
#pragma unroll
                for (int te = 0; te < 2; ++te) { vo[te][0] = frag_row8(Vc, 32 * cg + 16 * te, 0, lane); vo[te][1] = frag_row8(Vc, 32 * cg + 16 * te, 32, lane); }
                f32x4 o1a = ZERO4, o1b = ZERO4, o2a = ZERO4, o2b = ZERO4;
#pragma unroll
                for (int kb = 0; kb < KS; kb += 4) {
                    mx_bf16x8 st[2][4];
#pragma unroll
                    for (int ks = 0; ks < 4; ++ks) { st[0][ks] = frag_row(L + O_ST, QS, 32 * cg, 32 * (kb + ks), lane); st[1][ks] = frag_row(L + O_ST, QS, 32 * cg + 16, 32 * (kb + ks), lane); }
                    __builtin_amdgcn_sched_barrier(0);
                    if (kb == 0) { o1a = MX_MFMA(vo[0][0], bp0, o1a); o1b = MX_MFMA(vo[1][0], bp0, o1b); o1a = MX_MFMA(vo[0][1], bp1, o1a); o1b = MX_MFMA(vo[1][1], bp1, o1b); }
#pragma unroll
                    for (int ks = 0; ks < 4; ++ks) { o2a = MX_MFMA(st[0][ks], aq[kb + ks], o2a); o2b = MX_MFMA(st[1][ks], aq[kb + ks], o2b); }
                    __builtin_amdgcn_sched_barrier(0);
                }
                bf16* op = O + (size_t)(rlo + (dir ? 63 - (nq0 + i) : (nq0 + i))) * D + h * HD + eb * 64 + 32 * cg + 4 * g;
                const f32x4 ya = o1a * r1 + o2a * r2, yb = o1b * r1 + o2b * r2; v2u wa, wb; wa.x = pk2(ya[0], ya[1]); wa.y = pk2(ya[2], ya[3]); wb.x = pk2(yb[0], yb[1]); wb.y = pk2(yb[2], yb[3]);
                *(GAS v2u*)(op) = wa; *(GAS v2u*)(op + 16) = wb;
            }
            if (c + 1 < NCH) R3_STAGE(vb ^ 1);
            { const int cn = (c + 2 < NCH) ? c + 2 : NCH - 1; R3_LOAD(cn); }
            MX_BAR();
        }
#undef R3_ROWLO
#undef R3_LOAD
#undef R3_STAGE
    }
}
#ifndef MIX_MFMA_RET
#define MIX_MFMA_RET 1
#endif
#ifndef MIX_RET_V3
#define MIX_RET_V3 0
#endif
#ifndef MIX_HG_V2
#define MIX_HG_V2 1
#endif
#ifndef MIX_MFMA_HG
#define MIX_MFMA_HG 1
#endif
#ifndef REP_NORM
#define REP_NORM 1
#endif
#ifndef REP_GEMM_IN
#define REP_GEMM_IN 1
#endif
#ifndef REP_MIX_RET
#define REP_MIX_RET 1
#endif
#ifndef REP_MIX_HG
#define REP_MIX_HG 1
#endif
#ifndef REP_READ
#define REP_READ 1
#endif
#ifndef REP_GU
#define REP_GU 1
#endif
__global__ void __launch_bounds__(NWAVES * 64, 2) fwd_kernel(Args args) {
    extern __shared__ __attribute__((aligned(16))) unsigned char lds[];
    Frame F;
    F.lds = (LAS unsigned char*)lds;
    volatile LAS unsigned* MISC = (volatile LAS unsigned*)(F.lds + MISC_OFF);
    F.tid = threadIdx.x; F.lane = F.tid & 63; F.wave = __builtin_amdgcn_readfirstlane(F.tid >> 6);
    F.G = gridDim.x; { const int bx = blockIdx.x; F.vcu = (F.G % 8 == 0) ? (bx % 8) * (F.G / 8) + bx / 8 : bx; }
    unsigned char* ws = args.ws;
    F.ctl = (gu32*)(ws + WS_CTL);
    for (int u = F.tid; u < (LDS_BYTES - LDSCTL_OFF) / 4; u += NWAVES * 64) ((LAS unsigned*)(F.lds + LDSCTL_OFF))[u] = 0u;
    __syncthreads();
    XcdBarrier bar; bar.bar = (unsigned*)(F.ctl + CW_BAR); bar.x = 0; bar.st = nullptr;
    if (MK_N_LAUNCHES == 1) bar = xcd_barrier_post((unsigned*)(F.ctl + CW_BAR), MISC + 8);
    const int lo = args.ph_lo, hi = args.ph_hi;
#define IN(k) (lo <= (k) && (k) < hi)
#define SEAM(k) do { if (IN(k) && IN((k) + 1)) { xcd_barrier(bar); if (REP_BAR > 1) xcd_barrier(bar); } } while (0)
    const float* MOD = (const float*)(ws + WS_MOD);
    const float* TAB = (const float*)(ws + WS_TAB);
    float* X = (float*)(ws + WS_X);
    bf16* HN = (bf16*)(ws + WS_HN);
    bf16* ACT = (bf16*)(ws + WS_ACT);

    if (IN(0)) { p0_prologue(args, F); }
    SEAM(0);

    for (int layer = 0; layer < DEPTH; ++layer) {
        const int pb = 1 + 8 * layer;
        const bool last = (layer == DEPTH - 1), hg = (layer & 1) != 0;
        const int j = layer >> 1;
        const int Mr = last ? ML : M;
        const float* modl = MOD + (size_t)layer * 5 * MOD_LD;
        unsigned char* wb = ws + WS_W + (size_t)layer * W_LAYER;
        if (IN(pb + 0)) for (int rep = 0; rep < REP_NORM; ++rep) norm_mod_phase(args, F, args.in[6] + (size_t)layer * D, modl, 0, D, M, layer > 0 ? (modl - 5 * MOD_LD) + 4 * MOD_LD + 5 * D : nullptr, layer > 0 ? X : args.in[0], layer > 0 ? X + (size_t)ML * D : args.in[2]);
        SEAM(pb + 0);
        if (!hg) {
            if (IN(pb + 1)) {
                pg8::Gemm g{HN, (const bf16*)(wb + W_IN), M, 4 * D, D, D, D}; pg8::StaticOrder S; S.init(M, 4 * D, F.G, (int)blockIdx.x);
                pg8::EpiRetIn E{ACT, ACT_STRIDE, TAB + TAB_COS / 4, TAB + TAB_SIN / 4, NLP};
                for (int rep = 0; rep < REP_GEMM_IN; ++rep) pg8::gemm_phase<pg8::EpiRetIn, pg8::StaticOrder, GEMM_ALIGN, GEMM_SP2>(F.lds, g, S, E);
            }
            SEAM(pb + 1);
            if (IN(pb + 2)) for (int rep = 0; rep < REP_MIX_RET; ++rep) { if (MIX_RET_V3) mixer_ret3(args, F, j, !last); else if (MIX_MFMA_RET) mixer_mfma<false>(args, F, j, !last); else mixer_phase<false>(args, F, j, !last); if (MXV_RET) mixer_mfma<false, MXV_RET>(args, F, j, !last); }
            SEAM(pb + 2);
            if (IN(pb + 3)) for (int rep = 0; rep < REP_READ; ++rep) readout_phase<false>(args, F, nullptr, Mr);
            SEAM(pb + 3);
        } else {
            if (IN(pb + 1)) {
                pg8::Gemm g{HN, (const bf16*)(wb + W_IN), M, 5 * D, D, D, D}; pg8::StaticOrder S; S.init(M, 5 * D, F.G, (int)blockIdx.x);
                pg8::EpiHgIn E{ACT, ACT_STRIDE, TAB + TAB_LB / 4 + (size_t)j * D};
                for (int rep = 0; rep < REP_GEMM_IN; ++rep) pg8::gemm_phase<pg8::EpiHgIn, pg8::StaticOrder, GEMM_ALIGN, GEMM_SP2>(F.lds, g, S, E);
            }
            SEAM(pb + 1);
            if (IN(pb + 2)) for (int rep = 0; rep < REP_MIX_HG; ++rep) { if (MIX_HG_V2) mixer_hg2(args, F, !last); else if (MIX_MFMA_HG) mixer_mfma<true>(args, F, j, !last); else mixer_phase<true>(args, F, j, !last); if (MXV_HG) mixer_mfma<true, MXV_HG>(args, F, j, !last); }
            SEAM(pb + 2);
            if (IN(pb + 3)) for (int rep = 0; rep < REP_READ; ++rep) readout_phase<true>(args, F, args.in[13] + (size_t)j * D, Mr);
            SEAM(pb + 3);
        }
        if (IN(pb + 4)) {
            pg8::Gemm g{HN, (const bf16*)(wb + W_OUT), ML, D, D, D, D}; pg8::StaticOrder S; S.init(ML, D, F.G, (int)blockIdx.x);
            pg8::EpiResid E{X, layer > 0 ? X : args.in[0], modl + 2 * D, MOD_LD, NLP};
            if (REP_RESID > 1) { pg8::EpiResid E0{X, X, (const float*)(ws + WS_CTL + 512 * 1024), 0, NLP}; pg8::gemm_phase<pg8::EpiResid, pg8::StaticOrder, RESID_ALIGN, GEMM_SP2>(F.lds, g, S, E0); }
            pg8::gemm_phase<pg8::EpiResid, pg8::StaticOrder, RESID_ALIGN, GEMM_SP2>(F.lds, g, S, E);
            if (!last) {
                pg8::Gemm g2{HN, (const bf16*)(wb + W_OUT), M, D, D / 4, D, D}; pg8::SplitKOrder S2{F.G, (int)blockIdx.x, NLP, D / 4};
                pg8::EpiSlab E2{(float*)(ws + WS_SLAB), NLP, D / 4, (size_t)MC * D};
                pg8::gemm_phase<pg8::EpiSlab, pg8::SplitKOrder, true, true>(F.lds, g2, S2, E2);
            }
        }
        SEAM(pb + 4);
        if (IN(pb + 5)) for (int rep = 0; rep < REP_NORM; ++rep) norm_mod_phase(args, F, args.in[7] + (size_t)layer * D, modl, 3 * D, 4 * D, Mr, last ? nullptr : modl + 4 * MOD_LD + 2 * D, X, layer > 0 ? X + (size_t)ML * D : args.in[2]);
        SEAM(pb + 5);
        if (IN(pb + 6)) {
            pg8::Gemm g{HN, (const bf16*)(wb + W_GU), Mr, 2 * FF, D, D, D}; pg8::StaticOrder S; S.init(Mr, 2 * FF, F.G, (int)blockIdx.x, GU_WGM);
            if (KPROBE_GU) { pg8::TwiceOrder S2; S2.init(Mr, 2 * FF, F.G, (int)blockIdx.x); pg8::EpiGateUp E{ACT, FF, 0.5f}; pg8::gemm_phase<pg8::EpiGateUp, pg8::TwiceOrder, true, true>(F.lds, g, S2, E); }
            else { pg8::EpiGateUp E{ACT, FF, 1.0f};
            for (int rep = 0; rep < REP_GU; ++rep) pg8::gemm_phase<pg8::EpiGateUp, pg8::StaticOrder, GEMM_ALIGN, GEMM_SP2>(F.lds, g, S, E); }
        }
        SEAM(pb + 6);
        if (IN(pb + 7)) {
            pg8::Gemm g{ACT, (const bf16*)(wb + W_DN), ML, D, FF, FF, FF}; pg8::StaticOrder S; S.init(ML, D, F.G, (int)blockIdx.x);
            pg8::EpiResid E{X, X, modl + 5 * D, MOD_LD, NLP};
            if (REP_RESID > 1) { pg8::EpiResid E0{X, X, (const float*)(ws + WS_CTL + 512 * 1024), 0, NLP}; pg8::gemm_phase<pg8::EpiResid, pg8::StaticOrder, RESID_ALIGN, GEMM_SP2>(F.lds, g, S, E0); }
            pg8::gemm_phase<pg8::EpiResid, pg8::StaticOrder, RESID_ALIGN, GEMM_SP2>(F.lds, g, S, E);
            if (!last) {
                pg8::Gemm g2{ACT, (const bf16*)(wb + W_DN), M, D, FF / 4, FF, FF}; pg8::SplitKOrder S2{F.G, (int)blockIdx.x, NLP, FF / 4};
                pg8::EpiSlab E2{(float*)(ws + WS_SLAB), NLP, FF / 4, (size_t)MC * D};
                pg8::gemm_phase<pg8::EpiSlab, pg8::SplitKOrder, true, true>(F.lds, g2, S2, E2);
            }
        }
        SEAM(pb + 7);
    }
    if (IN(N_PHASES - 1)) final_norm_phase(args, F);
#undef IN
#undef SEAM
}

extern "C" void kernel_launch(void* const* d_in, const int* in_sizes, int n_in, void* d_out, int out_size, void* d_ws, size_t ws_size, hipStream_t stream) {
    static int grid = 0;
    if (grid == 0) {
        if (n_in != 18 || in_sizes[0] != ML * D || out_size != ML * D || ws_size < WS_END) { fprintf(stderr, "kernel_launch: unexpected shapes (n_in %d, in0 %d, out %d, ws %zu < %zu); nothing launched\n", n_in, n_in > 0 ? in_sizes[0] : -1, out_size, ws_size, (size_t)WS_END); grid = -1; return; }
        int dev = 0, cus = 0, per_cu = 0;
        if (hipGetDevice(&dev) != hipSuccess || hipDeviceGetAttribute(&cus, hipDeviceAttributeMultiprocessorCount, dev) != hipSuccess) { grid = -1; return; }
        if (hipFuncSetAttribute((const void*)fwd_kernel, hipFuncAttributeMaxDynamicSharedMemorySize, LDS_BYTES) != hipSuccess) { fprintf(stderr, "kernel_launch: hipFuncSetAttribute failed\n"); grid = -1; return; }
        if (hipOccupancyMaxActiveBlocksPerMultiprocessor(&per_cu, (const void*)fwd_kernel, NWAVES * 64, LDS_BYTES) != hipSuccess || per_cu < 1) { fprintf(stderr, "kernel_launch: occupancy query says %d blocks per CU\n", per_cu); (void)hipGetLastError(); grid = -1; return; }
        grid = cus;
    }
    if (grid < 0) return;
    if (hipMemsetAsync((char*)d_ws, 0, ZERO_BYTES, stream) != hipSuccess) return;
    Args a{};
    for (int i = 0; i < 18; ++i) a.in[i] = (const float*)d_in[i];
    a.out = (float*)d_out; a.ws = (unsigned char*)d_ws;
    if (MK_N_LAUNCHES == 1) {
        a.ph_lo = 0; a.ph_hi = N_PHASES;
        hipLaunchKernelGGL(fwd_kernel, dim3(grid), dim3(NWAVES * 64), LDS_BYTES, stream, a);
    } else {
        for (int p = 0; p < N_PHASES; ++p) { a.ph_lo = p; a.ph_hi = p + 1; hipLaunchKernelGGL(fwd_kernel, dim3(grid), dim3(NWAVES * 64), LDS_BYTES, stream, a); }
    }
}
```

```cpp
#include <hip/hip_runtime.h>
#include <cstdio>
#include <cstdint>
#ifndef REP_EPI
#define REP_EPI 1
#endif
#ifndef REP_PRO
#define REP_PRO 1
#endif
#ifndef REP_BAR
#define REP_BAR 1
#endif
#ifndef RESID_ATOMIC
#define RESID_ATOMIC 1
#endif
#ifndef REP_RESID
#define REP_RESID 1
#endif
#ifndef MXP_STG
#define MXP_STG 1
#endif
#ifndef MXP_S1
#define MXP_S1 1
#endif
#ifndef MXP_S2
#define MXP_S2 1
#endif
#ifndef MX_PF_HG
#define MX_PF_HG 1
#endif
#ifndef MX_PF_RET
#define MX_PF_RET 1
#endif
#ifndef MXP_SLEEP
#define MXP_SLEEP 0
#endif
#ifndef MXP_BAR
#define MXP_BAR 1
#endif
#ifndef MXV_RET
#define MXV_RET 0
#endif
#ifndef MXV_HG
#define MXV_HG 0
#endif
#ifndef REP_BIAS
#define REP_BIAS 1
#endif
#ifndef KPROBE_GU
#define KPROBE_GU 0
#endif
#ifndef STEAL_TICKS_UNIT
#define STEAL_TICKS_UNIT 4000u
#endif
#ifndef STEAL_TICKS_OUT
#define STEAL_TICKS_OUT 900u
#endif
#ifndef STEAL_TICKS_DOWN
#define STEAL_TICKS_DOWN 2800u
#endif
#ifndef STEAL_BATCH
#define STEAL_BATCH 4
#endif
#ifndef RESID_ALIGN
#define RESID_ALIGN false
#endif
#ifndef GEMM_ALIGN
#define GEMM_ALIGN true
#endif
#ifndef PG8_WGM
#define PG8_WGM 4
#endif
#ifndef GEMM_SP2
#define GEMM_SP2 true
#endif
#ifndef PG8_ROUND_MAJOR
#define PG8_ROUND_MAJOR 1
#endif
#ifndef PRO_NT
#define PRO_NT 1
#endif
#ifndef WT_STORES
#define WT_STORES 0
#endif
#ifndef GU_WGM
#define GU_WGM 8
#endif
#ifndef EW_NT
#define EW_NT 1
#endif
#ifndef EPI_NT
#define EPI_NT 0
#endif
#ifndef RESID_NT
#define RESID_NT 0
#endif
#ifndef ST16_GLOBAL
#define ST16_GLOBAL 1
#endif
#ifndef TAIL_CONVERT
#define TAIL_CONVERT 1
#endif
#ifndef WT_NT_ST
#define WT_NT_ST 1
#endif
#ifndef EPI_DRAIN_OVERLAP
#define EPI_DRAIN_OVERLAP 1
#endif
#ifndef XRES_F16
#define XRES_F16 1
#endif
#ifndef NORM_PIPE
#define NORM_PIPE 1
#endif

#define TIDTAB_OFF 132416
#define MK_LAS __attribute__((address_space(3)))
__device__ __forceinline__ unsigned mk_hwkey() { unsigned hw; asm volatile("s_getreg_b32 %0, hwreg(HW_REG_HW_ID, 0, 6)" : "=s"(hw)); return hw; }
__device__ __forceinline__ int mk_wave() {
    extern __shared__ __attribute__((aligned(16))) unsigned char lds[];
    const unsigned hw = mk_hwkey();
    return __builtin_amdgcn_readfirstlane((int)*(volatile MK_LAS unsigned*)((MK_LAS unsigned char*)lds + TIDTAB_OFF + 4 * hw));
}
__device__ __forceinline__ int mk_lane() { int l; asm volatile("v_mbcnt_lo_u32_b32 %0, -1, 0\n\tv_mbcnt_hi_u32_b32 %0, -1, %0" : "=v"(l)); return l; }
__device__ __forceinline__ int mk_tid() { return mk_wave() * 64 + mk_lane(); }
namespace pg8 {
#define PG8_LAS __attribute__((address_space(3)))
typedef unsigned short bf16_t;
typedef short bf16x8 __attribute__((ext_vector_type(8)));
typedef float f32x4 __attribute__((ext_vector_type(4)));
typedef unsigned u32x4 __attribute__((ext_vector_type(4)));
constexpr int BM = 256, BK = 64, HALF = 128, HTB = HALF * BK * 2  , STAGE_BYTES = 8 * HTB, NXCD = 8, WGM = PG8_WGM;

__host__ __device__ __forceinline__ int lds_byte(int r, int c) { const int st = (r >> 4) * 2 + (c >> 5), rr = r & 15, cc = c & 31, ob = rr * 64 + cc * 2; return st * 1024 + (ob ^ (((ob >> 9) & 1) << 5)); }
__host__ __device__ __forceinline__ void stage_rc(int b, int& R, int& C) { const int st = b / 1024, sb = b % 1024, swz = sb ^ (((sb >> 9) & 1) << 5); R = (st >> 1) * 16 + swz / 64; C = (st & 1) * 32 + (swz % 64) / 2; }
__host__ __device__ __forceinline__ int perm32(int rho) { const int n = rho >> 4, i = rho & 15; return 8 * (i >> 2) + 4 * n + (i & 3); }

struct Unit { int pm, pn, k0; };
struct Gemm { const bf16_t* A; const bf16_t* Bt; int M, N, K, lda, ldb; };

struct StaticOrder {
    static constexpr bool KTWICE = false;
    int nM, nN, nwg, G, c, wgm;
    __host__ __device__ void init(int M, int N, int G_, int c_, int wgm_ = WGM) { nM = M / BM; nN = N / BM; nwg = nM * nN; G = G_; c = c_; wgm = wgm_; }
    __host__ __device__ bool next(int i, Unit& u) const {
        const long L = (long)i * G + c; if (!(PG8_ROUND_MAJOR && G % NXCD == 0) && L >= nwg) return false; if ((long)i * G >= nwg) return false;
        int wgid = (int)L;
        if (PG8_ROUND_MAJOR && G % NXCD == 0) { const int per = G / NXCD; wgid = ((i * NXCD) + (c % NXCD)) * per + (c / NXCD); if (wgid >= nwg) return false; }
        else { const int q = nwg / NXCD, r = nwg % NXCD, xcd = wgid % NXCD, off = wgid / NXCD; wgid = (xcd < r ? xcd * (q + 1) : r * (q + 1) + (xcd - r) * q) + off; }
        const int nig = wgm * nN, gid = wgid / nig, fm = gid * wgm, gsz = (nM - fm) < wgm ? (nM - fm) : wgm;
        u.pm = fm + ((wgid % nig) % gsz); u.pn = (wgid % nig) / gsz; u.k0 = 0; return true;
    }
    __device__ __forceinline__ void a_ready(const Unit&) const {}
    __device__ __forceinline__ void done(const Unit&) const {}
};
struct TwiceOrder : StaticOrder {
    static constexpr bool KTWICE = true;
    __host__ __device__ bool next(int i, Unit& u) const { return StaticOrder::next(i >> 1, u); }
};
struct SplitKOrder {
    static constexpr bool KTWICE = false;
    int G, c, pm0, ksub;
    __device__ __forceinline__ bool next(int i, Unit& u) const { const int s = i * G + c; if (s >= 128) return false; const int t = s >> 2; u.pm = pm0 + (t & 3); u.pn = t >> 2; u.k0 = (s & 3) * ksub; return true; }
    __device__ __forceinline__ void a_ready(const Unit&) const {}
    __device__ __forceinline__ void done(const Unit&) const {}
};
__device__ __forceinline__ unsigned cvt_pk_bf16(float lo, float hi) { unsigned r; asm volatile("v_cvt_pk_bf16_f32 %0, %1, %2" : "=v"(r) : "v"(lo), "v"(hi)); return r; }
#define PG8_GAS __attribute__((address_space(1)))
#if ST16_GLOBAL
#define ST16_AS PG8_GAS
#else
#define ST16_AS
#endif
__device__ __forceinline__ float fast_sigmoid(float x) { return __builtin_amdgcn_rcpf(1.0f + __expf(-x)); }
__device__ __forceinline__ f32x4 silu4(f32x4 v) { f32x4 o; o[0] = v[0] * fast_sigmoid(v[0]); o[1] = v[1] * fast_sigmoid(v[1]); o[2] = v[2] * fast_sigmoid(v[2]); o[3] = v[3] * fast_sigmoid(v[3]); return o; }
__device__ __forceinline__ f32x4 sigm4(f32x4 v) { f32x4 o; o[0] = fast_sigmoid(v[0]); o[1] = fast_sigmoid(v[1]); o[2] = fast_sigmoid(v[2]); o[3] = fast_sigmoid(v[3]); return o; }
template <typename T> __device__ __forceinline__ void st16(T* base, unsigned elem_off, u32x4 v) {
#if WT_STORES
    const __amdgpu_buffer_rsrc_t r = __builtin_amdgcn_make_buffer_rsrc(base, 0, 0x7fffffff, 0x00020000);
    __builtin_amdgcn_raw_buffer_store_b128(v, r, (int)(elem_off * sizeof(T)), 0, 16);
#elif EPI_NT
    __builtin_nontemporal_store(v, (u32x4*)(base + elem_off));
#else
    *(ST16_AS u32x4*)((ST16_AS char*)base + (size_t)(elem_off * (unsigned)sizeof(T))) = v;
#endif
}
__device__ __forceinline__ u32x4 pack8(f32x4 v0, f32x4 v1) { u32x4 w; w.x = cvt_pk_bf16(v0[0], v0[1]); w.y = cvt_pk_bf16(v0[2], v0[3]); w.z = cvt_pk_bf16(v1[0], v1[1]); w.w = cvt_pk_bf16(v1[2], v1[3]); return w; }

struct EpiRetIn {
    static constexpr bool PERM = true, AFTER_DRAIN = false, REP2 = false;
    static constexpr bool DRAIN_OK = true;
    static constexpr int NVM = 16;
    bf16_t* act; size_t tstride; const float* cosT; const float* sinT; int n_lat_panels;
    __device__ __forceinline__ void store_rows(const f32x4& a0, const f32x4& a1, const f32x4& b0, const f32x4& b1, int type, bf16_t* base, size_t off) const {
        f32x4 x0 = a0, x1 = a1, y0 = b0, y1 = b1;
        if (type == 1) { x0 = x0 * 0.0625f; x1 = x1 * 0.0625f; y0 = y0 * 0.0625f; y1 = y1 * 0.0625f; }
        if (type == 3) { x0 = silu4(x0); x1 = silu4(x1); y0 = silu4(y0); y1 = silu4(y1); }
        st16(base, off, pack8(x0, x1));
        st16(base, off + HALF, pack8(y0, y1));
    }
    __device__ __forceinline__ void operator()(const f32x4 (&acc)[2][2][4][2], const Unit& u, int wr, int wc, int fr_in, int fq_in) const {
        int fr = fr_in, fq = fq_in; asm volatile("" : "+v"(fr), "+v"(fq));
        const int type = u.pn >> 3, head = u.pn & 7;
        bf16_t* base = act + (size_t)type * tstride; const size_t coff = head * 256 + wc * 32 + 8 * fq;
        const int row0 = u.pm * BM + wr * 64 + fr;
        const bool rope = (type < 2) && (u.pm < n_lat_panels);
        const int fidx = (wc & 1) * 32 + 8 * fq;
        if (!rope) {
#pragma unroll
            for (int ai = 0; ai < 2; ++ai)
#pragma unroll
                for (int m = 0; m < 4; ++m) store_rows(acc[ai][0][m][0], acc[ai][0][m][1], acc[ai][1][m][0], acc[ai][1][m][1], type, base, (size_t)(row0 + ai * HALF + m * 16) * 2048 + coff);
        } else if (wc < 2) {
#pragma unroll
            for (int ai = 0; ai < 2; ++ai) {
                const int pos = (4 * u.pm + 2 * ai + wr) & 63;
                const f32x4 c0 = *(const PG8_GAS f32x4*)(cosT + pos * 64 + fidx), c1 = *(const PG8_GAS f32x4*)(cosT + pos * 64 + fidx + 4), s0 = *(const PG8_GAS f32x4*)(sinT + pos * 64 + fidx), s1 = *(const PG8_GAS f32x4*)(sinT + pos * 64 + fidx + 4);
#pragma unroll
                for (int m = 0; m < 4; ++m) { const f32x4 a0 = acc[ai][0][m][0], a1 = acc[ai][0][m][1], b0 = acc[ai][1][m][0], b1 = acc[ai][1][m][1];
                    store_rows(a0 * c0 - b0 * s0, a1 * c1 - b1 * s1, a0 * s0 + b0 * c0, a1 * s1 + b1 * c1, type, base, (size_t)(row0 + ai * HALF + m * 16) * 2048 + coff); }
            }
        } else {
#pragma unroll
            for (int m = 0; m < 4; ++m) {
                const int pos = 16 * m + fr;
                const f32x4 c0 = *(const PG8_GAS f32x4*)(cosT + pos * 64 + fidx), c1 = *(const PG8_GAS f32x4*)(cosT + pos * 64 + fidx + 4), s0 = *(const PG8_GAS f32x4*)(sinT + pos * 64 + fidx), s1 = *(const PG8_GAS f32x4*)(sinT + pos * 64 + fidx + 4);
#pragma unroll
                for (int ai = 0; ai < 2; ++ai) { const f32x4 a0 = acc[ai][0][m][0], a1 = acc[ai][0][m][1], b0 = acc[ai][1][m][0], b1 = acc[ai][1][m][1];
                    store_rows(a0 * c0 - b0 * s0, a1 * c1 - b1 * s1, a0 * s0 + b0 * c0, a1 * s1 + b1 * c1, type, base, (size_t)(row0 + ai * HALF + m * 16) * 2048 + coff); }
            }
        }
    }
};

struct EpiHgIn {
    static constexpr bool PERM = true, AFTER_DRAIN = false, REP2 = false;
    static constexpr bool DRAIN_OK = true;
    static constexpr int NVM = 16;
    bf16_t* act; size_t tstride; const float* lb;
    __device__ __forceinline__ void operator()(const f32x4 (&acc)[2][2][4][2], const Unit& u, int wr, int wc, int fr_in, int fq_in) const {
        int fr = fr_in, fq = fq_in; asm volatile("" : "+v"(fr), "+v"(fq));
        const int type = u.pn >> 3, cb = (u.pn & 7) * 256 + wc * 32 + 8 * fq;
        const int row0 = u.pm * BM + wr * 64 + fr;
        const int slot = (type == 0) ? 0 : (type == 1) ? 1 : (type == 2) ? 3 : (type == 3) ? 5 : 6;
        bf16_t* base = act + (size_t)slot * tstride;
        f32x4 lbv[2][2];
#pragma unroll
        for (int bj = 0; bj < 2; ++bj)
#pragma unroll
            for (int n = 0; n < 2; ++n) lbv[bj][n] = (type == 1 || type == 2) ? *(const PG8_GAS f32x4*)(lb + cb + bj * HALF + 4 * n) : (f32x4){0.f, 0.f, 0.f, 0.f};
#pragma unroll
        for (int ai = 0; ai < 2; ++ai)
#pragma unroll
            for (int m = 0; m < 4; ++m) {
                const int r = row0 + ai * HALF + m * 16;
                const size_t roff = (size_t)r * 2048 + cb;
#pragma unroll
                for (int bj = 0; bj < 2; ++bj) {
                    f32x4 v0 = acc[ai][bj][m][0], v1 = acc[ai][bj][m][1];
                    if (type == 0) { v0 = silu4(v0); v1 = silu4(v1); }
                    if (type == 4) { v0 = sigm4(v0); v1 = sigm4(v1); }
                    if (type == 1 || type == 2) {
                        f32x4 k0, k1;
#pragma unroll
                        for (int j = 0; j < 4; ++j) {
                            { const float z = fminf(fmaxf(v0[j], -80.f), 80.f), e = __expf(-z), sg = __builtin_amdgcn_rcpf(1.0f + e), l = lbv[bj][0][j];
                              v0[j] = __logf(l + (1.0f - l) * sg); k0[j] = (1.0f - l) * (e * sg); }
                            { const float z = fminf(fmaxf(v1[j], -80.f), 80.f), e = __expf(-z), sg = __builtin_amdgcn_rcpf(1.0f + e), l = lbv[bj][1][j];
                              v1[j] = __logf(l + (1.0f - l) * sg); k1[j] = (1.0f - l) * (e * sg); }
                        }
                        st16(base + tstride, roff + bj * HALF, pack8(k0, k1));
                    }
                    st16(base, roff + bj * HALF, pack8(v0, v1));
                }
            }
    }
};

typedef _Float16 x_h2 __attribute__((ext_vector_type(2)));
typedef float x_f2 __attribute__((ext_vector_type(2)));
__device__ __forceinline__ float x_lo(unsigned w) { if (XRES_F16) { const x_h2 h = __builtin_bit_cast(x_h2, w); return (float)h[0]; } return __builtin_bit_cast(float, w << 16); }
__device__ __forceinline__ float x_hi(unsigned w) { if (XRES_F16) { const x_h2 h = __builtin_bit_cast(x_h2, w); return (float)h[1]; } return __builtin_bit_cast(float, w & 0xffff0000u); }
__device__ __forceinline__ unsigned x_pk(float lo, float hi) { if (XRES_F16) { const x_f2 v = {lo, hi}; const x_h2 h = __builtin_convertvector(v, x_h2); return __builtin_bit_cast(unsigned, h); } return cvt_pk_bf16(lo, hi); }
__device__ __forceinline__ u32x4 x_pack8(f32x4 v0, f32x4 v1) { u32x4 w; w.x = x_pk(v0[0], v0[1]); w.y = x_pk(v0[2], v0[3]); w.z = x_pk(v1[0], v1[1]); w.w = x_pk(v1[2], v1[3]); return w; }
struct EpiResid {
    static constexpr bool PERM = true, AFTER_DRAIN = false, REP2 = false;
    static constexpr bool DRAIN_OK = true;
    static constexpr int NVM = 36;
    bf16_t* X; const float* gate; int gstride; int n_lat_panels;
    __device__ __forceinline__ void operator()(const f32x4 (&acc)[2][2][4][2], const Unit& u, int wr, int wc, int fr, int fq) const {
        const int row0 = u.pm * BM + wr * 64 + fr, col0 = u.pn * BM + wc * 32 + 8 * fq;
        const int b = (u.pm < n_lat_panels) ? (u.pm >> 4) : 4;
        const float* g = gate + (size_t)b * gstride + col0;
        bf16_t* xb = X + (size_t)row0 * 2048 + col0;
        f32x4 gv[2][2];
#pragma unroll
        for (int bj = 0; bj < 2; ++bj)
#pragma unroll
            for (int n = 0; n < 2; ++n) gv[bj][n] = *(const f32x4*)(g + bj * HALF + 4 * n);
        u32x4 xa[2][2], xc[2][2];
#define ER_LOAD(dst, ai, mp) do { _Pragma("unroll") for (int mm = 0; mm < 2; ++mm) _Pragma("unroll") for (int bj = 0; bj < 2; ++bj) \
            dst[mm][bj] = *(const u32x4*)(xb + (size_t)((ai) * HALF + (2 * (mp) + mm) * 16) * 2048 + bj * HALF); } while (0)
#define ER_STORE(src, ai, mp) do { _Pragma("unroll") for (int mm = 0; mm < 2; ++mm) _Pragma("unroll") for (int bj = 0; bj < 2; ++bj) { const u32x4 w_ = src[mm][bj]; \
            const f32x4 lo_ = (f32x4){x_lo(w_.x), x_hi(w_.x), x_lo(w_.y), x_hi(w_.y)} + gv[bj][0] * acc[ai][bj][2 * (mp) + mm][0]; \
            const f32x4 hi_ = (f32x4){x_lo(w_.z), x_hi(w_.z), x_lo(w_.w), x_hi(w_.w)} + gv[bj][1] * acc[ai][bj][2 * (mp) + mm][1]; \
            *(u32x4*)(xb + (size_t)((ai) * HALF + (2 * (mp) + mm) * 16) * 2048 + bj * HALF) = x_pack8(lo_, hi_); } } while (0)
        ER_LOAD(xa, 0, 0); ER_LOAD(xc, 0, 1);
        ER_STORE(xa, 0, 0); ER_LOAD(xa, 1, 0);
        ER_STORE(xc, 0, 1); ER_LOAD(xc, 1, 1);
        ER_STORE(xa, 1, 0); ER_STORE(xc, 1, 1);
#undef ER_LOAD
#undef ER_STORE
    }
};

struct EpiGateUp {
    static constexpr bool PERM = true, AFTER_DRAIN = false, REP2 = true;
    static constexpr bool DRAIN_OK = true;
    static constexpr int NVM = 8;
    bf16_t* H; int ldh; float pre;
    __device__ __forceinline__ void operator()(const f32x4 (&acc)[2][2][4][2], const Unit& u, int wr, int wc, int fr, int fq) const {
        const int row0 = u.pm * BM + wr * 64 + fr, col0 = u.pn * HALF + wc * 32 + 8 * fq;
#pragma unroll
        for (int ai = 0; ai < 2; ++ai)
#pragma unroll
            for (int m = 0; m < 4; ++m) {
                const f32x4 h0 = silu4(acc[ai][0][m][0] * pre) * (acc[ai][1][m][0] * pre), h1 = silu4(acc[ai][0][m][1] * pre) * (acc[ai][1][m][1] * pre);
                st16(H, (size_t)(row0 + ai * HALF + m * 16) * ldh + col0, pack8(h0, h1));
            }
    }
};


struct EpiSlab {
    static constexpr bool PERM = false, AFTER_DRAIN = false, REP2 = false;
    static constexpr bool DRAIN_OK = true;
    static constexpr int NVM = 32;
    float* slab; int pm0, ksub; size_t kstride;
    __device__ __forceinline__ void operator()(const f32x4 (&acc)[2][2][4][2], const Unit& u, int wr, int wc, int fr, int fq) const {
        float* base = slab + (size_t)(u.k0 / ksub) * kstride + (size_t)((u.pm - pm0) * BM + wr * 64 + fr) * 2048 + u.pn * BM + wc * 32 + 4 * fq;
#pragma unroll
        for (int ai = 0; ai < 2; ++ai)
#pragma unroll
            for (int m = 0; m < 4; ++m) { float* rowp = base + (size_t)(ai * HALF + m * 16) * 2048;
#pragma unroll
                for (int bj = 0; bj < 2; ++bj)
#pragma unroll
                    for (int n = 0; n < 2; ++n) *(PG8_GAS f32x4*)(rowp + bj * HALF + n * 16) = acc[ai][bj][m][n]; }
    }
};
template <class Epi, class Sched, bool ALIGN_EPI = false, bool SP2 = false>
__device__ __forceinline__ void gemm_phase(PG8_LAS unsigned char* lds, const Gemm g, const Sched& S, const Epi& E) {
    int tid_ = mk_tid(); asm volatile("" : "+v"(tid_));
    const int tid = tid_, wid = __builtin_amdgcn_readfirstlane(tid >> 6), lane = tid & 63, wr = wid >> 2, wc = wid & 3, fr = lane & 15, fq = lane >> 4;
    const int K = g.K, nt = K / BK;
    unsigned voffA[2], voffB[2];
#pragma unroll
    for (int i = 0; i < 2; ++i) { int R, C; stage_rc(tid * 16 + i * 8192, R, C); const int Rb = Epi::PERM ? ((R & ~31) + perm32(R & 31)) : R;
        voffA[i] = (unsigned)(R * g.lda + C) * 2u; voffB[i] = (unsigned)(Rb * g.ldb + C) * 2u; }
    const size_t kstep = (size_t)(BK * 2);
    const size_t hsA = (size_t)HALF * g.lda * 2, hsB = (size_t)HALF * g.ldb * 2;
    const size_t tsA = 2 * hsA, tsB = 2 * hsB;
    const unsigned ldsbase = (unsigned)(unsigned long long)lds;
    const unsigned ldsw = (unsigned)wid * 1024u;
    const int aoff = lds_byte(wr * 64 + fr, fq * 8), boff = lds_byte(wc * 32 + fr, fq * 8);
#define PG8_SA(b, h) (((b) * 2 + (h)) * HTB)
#define PG8_SB(b, h) ((4 + (b) * 2 + (h)) * HTB)
#define PG8_STAGE(bufoff, gbase, voff) do { _Pragma("unroll") for (int _i = 0; _i < 2; ++_i) { \
        const unsigned m0_ = ldsbase + (unsigned)(bufoff) + ldsw + (unsigned)_i * 8192u; \
        asm volatile("s_mov_b32 m0, %2\n\ts_nop 0\n\tglobal_load_lds_dwordx4 %0, %1" :: "v"((voff)[_i]), "s"((const char*)(gbase)), "s"(m0_) : "memory", "m0"); } } while (0)
#define PG8_LDA(dst, b, h) do { _Pragma("unroll") for (int m = 0; m < 4; ++m) _Pragma("unroll") for (int k = 0; k < 2; ++k) dst[m][k] = *(const PG8_LAS bf16x8*)(lds + PG8_SA(b, h) + aoff + m * 2048 + k * 1024); } while (0)
#define PG8_LDB(dst, b, h) do { _Pragma("unroll") for (int n = 0; n < 2; ++n) _Pragma("unroll") for (int k = 0; k < 2; ++k) dst[n][k] = *(const PG8_LAS bf16x8*)(lds + PG8_SB(b, h) + boff + n * 2048 + k * 1024); } while (0)
#define PG8_MMA(ai, bj, At, Bt) do { __builtin_amdgcn_s_setprio(1); _Pragma("unroll") for (int m = 0; m < 4; ++m) _Pragma("unroll") for (int n = 0; n < 2; ++n) _Pragma("unroll") for (int k = 0; k < 2; ++k) \
        acc[ai][bj][m][n] = __builtin_amdgcn_mfma_f32_16x16x32_bf16(Bt[n][k], At[m][k], acc[ai][bj][m][n], 0, 0, 0); __builtin_amdgcn_s_setprio(0); } while (0)
#define PG8_WAIT_V(n) asm volatile("s_waitcnt vmcnt(" #n ")" ::: "memory")
#define PG8_WAIT_L(n) asm volatile("s_waitcnt lgkmcnt(" #n ")" ::: "memory")
#define PG8_BAR __builtin_amdgcn_s_barrier()
#define PG8_SCHED __builtin_amdgcn_sched_barrier(0)
    Unit cur, nxt; int ui = 0; bool epi_ran = false;
    if (!S.next(0, cur)) return;
    f32x4 acc[2][2][4][2];
#pragma unroll
    for (int a = 0; a < 2; ++a)
#pragma unroll
        for (int b = 0; b < 2; ++b)
#pragma unroll
            for (int m = 0; m < 4; ++m)
#pragma unroll
                for (int n = 0; n < 2; ++n) acc[a][b][m][n] = (f32x4){0.f, 0.f, 0.f, 0.f};
    bf16x8 At[4][2], B0[2][2], B1[2][2];
    const char* cA = (const char*)g.A + (size_t)cur.pm * tsA + (size_t)cur.k0 * 2; const char* cB = (const char*)g.Bt + (size_t)cur.pn * tsB + (size_t)cur.k0 * 2;
    S.a_ready(cur);
    if constexpr (SP2) {
        PG8_STAGE(PG8_SB(0, 0), cB, voffB); PG8_STAGE(PG8_SB(0, 1), cB + hsB, voffB); PG8_STAGE(PG8_SA(0, 0), cA, voffA); PG8_STAGE(PG8_SA(0, 1), cA + hsA, voffA);
        if (wr == 1) PG8_BAR;
        PG8_WAIT_V(2); PG8_BAR;
        PG8_STAGE(PG8_SB(1, 0), cB + kstep, voffB); PG8_STAGE(PG8_SA(1, 0), cA + kstep, voffA); PG8_STAGE(PG8_SB(1, 1), cB + hsB + kstep, voffB);
        PG8_WAIT_V(6); PG8_BAR;
    } else {
        PG8_STAGE(PG8_SB(0, 0), cB, voffB); PG8_STAGE(PG8_SA(0, 0), cA, voffA); PG8_STAGE(PG8_SB(0, 1), cB + hsB, voffB); PG8_STAGE(PG8_SA(0, 1), cA + hsA, voffA);
        if (wr == 1) PG8_BAR;
        PG8_WAIT_V(4); PG8_BAR;
        PG8_STAGE(PG8_SB(1, 0), cB + kstep, voffB); PG8_STAGE(PG8_SA(1, 0), cA + kstep, voffA); PG8_STAGE(PG8_SB(1, 1), cB + hsB + kstep, voffB);
        PG8_WAIT_V(6); PG8_BAR;
    }
    constexpr bool DRO = SP2 && (EPI_DRAIN_OVERLAP != 0) && !Sched::KTWICE && !Epi::AFTER_DRAIN && Epi::DRAIN_OK;
#define PG8_TRIP(STAGE11, WV) do { \
            PG8_LDB(B0, 0, 0); PG8_LDB(B1, 0, 1); PG8_SCHED; PG8_LDA(At, 0, 0); if (STAGE11) PG8_STAGE(PG8_SA(1, 1), a1 + hsA, voffA); \
            WV; PG8_WAIT_L(0); PG8_BAR; PG8_MMA(0, 0, At, B0); PG8_MMA(0, 1, At, B1); PG8_BAR; PG8_SCHED; \
              \
            PG8_LDA(At, 0, 1); PG8_STAGE(PG8_SB(0, 0), b2, voffB); PG8_STAGE(PG8_SB(0, 1), b2 + hsB, voffB); PG8_STAGE(PG8_SA(0, 0), a2, voffA); \
            WV; PG8_WAIT_L(0); PG8_BAR; PG8_MMA(1, 0, At, B0); PG8_MMA(1, 1, At, B1); PG8_BAR; PG8_SCHED; \
              \
            PG8_LDB(B0, 1, 0); PG8_LDB(B1, 1, 1); PG8_SCHED; PG8_LDA(At, 1, 0); PG8_STAGE(PG8_SA(0, 1), a2 + hsA, voffA); \
            WV; PG8_WAIT_L(0); PG8_BAR; PG8_MMA(0, 0, At, B0); PG8_MMA(0, 1, At, B1); PG8_BAR; PG8_SCHED; \
              \
            PG8_LDA(At, 1, 1); PG8_STAGE(PG8_SB(1, 0), b3, voffB); PG8_STAGE(PG8_SB(1, 1), b3 + hsB, voffB); PG8_STAGE(PG8_SA(1, 0), a3, voffA); \
            PG8_WAIT_V(8); PG8_WAIT_L(0); PG8_BAR; PG8_MMA(1, 0, At, B0); PG8_MMA(1, 1, At, B1); PG8_BAR; PG8_SCHED; } while (0)
    for (;;) {
        const bool has_next = S.next(ui + 1, nxt);
        const char* nA = has_next ? (const char*)g.A + (size_t)nxt.pm * tsA + (size_t)nxt.k0 * 2 : cA; const char* nB = has_next ? (const char*)g.Bt + (size_t)nxt.pn * tsB + (size_t)nxt.k0 * 2 : cB;
        for (int t = (DRO && ui > 0) ? 2 : 0; t < nt; t += 2) {
            const bool last = (t == nt - 2);
            const char* a1 = cA + (size_t)(t + 1) * kstep;
            const char* a2 = last ? nA : cA + (size_t)(t + 2) * kstep; const char* b2 = last ? nB : cB + (size_t)(t + 2) * kstep;
            const char* a3 = a2 + kstep; const char* b3 = b2 + kstep;
            if (last && has_next) S.a_ready(nxt);
            if constexpr (SP2) {
            PG8_TRIP(true, PG8_WAIT_V(8));
            } else {
            PG8_LDB(B0, 0, 0); PG8_SCHED; PG8_LDA(At, 0, 0); PG8_STAGE(PG8_SA(1, 1), a1 + hsA, voffA);
            PG8_WAIT_L(8); PG8_BAR; PG8_WAIT_L(0); PG8_MMA(0, 0, At, B0); PG8_BAR; PG8_SCHED;
            PG8_LDB(B1, 0, 1); PG8_STAGE(PG8_SB(0, 0), b2, voffB);
            PG8_BAR; PG8_WAIT_L(0); PG8_MMA(0, 1, At, B1); PG8_BAR;
            PG8_LDA(At, 0, 1); PG8_STAGE(PG8_SA(0, 0), a2, voffA);
            PG8_BAR; PG8_WAIT_L(0); PG8_MMA(1, 0, At, B0); PG8_BAR; PG8_SCHED;
            PG8_STAGE(PG8_SB(0, 1), b2 + hsB, voffB);
            PG8_WAIT_V(6); PG8_BAR; PG8_MMA(1, 1, At, B1); PG8_BAR;
            PG8_LDB(B0, 1, 0); PG8_SCHED; PG8_LDA(At, 1, 0); PG8_STAGE(PG8_SA(0, 1), a2 + hsA, voffA);
            PG8_WAIT_L(8); PG8_BAR; PG8_WAIT_L(0); PG8_MMA(0, 0, At, B0); PG8_BAR; PG8_SCHED;
            PG8_LDB(B1, 1, 1); PG8_STAGE(PG8_SB(1, 0), b3, voffB);
            PG8_BAR; PG8_WAIT_L(0); PG8_MMA(0, 1, At, B1); PG8_BAR;
            PG8_LDA(At, 1, 1); PG8_STAGE(PG8_SA(1, 0), a3, voffA);
            PG8_BAR; PG8_WAIT_L(0); PG8_MMA(1, 0, At, B0); PG8_BAR; PG8_SCHED;
            PG8_STAGE(PG8_SB(1, 1), b3 + hsB, voffB);
            PG8_WAIT_V(6); PG8_BAR; PG8_MMA(1, 1, At, B1); PG8_BAR;
            }
        }
        if constexpr (DRO) { asm volatile("" ::: "memory"); PG8_STAGE(PG8_SA(1, 1), nA + kstep + hsA, voffA); asm volatile("" ::: "memory"); }
        const bool kp_first = Sched::KTWICE && ((ui & 1) == 0);
        (void)epi_ran;
        if constexpr (ALIGN_EPI) { if (wr == 0) PG8_BAR; }
        if (!kp_first) if constexpr (!Epi::AFTER_DRAIN) { E(acc, cur, wr, wc, fr, fq); if constexpr (REP_EPI > 1 && Epi::REP2) { asm volatile("" ::: "memory"); E(acc, cur, wr, wc, fr, fq); } S.done(cur); }
        asm volatile("" ::: "memory");
        if (!has_next) break;
        if (!kp_first)
#pragma unroll
        for (int a = 0; a < 2; ++a)
#pragma unroll
            for (int b = 0; b < 2; ++b)
#pragma unroll
                for (int m = 0; m < 4; ++m)
#pragma unroll
                    for (int n = 0; n < 2; ++n) acc[a][b][m][n] = (f32x4){0.f, 0.f, 0.f, 0.f};
        cur = nxt; cA = nA; cB = nB; ++ui;
        if constexpr (ALIGN_EPI) { if (wr == 1) PG8_BAR; }
        if constexpr (DRO) {
            const char* a1 = cA + kstep; const char* a2 = cA + 2 * kstep; const char* b2 = cB + 2 * kstep; const char* a3 = a2 + kstep; const char* b3 = b2 + kstep;
            PG8_TRIP(false, asm volatile("s_waitcnt vmcnt(%0)" :: "n"(8 + Epi::NVM) : "memory"));
        }
    }
    PG8_WAIT_V(0);
    if constexpr (!ALIGN_EPI) { if (wr == 0) PG8_BAR; }
    PG8_BAR;
    if constexpr (Epi::AFTER_DRAIN) { E.fused(acc, cur, wr, wc, fr, fq, lds, wid, lane); S.done(cur); }
#undef PG8_SA
#undef PG8_SB
#undef PG8_STAGE
#undef PG8_LDA
#undef PG8_LDB
#undef PG8_MMA
#undef PG8_WAIT_V
#undef PG8_TRIP
#undef PG8_WAIT_L
#undef PG8_BAR
#undef PG8_SCHED
}
}

#ifndef MK_N_LAUNCHES
#define MK_N_LAUNCHES 1
#endif
constexpr int NWAVES = 8;
constexpr int D = 2048, BATCH = 4, SEQ = 4096, CTXL = 256, DEPTH = 4, FF = 5632;
constexpr int ML = BATCH * SEQ, MC = BATCH * CTXL, M = ML + MC;
constexpr int NLP = ML / 256;
constexpr int MOD_LD = 6 * D;
constexpr float EPS = 1e-6f;
constexpr int N_PHASES = 3 + 8 * DEPTH;

constexpr size_t MiB = 1u << 20;
constexpr size_t WS_CTL = 0, WS_MOD = 1 * MiB, ZERO_BYTES = 2 * MiB;
constexpr size_t WS_TAB = 2 * MiB;
constexpr size_t TAB_COS = 0, TAB_SIN = 16384, TAB_LB = 32768;
constexpr size_t WS_X = 4 * MiB;
constexpr size_t WS_HN = 140 * MiB;
constexpr size_t WS_ACT = 208 * MiB;
constexpr size_t ACT_STRIDE = (size_t)M * D;
constexpr size_t WS_OF = 684 * MiB, WS_OB = 820 * MiB;
constexpr size_t WS_W = 956 * MiB, W_LAYER = 114 * MiB;
constexpr size_t W_IN = 0, W_OUT = 40 * MiB, W_GU = 48 * MiB, W_DN = 92 * MiB;
constexpr size_t WS_SLAB = WS_W + 4 * W_LAYER;
constexpr size_t WS_END = WS_SLAB + 32 * MiB;
constexpr int CW_BAR = 4096;

constexpr int RING_BYTES = 131072;
constexpr int LDSCTL_OFF = RING_BYTES, MISC_OFF = LDSCTL_OFF + 320;
constexpr int LDS_BYTES = 147456;

#define GAS __attribute__((address_space(1)))
#define LAS __attribute__((address_space(3)))
typedef unsigned short bf16;
typedef unsigned v4u __attribute__((ext_vector_type(4)));
typedef unsigned v2u __attribute__((ext_vector_type(2)));
typedef float f32x4 __attribute__((ext_vector_type(4)));
typedef GAS unsigned gu32;
#define LDS_WAIT() asm volatile("s_waitcnt lgkmcnt(0)" ::: "memory")
__device__ __forceinline__ unsigned f2bf(float f) { unsigned u = __builtin_bit_cast(unsigned, f); return (u + 0x7fffu + ((u >> 16) & 1u)) >> 16; }
typedef float f32x2_t __attribute__((ext_vector_type(2)));
typedef __bf16 bf16x2_t __attribute__((ext_vector_type(2)));
__device__ __forceinline__ unsigned pk2(float lo, float hi) { const f32x2_t v = {lo, hi}; const bf16x2_t b = __builtin_convertvector(v, bf16x2_t); return __builtin_bit_cast(unsigned, b); }
__device__ __forceinline__ float bflo(unsigned w) { return __builtin_bit_cast(float, w << 16); }
typedef _Float16 f16x2_t __attribute__((ext_vector_type(2)));
__device__ __forceinline__ unsigned xpk2(float lo, float hi) { if (XRES_F16) { const f32x2_t v = {lo, hi}; const f16x2_t h = __builtin_convertvector(v, f16x2_t); return __builtin_bit_cast(unsigned, h); } return pk2(lo, hi); }
__device__ __forceinline__ float xlo(unsigned w) { if (XRES_F16) { const f16x2_t h = __builtin_bit_cast(f16x2_t, w); return (float)h[0]; } return __builtin_bit_cast(float, w << 16); }
__device__ __forceinline__ float xhi(unsigned w) { if (XRES_F16) { const f16x2_t h = __builtin_bit_cast(f16x2_t, w); return (float)h[1]; } return __builtin_bit_cast(float, w & 0xffff0000u); }
__device__ __forceinline__ float bfhi(unsigned w) { return __builtin_bit_cast(float, w & 0xffff0000u); }
template <int CTRL> __device__ __forceinline__ float dpp_mov(float v) { return __builtin_bit_cast(float, __builtin_amdgcn_update_dpp(0, __builtin_bit_cast(int, v), CTRL, 0xF, 0xF, true)); }
__device__ __forceinline__ float wave_sum(float v) {
    v += dpp_mov<0xB1>(v);
    v += dpp_mov<0x4E>(v);
    v += dpp_mov<0x141>(v);
    v += dpp_mov<0x140>(v);
    const int iv = __builtin_bit_cast(int, v);
    const float a = __builtin_bit_cast(float, __builtin_amdgcn_readlane(iv, 0)), b = __builtin_bit_cast(float, __builtin_amdgcn_readlane(iv, 16));
    const float c = __builtin_bit_cast(float, __builtin_amdgcn_readlane(iv, 32)), d = __builtin_bit_cast(float, __builtin_amdgcn_readlane(iv, 48));
    return (a + b) + (c + d);
}
#define XB_TMO      128
#define XB_XCNT(j)  (256  + 64 * (j))
#define XB_XSUB(j)  (1280 + 64 * (j))
#define XB_XGEN(j)  (2304 + 64 * (j))
#define XB_TOP      3328
#define XB_TOPGEN   3392
#define XCD_BAR_WORDS 3456
#define XB_SPIN_CAP (1u << 18)

__device__ __forceinline__ unsigned xb_ld(unsigned* p)              { return __hip_atomic_load(p, __ATOMIC_RELAXED, __HIP_MEMORY_SCOPE_AGENT); }
__device__ __forceinline__ unsigned xb_add(unsigned* p, unsigned v) { return __hip_atomic_fetch_add(p, v, __ATOMIC_RELAXED, __HIP_MEMORY_SCOPE_AGENT); }
__device__ __forceinline__ unsigned xb_xcc_id() { return (unsigned)__builtin_amdgcn_s_getreg((3 << 11) | 20) & 0xFu; }
#define XB_SPIN(cond, bar) do { unsigned _sp = 0; while (cond) { __builtin_amdgcn_s_sleep(1); \
    if ((++_sp & 255u) == 0u) { if (xb_ld(&(bar)[XB_TMO])) break; if (_sp > XB_SPIN_CAP) { atomicAdd(&(bar)[XB_TMO], 1u); break; } } } } while (0)

struct XcdBarrier {
    unsigned* bar; unsigned x;
    volatile LAS unsigned* st;
};

__device__ __forceinline__ XcdBarrier xcd_barrier_post(unsigned* bar, volatile LAS unsigned* st) {
    XcdBarrier b; b.bar = bar; b.x = xb_xcc_id(); b.st = st;
    if (threadIdx.x == 0) (void)xb_add(&bar[XB_XCNT(b.x)], 1u);
    return b;
}
__device__ __forceinline__ void xcd_barrier_complete(unsigned* bar, unsigned x, unsigned& nloc, unsigned& nx) {
    const unsigned G = gridDim.x * gridDim.y * gridDim.z;
    unsigned sum, cnt, mine, sp = 0u;
    for (;;) {
        sum = 0u; cnt = 0u; mine = 0u;
#pragma unroll
        for (unsigned j = 0; j < 16; ++j) { const unsigned c = xb_ld(&bar[XB_XCNT(j)]); sum += c; cnt += (c > 0u) ? 1u : 0u; mine = (j == x) ? c : mine; }
        if (sum == G) break;
        __builtin_amdgcn_s_sleep(1);
        if ((++sp & 255u) == 0u) { if (xb_ld(&bar[XB_TMO])) break; if (sp > XB_SPIN_CAP) { atomicAdd(&bar[XB_TMO], 1u); break; } }
    }
    nloc = mine > 0u ? mine : 1u; nx = cnt > 0u ? cnt : 1u;
}

__device__ __forceinline__ void xcd_barrier(const XcdBarrier& b) {
    asm volatile("s_waitcnt vmcnt(0)" ::: "memory");
    __syncthreads();
    if (mk_tid() == 0) {
        unsigned* bar = b.bar;
        __builtin_amdgcn_s_waitcnt(0);
        unsigned nloc = b.st[0], nx = b.st[1];
        if (nloc == 0u) { xcd_barrier_complete(bar, b.x, nloc, nx); b.st[0] = nloc; b.st[1] = nx; }
        const unsigned old = xb_add(&bar[XB_XSUB(b.x)], 1u);
        const unsigned gen = old / nloc;
        if (old + 1u == (gen + 1u) * nloc) {
            __builtin_amdgcn_fence(__ATOMIC_RELEASE, "agent");
            asm volatile("s_waitcnt vmcnt(0)" ::: "memory");
            const unsigned og = xb_add(&bar[XB_TOP], 1u);
            const unsigned tg = og / nx;
            if (og + 1u == (tg + 1u) * nx) xb_add(&bar[XB_TOPGEN], 1u);
            else XB_SPIN(xb_ld(&bar[XB_TOPGEN]) == tg, bar);
            __builtin_amdgcn_fence(__ATOMIC_ACQUIRE, "agent");
            xb_add(&bar[XB_XGEN(b.x)], 1u);
            asm volatile("s_waitcnt vmcnt(0)" ::: "memory");
        } else {
            XB_SPIN(xb_ld(&bar[XB_XGEN(b.x)]) == gen, bar);
            __builtin_amdgcn_fence(__ATOMIC_ACQUIRE, "agent");
            asm volatile("s_waitcnt vmcnt(0)" ::: "memory");
        }
    }
    __syncthreads();
}

struct Args { const float* in[18]; float* out; unsigned char* ws; int ph_lo, ph_hi; };
struct Frame {
    LAS unsigned char* lds;
    gu32* ctl;
    int tid, lane, wave, vcu, G;
};
__device__ __forceinline__ void relaunder(Frame& F) { int t = mk_tid(); asm volatile("" : "+v"(t)); F.tid = t; F.lane = t & 63; F.wave = __builtin_amdgcn_readfirstlane(t >> 6); }

__device__ __forceinline__ void p0_transpose_item(const float* W, int K, int N, bf16* WT, int dst_row0, LAS float* scr, int k0, int n0, int lane) {
    float r[32];
    const GAS float* wp = (const GAS float*)W + (size_t)(k0 + (lane >> 5)) * N + n0 + (lane & 31);
#pragma unroll
    for (int i = 0; i < 32; ++i) r[i] = PRO_NT ? __builtin_nontemporal_load(wp + (size_t)(2 * i) * N) : wp[(size_t)(2 * i) * N];
#pragma unroll
    for (int i = 0; i < 32; ++i) scr[(2 * i + (lane >> 5)) * 33 + (lane & 31)] = r[i];
    LDS_WAIT(); asm volatile("" ::: "memory");
    const int c = lane & 7;
#pragma unroll
    for (int j = 0; j < 4; ++j) { const int n = (lane >> 3) + 8 * j; const LAS float* s = scr + (8 * c) * 33 + n;
        v4u o; o.x = pk2(s[0 * 33], s[1 * 33]); o.y = pk2(s[2 * 33], s[3 * 33]); o.z = pk2(s[4 * 33], s[5 * 33]); o.w = pk2(s[6 * 33], s[7 * 33]);
        if (WT_NT_ST) __builtin_nontemporal_store(o, (GAS v4u*)(WT + (size_t)(dst_row0 + n) * K + k0 + 8 * c)); else *(GAS v4u*)(WT + (size_t)(dst_row0 + n) * K + k0 + 8 * c) = o; }
    LDS_WAIT(); asm volatile("" ::: "memory");
}
__device__ __forceinline__ bool p0_matrix(int& it, const float* W, int K, int N, bf16* WT, bool gu, LAS float* scr, int lane) {
    const int nblk = N / 32, items = (K / 64) * nblk;
    if (it >= items) { it -= items; return false; }
    const int kb = it / nblk, nb = it % nblk, n0 = 32 * nb;
    int dst = n0;
    if (gu) { const int half = n0 / FF, w = n0 % FF; dst = (w / 128) * 256 + half * 128 + (w % 128); }
    p0_transpose_item(W, K, N, WT, dst, scr, 64 * kb, n0, lane);
    return true;
}
__device__ __forceinline__ void sincos_pos(float x, float& s, float& c) {
    const float n = rintf(x * 0.63661977236758f);
    float r = fmaf(n, -1.5707962512969971f, x); r = fmaf(n, -7.5497894158615964e-08f, r);
    const float r2 = r * r;
    const float sp = r + r * r2 * (-1.6666667e-1f + r2 * (8.3333333e-3f + r2 * (-1.9841270e-4f + r2 * 2.7557319e-6f)));
    const float cp = 1.0f + r2 * (-0.5f + r2 * (4.1666667e-2f + r2 * (-1.3888889e-3f + r2 * (2.4801587e-5f + r2 * -2.7557319e-7f))));
    const int q = ((int)n) & 3;
    s = (q == 0) ? sp : (q == 1) ? cp : (q == 2) ? -sp : -cp;
    c = (q == 0) ? cp : (q == 1) ? -sp : (q == 2) ? -cp : sp;
}
constexpr int I_RET = 32 * 256 + 32 * 64 + 32 * 352 + 88 * 64, I_HG = 32 * 320 + 32 * 64 + 32 * 352 + 88 * 64;
__device__ __forceinline__ void p0_convert_item(const Args& a, int layer, int it, LAS float* scr, int lane) {
    unsigned char* wb = a.ws + WS_W + (size_t)layer * W_LAYER;
    const int j = layer >> 1;
    if (layer & 1) { if (p0_matrix(it, a.in[11] + (size_t)j * D * 5 * D, D, 5 * D, (bf16*)(wb + W_IN), false, scr, lane)) return;
                     if (p0_matrix(it, a.in[12] + (size_t)j * D * D, D, D, (bf16*)(wb + W_OUT), false, scr, lane)) return; }
    else           { if (p0_matrix(it, a.in[8] + (size_t)j * D * 4 * D, D, 4 * D, (bf16*)(wb + W_IN), false, scr, lane)) return;
                     if (p0_matrix(it, a.in[9] + (size_t)j * D * D, D, D, (bf16*)(wb + W_OUT), false, scr, lane)) return; }
    if (p0_matrix(it, a.in[15] + (size_t)layer * D * 2 * FF, D, 2 * FF, (bf16*)(wb + W_GU), true, scr, lane)) return;
    p0_matrix(it, a.in[16] + (size_t)layer * FF * D, FF, D, (bf16*)(wb + W_DN), false, scr, lane);
}
__device__ __forceinline__ void tail_convert(const Args& a, Frame& F, int layer_next, int window, int widx, int nidle, int nidle1) {
    relaunder(F);
    const int T = (layer_next & 1) ? I_HG : I_RET;
    const int n1 = nidle1 * NWAVES * 12, n2 = n1 + 128 * NWAVES * 4, n3 = n2 + 80 * NWAVES * 12;
    const int lo = window == 1 ? 0 : window == 2 ? n1 : window == 3 ? n2 : n3, hi_ = window == 1 ? n1 : window == 2 ? n2 : window == 3 ? n3 : T;
    const int hi = hi_ < T ? hi_ : T;
    LAS float* scr = (LAS float*)(F.lds + F.wave * 9216);
    for (int it = lo + widx * NWAVES + F.wave; it < hi; it += nidle * NWAVES) p0_convert_item(a, layer_next, it, scr, F.lane);
}
__device__ __forceinline__ void p0_prologue(const Args& a, Frame& F) {
    relaunder(F);
    LAS float* scr = (LAS float*)(F.lds + F.wave * 9216);
    LAS float* act = (LAS float*)(F.lds + 73728);
    for (int i = F.tid; i < 5 * D; i += NWAVES * 64) { const float v = (i < 4 * D) ? a.in[1][i] : a.in[3][i - 4 * D]; act[i] = v / (1.f + __expf(-v)); }
    __syncthreads();
    const int gw = F.vcu * NWAVES + F.wave, NGW = F.G * NWAVES;
    for (int t = gw; t < DEPTH * 48 * 32; t += NGW) {
        const int layer = t / (48 * 32), rem = t % (48 * 32), cb = rem >> 5, ks = rem & 31;
        const int col = cb * 256 + F.lane * 4;
        const float* wp = a.in[4] + ((size_t)layer * D + ks * 64) * MOD_LD + col;
        f32x4 acc0 = {0.f, 0.f, 0.f, 0.f}, acc1 = acc0, acc2 = acc0, acc3 = acc0, acc4 = acc0;
        for (int kk = 0; kk < 64; kk += 16) {
            f32x4 w[16];
#pragma unroll
            for (int u = 0; u < 16; ++u) w[u] = PRO_NT ? __builtin_nontemporal_load((const GAS f32x4*)(wp + (size_t)(kk + u) * MOD_LD)) : *(const GAS f32x4*)(wp + (size_t)(kk + u) * MOD_LD);
#pragma unroll
            for (int u = 0; u < 16; ++u) { const int k = ks * 64 + kk + u;
                acc0 += act[k] * w[u]; acc1 += act[D + k] * w[u]; acc2 += act[2 * D + k] * w[u]; acc3 += act[3 * D + k] * w[u]; acc4 += act[4 * D + k] * w[u]; }
        }
        float* pp = (float*)(a.ws + WS_SLAB) + ((size_t)(layer * 32 + ks) * 5) * MOD_LD + col;
        *(GAS f32x4*)(pp) = acc0; *(GAS f32x4*)(pp + MOD_LD) = acc1; *(GAS f32x4*)(pp + 2 * MOD_LD) = acc2; *(GAS f32x4*)(pp + 3 * MOD_LD) = acc3; *(GAS f32x4*)(pp + 4 * MOD_LD) = acc4;
    }
    {
        const int gt = (F.vcu * NWAVES + F.wave) * 64 + F.lane;
        float* tab = (float*)(a.ws + WS_TAB);
        if (gt < 4096) { const int pos = gt >> 6, f = gt & 63; const float inv = expf(-(float)f * (9.210340371976184f / 64.0f)); float s, c; sincos_pos((float)pos * inv, s, c);
            tab[TAB_COS / 4 + gt] = c; tab[TAB_SIN / 4 + gt] = s; }
        else if (gt < 4096 + D) { const int ch = gt - 4096; const float b0 = a.in[14][ch], b1 = a.in[14][D + ch], mx = fmaxf(b0, b1), e0 = __expf(b0 - mx), e1 = __expf(b1 - mx), p0 = e0 / (e0 + e1), p1 = e1 / (e0 + e1);
            tab[TAB_LB / 4 + ch] = p0 - p0; tab[TAB_LB / 4 + D + ch] = (p0 + p1) - p0; }
    }
    for (int rep_ = 0; rep_ < REP_PRO; ++rep_) {
    {
        bf16* Xb = (bf16*)(a.ws + WS_X);
        for (int r0_ = gw; r0_ < M; r0_ += 4 * NGW) {
            f32x4 t[4][8];
#pragma unroll
            for (int u = 0; u < 4; ++u) { const int r = r0_ + u * NGW; if (r < M) { const GAS f32x4* xr = (const GAS f32x4*)((r < ML) ? a.in[0] + (size_t)r * D : a.in[2] + (size_t)(r - ML) * D) + F.lane;
#pragma unroll
                for (int j = 0; j < 8; ++j) t[u][j] = __builtin_nontemporal_load(xr + 64 * j); } }
#pragma unroll
            for (int u = 0; u < 4; ++u) { const int r = r0_ + u * NGW; if (r < M) { GAS v2u* o = (GAS v2u*)(Xb + (size_t)r * D) + F.lane;
#pragma unroll
                for (int j = 0; j < 8; ++j) { v2u w; w.x = xpk2(t[u][j][0], t[u][j][1]); w.y = xpk2(t[u][j][2], t[u][j][3]); o[64 * j] = w; } } }
        }
    }
    if (TAIL_CONVERT && F.G == 256) {
        for (int it = gw; it < I_RET; it += NGW) p0_convert_item(a, 0, it, scr, F.lane);
    } else {
        for (int it0 = gw; it0 < 2 * (I_RET + I_HG); it0 += NGW) {
            int it = it0; const int lp = it / (I_RET + I_HG); it -= lp * (I_RET + I_HG);
            int layer = 2 * lp; if (it >= I_RET) { it -= I_RET; layer += 1; }
            p0_convert_item(a, layer, it, scr, F.lane);
        }
    }
    }
}

__device__ __forceinline__ void p1_modreduce(const Args& a, Frame& F) {
    relaunder(F);
    static_assert((size_t)DEPTH * 32 * 5 * MOD_LD * 4 <= 32 * MiB, "the GEMV partials fit the slab region");
    for (int q = (F.vcu * NWAVES + F.wave) * 64 + F.lane; q < DEPTH * 5 * (MOD_LD / 4); q += F.G * NWAVES * 64) {
        const int layer = q / (5 * (MOD_LD / 4)), rem = q % (5 * (MOD_LD / 4)), row = rem / (MOD_LD / 4), c4 = rem % (MOD_LD / 4);
        const GAS f32x4* pp = (const GAS f32x4*)((const float*)(a.ws + WS_SLAB) + ((size_t)(layer * 32) * 5 + row) * MOD_LD) + c4;
        f32x4 t[32];
#pragma unroll
        for (int ks = 0; ks < 32; ++ks) t[ks] = pp[(size_t)ks * 5 * (MOD_LD / 4)];
        f32x4 sum = *(const GAS f32x4*)(a.in[5] + (size_t)layer * MOD_LD + 4 * c4);
#pragma unroll
        for (int ks = 0; ks < 32; ++ks) sum += t[ks];
        *((GAS f32x4*)((float*)(a.ws + WS_MOD) + ((size_t)layer * 5 + row) * MOD_LD) + c4) = sum;
    }
}

__device__ __forceinline__ void norm_mod_phase(const Args& a, Frame& F, const float* gain, const float* modl, int sh_off, int sc_off, int nrows, const float* slab_gate) {
    relaunder(F);
    const int gw = F.vcu * NWAVES + F.wave, NGW = F.G * NWAVES;
    bf16* X = (bf16*)(a.ws + WS_X); bf16* HN = (bf16*)(a.ws + WS_HN);
    for (int r = gw; r < nrows; r += NGW) {
        const int b = (r < ML) ? (r >> 12) : 4;
        const GAS v2u* xr = (const GAS v2u*)(X + (size_t)r * D) + F.lane;
        f32x4 v[8]; float ss = 0.f;
#pragma unroll
        for (int j = 0; j < 8; ++j) { const v2u w = xr[64 * j]; v[j] = (f32x4){xlo(w.x), xhi(w.x), xlo(w.y), xhi(w.y)}; }
        if (slab_gate != nullptr && r >= ML) {
            const GAS f32x4* sl = (const GAS f32x4*)((const float*)(a.ws + WS_SLAB) + (size_t)(r - ML) * D) + F.lane;
#pragma unroll
            for (int j = 0; j < 8; ++j) { const f32x4 p = (sl[64 * j] + sl[64 * j + (size_t)MC * D / 4]) + (sl[64 * j + 2 * ((size_t)MC * D / 4)] + sl[64 * j + 3 * ((size_t)MC * D / 4)]);
                v[j] += *(const GAS f32x4*)(slab_gate + 256 * j + 4 * F.lane) * p; v2u w; w.x = xpk2(v[j][0], v[j][1]); w.y = xpk2(v[j][2], v[j][3]); ((GAS v2u*)(X + (size_t)r * D) + F.lane)[64 * j] = w;
                v[j] = (f32x4){xlo(w.x), xhi(w.x), xlo(w.y), xhi(w.y)}; }
        }
#pragma unroll
        for (int j = 0; j < 8; ++j) ss += (v[j][0] * v[j][0] + v[j][1] * v[j][1]) + (v[j][2] * v[j][2] + v[j][3] * v[j][3]);
        const float rstd = 1.0f / sqrtf(wave_sum(ss) * (1.0f / D) + EPS);
        const float* mb = modl + (size_t)b * MOD_LD;
        GAS v2u* o8 = (GAS v2u*)(HN + (size_t)r * D) + F.lane;
#pragma unroll
        for (int j = 0; j < 8; ++j) { const int c = 256 * j + 4 * F.lane;
            const f32x4 g = *(const GAS f32x4*)(gain + c), sh = *(const GAS f32x4*)(mb + sh_off + c), sc = *(const GAS f32x4*)(mb + sc_off + c);
            const f32x4 y = (v[j] * rstd) * g * (sc + 1.0f) + sh;
            v2u w; w.x = pk2(y[0], y[1]); w.y = pk2(y[2], y[3]); o8[64 * j] = w; }
    }
}
#define NORM_FN(...) do { if (NORM_PIPE && F.G == 256) norm_mod_phase2(__VA_ARGS__); else norm_mod_phase(__VA_ARGS__); } while (0)
__device__ __forceinline__ void norm_mod_phase2(const Args& a, Frame& F, const float* gain, const float* modl, int sh_off, int sc_off, int nrows, const float* slab_gate) {
    relaunder(F);
    static_assert(ML == 8 * 2048 && MC <= 2048, "8 latent rows and at most one context row per wave of 2048");
    const int nw = F.vcu * NWAVES + F.wave;
    bf16* X = (bf16*)(a.ws + WS_X); bf16* HN = (bf16*)(a.ws + WS_HN);
    LAS float* CA = (LAS float*)F.lds; LAS float* CB = CA + 5 * D;
    v2u r0[8], r1[8], r2[8], r3[8], r4[8], r5[8], r6[8], r7[8];
#define NR_LOAD(dst, k_) do { const GAS v2u* xr_ = (const GAS v2u*)(X + (size_t)(nw + 2048 * (k_)) * D) + F.lane; \
        _Pragma("unroll") for (int j = 0; j < 8; ++j) dst[j] = __builtin_nontemporal_load(xr_ + 64 * j); } while (0)
#define NR_FINISH(raw, r_, b_) do { const int rr_ = (r_); float ss_ = 0.f; f32x4 v[8]; \
        _Pragma("unroll") for (int j = 0; j < 8; ++j) { v[j] = (f32x4){xlo(raw[j].x), xhi(raw[j].x), xlo(raw[j].y), xhi(raw[j].y)}; ss_ += (v[j][0] * v[j][0] + v[j][1] * v[j][1]) + (v[j][2] * v[j][2] + v[j][3] * v[j][3]); } \
        const float rstd_ = 1.0f / sqrtf(wave_sum(ss_) * (1.0f / D) + EPS); \
        GAS v2u* ho_ = (GAS v2u*)(HN + (size_t)rr_ * D) + F.lane; \
        _Pragma("unroll") for (int j = 0; j < 8; ++j) { const int c_ = 256 * j + 4 * F.lane; \
            const f32x4 y_ = (v[j] * rstd_) * *(const LAS f32x4*)(CA + (b_) * D + c_) + *(const LAS f32x4*)(CB + (b_) * D + c_); v2u w_; w_.x = pk2(y_[0], y_[1]); w_.y = pk2(y_[2], y_[3]); \
            ho_[64 * j] = w_; } } while (0)
    NR_LOAD(r0, 0); NR_LOAD(r1, 1); NR_LOAD(r2, 2); NR_LOAD(r3, 3); NR_LOAD(r4, 4); NR_LOAD(r5, 5); NR_LOAD(r6, 6); NR_LOAD(r7, 7);
    { const GAS f32x4* g4 = (const GAS f32x4*)gain;
      for (int q = F.tid; q < 5 * D / 4; q += NWAVES * 64) { const int bq = q >> 9, cq = q & 511; const GAS f32x4* mb4 = (const GAS f32x4*)(modl + (size_t)bq * MOD_LD);
          ((LAS f32x4*)CA)[q] = g4[cq] * (mb4[sc_off / 4 + cq] + 1.0f); ((LAS f32x4*)CB)[q] = mb4[sh_off / 4 + cq]; } }
    asm volatile("s_waitcnt lgkmcnt(0)" ::: "memory"); __builtin_amdgcn_s_barrier(); asm volatile("" ::: "memory");
    NR_FINISH(r0, nw,            (nw) >> 12);
    NR_FINISH(r1, nw + 2048,     (nw + 2048) >> 12);
    NR_FINISH(r2, nw + 2 * 2048, (nw + 2 * 2048) >> 12);
    NR_FINISH(r3, nw + 3 * 2048, (nw + 3 * 2048) >> 12);
    NR_FINISH(r4, nw + 4 * 2048, (nw + 4 * 2048) >> 12);
    NR_FINISH(r5, nw + 5 * 2048, (nw + 5 * 2048) >> 12);
    NR_FINISH(r6, nw + 6 * 2048, (nw + 6 * 2048) >> 12);
    NR_FINISH(r7, nw + 7 * 2048, (nw + 7 * 2048) >> 12);
    if (ML + nw < nrows) {
        const int r = ML + nw, rc = nw;
        const GAS v2u* xr = (const GAS v2u*)(X + (size_t)r * D) + F.lane;
#pragma unroll
        for (int j = 0; j < 8; ++j) r0[j] = xr[64 * j];
        if (slab_gate != nullptr) { const GAS f32x4* sl = (const GAS f32x4*)((const float*)(a.ws + WS_SLAB) + (size_t)rc * D) + F.lane;
#pragma unroll
            for (int j = 0; j < 8; ++j) { const f32x4 p = (sl[64 * j] + sl[64 * j + (size_t)MC * D / 4]) + (sl[64 * j + 2 * ((size_t)MC * D / 4)] + sl[64 * j + 3 * ((size_t)MC * D / 4)]);
                const f32x4 x = (f32x4){xlo(r0[j].x), xhi(r0[j].x), xlo(r0[j].y), xhi(r0[j].y)} + *(const GAS f32x4*)(slab_gate + 256 * j + 4 * F.lane) * p;
                v2u w; w.x = xpk2(x[0], x[1]); w.y = xpk2(x[2], x[3]); ((GAS v2u*)(X + (size_t)r * D) + F.lane)[64 * j] = w; r0[j] = w; } }
        NR_FINISH(r0, r, 4);
    }
    __syncthreads();
#undef NR_LOAD
#undef NR_FINISH
}

template <bool HG>
__device__ __forceinline__ void readout_phase(const Args& a, Frame& F, const float* gain, int nrows) {
    relaunder(F);
    const int gw = F.vcu * NWAVES + F.wave, NGW = F.G * NWAVES;
    const bf16* OF = (const bf16*)(a.ws + WS_OF); const bf16* OB = (const bf16*)(a.ws + WS_OB);
    const bf16* G = (const bf16*)(a.ws + WS_ACT) + (size_t)(HG ? 6 : 3) * ACT_STRIDE; bf16* HN = (bf16*)(a.ws + WS_HN);
    for (int r = gw; r < nrows; r += NGW) {
        const GAS v2u* f = (const GAS v2u*)(OF + (size_t)r * D) + F.lane; const GAS v2u* bk = (const GAS v2u*)(OB + (size_t)r * D) + F.lane;
        const GAS v2u* g8 = (const GAS v2u*)(G + (size_t)r * D) + F.lane;
        f32x4 v[8]; float ssj[8]; float tot = 0.f;
#pragma unroll
        for (int j = 0; j < 8; ++j) { const v2u fa = EW_NT ? __builtin_nontemporal_load(f + 64 * j) : f[64 * j], fb = EW_NT ? __builtin_nontemporal_load(bk + 64 * j) : bk[64 * j]; v[j] = (f32x4){bflo(fa.x) + bflo(fb.x), bfhi(fa.x) + bfhi(fb.x), bflo(fa.y) + bflo(fb.y), bfhi(fa.y) + bfhi(fb.y)}; ssj[j] = (v[j][0] * v[j][0] + v[j][1] * v[j][1]) + (v[j][2] * v[j][2] + v[j][3] * v[j][3]); tot += ssj[j]; }
        float rs_all = 0.f;
        if (HG) rs_all = 1.0f / sqrtf(wave_sum(tot) * (1.0f / D) + EPS);
        GAS v2u* o8 = (GAS v2u*)(HN + (size_t)r * D) + F.lane;
#pragma unroll
        for (int j = 0; j < 8; ++j) {
            float rs = rs_all; f32x4 gn = {1.f, 1.f, 1.f, 1.f};
            if (!HG) rs = 1.0f / sqrtf(wave_sum(ssj[j]) * (1.0f / 256.0f) + EPS);
            else gn = *(const GAS f32x4*)(gain + 256 * j + 4 * F.lane);
            const v2u gw2 = EW_NT ? __builtin_nontemporal_load(g8 + 64 * j) : g8[64 * j];
            const f32x4 gt = {bflo(gw2.x), bfhi(gw2.x), bflo(gw2.y), bfhi(gw2.y)};
            const f32x4 y = (v[j] * rs) * gn * gt;
            v2u w; w.x = pk2(y[0], y[1]); w.y = pk2(y[2], y[3]); o8[64 * j] = w; }
    }
}
template <bool HG>
__device__ __forceinline__ void readout_phase2(const Args& a, Frame& F, const float* gain, int nrows) {
    relaunder(F);
    const int nw = F.vcu * NWAVES + F.wave;
    const bf16* OF = (const bf16*)(a.ws + WS_OF); const bf16* OB = (const bf16*)(a.ws + WS_OB);
    const bf16* G = (const bf16*)(a.ws + WS_ACT) + (size_t)(HG ? 6 : 3) * ACT_STRIDE; bf16* HN = (bf16*)(a.ws + WS_HN);
    LAS float* GL = (LAS float*)F.lds;
    v2u f0[8], b0[8], g0[8], f1[8], b1[8], g1[8], f2[8], b2[8], g2[8];
#define RO_LOAD(fs, bs, gs, r_) do { const size_t o_ = (size_t)(r_) * D; const GAS v2u* f_ = (const GAS v2u*)(OF + o_) + F.lane; const GAS v2u* k_ = (const GAS v2u*)(OB + o_) + F.lane; const GAS v2u* q_ = (const GAS v2u*)(G + o_) + F.lane; \
        _Pragma("unroll") for (int j = 0; j < 8; ++j) { fs[j] = __builtin_nontemporal_load(f_ + 64 * j); bs[j] = __builtin_nontemporal_load(k_ + 64 * j); gs[j] = __builtin_nontemporal_load(q_ + 64 * j); } } while (0)
#define RO_FINISH(fs, bs, gs, r_) do { f32x4 v[8]; float ssj[8]; float tot = 0.f; \
        _Pragma("unroll") for (int j = 0; j < 8; ++j) { v[j] = (f32x4){bflo(fs[j].x) + bflo(bs[j].x), bfhi(fs[j].x) + bfhi(bs[j].x), bflo(fs[j].y) + bflo(bs[j].y), bfhi(fs[j].y) + bfhi(bs[j].y)}; \
            ssj[j] = (v[j][0] * v[j][0] + v[j][1] * v[j][1]) + (v[j][2] * v[j][2] + v[j][3] * v[j][3]); tot += ssj[j]; } \
        float rs_all = 0.f; if (HG) rs_all = 1.0f / sqrtf(wave_sum(tot) * (1.0f / D) + EPS); \
        GAS v2u* o8 = (GAS v2u*)(HN + (size_t)(r_) * D) + F.lane; \
        _Pragma("unroll") for (int j = 0; j < 8; ++j) { float rs = rs_all; f32x4 gn = {1.f, 1.f, 1.f, 1.f}; \
            if (!HG) rs = 1.0f / sqrtf(wave_sum(ssj[j]) * (1.0f / 256.0f) + EPS); else gn = *(const LAS f32x4*)(GL + 256 * j + 4 * F.lane); \
            const f32x4 gt = {bflo(gs[j].x), bfhi(gs[j].x), bflo(gs[j].y), bfhi(gs[j].y)}; const f32x4 y = (v[j] * rs) * gn * gt; \
            v2u w; w.x = pk2(y[0], y[1]); w.y = pk2(y[2], y[3]); o8[64 * j] = w; } } while (0)
    RO_LOAD(f0, b0, g0, nw); RO_LOAD(f1, b1, g1, nw + 2048); RO_LOAD(f2, b2, g2, nw + 2 * 2048);
    if (HG) { for (int q = F.tid; q < D / 4; q += NWAVES * 64) ((LAS f32x4*)GL)[q] = ((const GAS f32x4*)gain)[q];
              asm volatile("s_waitcnt lgkmcnt(0)" ::: "memory"); __builtin_amdgcn_s_barrier(); asm volatile("" ::: "memory"); }
    RO_FINISH(f0, b0, g0, nw);            RO_LOAD(f0, b0, g0, nw + 3 * 2048);
    RO_FINISH(f1, b1, g1, nw + 2048);     RO_LOAD(f1, b1, g1, nw + 4 * 2048);
    RO_FINISH(f2, b2, g2, nw + 2 * 2048); RO_LOAD(f2, b2, g2, nw + 5 * 2048);
    RO_FINISH(f0, b0, g0, nw + 3 * 2048); RO_LOAD(f0, b0, g0, nw + 6 * 2048);
    RO_FINISH(f1, b1, g1, nw + 4 * 2048); RO_LOAD(f1, b1, g1, nw + 7 * 2048);
    RO_FINISH(f2, b2, g2, nw + 5 * 2048);
    const bool cx = ML + nw < nrows;
    RO_LOAD(f2, b2, g2, cx ? ML + nw : nw + 7 * 2048);
    RO_FINISH(f0, b0, g0, nw + 6 * 2048);
    RO_FINISH(f1, b1, g1, nw + 7 * 2048);
    if (cx) RO_FINISH(f2, b2, g2, ML + nw);
    if (HG) __syncthreads();
#undef RO_LOAD
#undef RO_FINISH
}
__device__ __forceinline__ void final_norm_phase2(const Args& a, Frame& F) {
    relaunder(F);
    const int nw = F.vcu * NWAVES + F.wave;
    const bf16* X = (const bf16*)(a.ws + WS_X); const float* gain = a.in[17];
    LAS float* GL = (LAS float*)F.lds;
    v2u r0[8], r1[8], r2[8], r3[8], r4[8], r5[8], r6[8], r7[8];
#define FN_LOAD(dst, k_) do { const GAS v2u* xr_ = (const GAS v2u*)(X + (size_t)(nw + 2048 * (k_)) * D) + F.lane; \
        _Pragma("unroll") for (int j = 0; j < 8; ++j) dst[j] = __builtin_nontemporal_load(xr_ + 64 * j); } while (0)
#define FN_FINISH(raw, k_) do { float ss_ = 0.f; f32x4 v[8]; \
        _Pragma("unroll") for (int j = 0; j < 8; ++j) { v[j] = (f32x4){xlo(raw[j].x), xhi(raw[j].x), xlo(raw[j].y), xhi(raw[j].y)}; ss_ += (v[j][0] * v[j][0] + v[j][1] * v[j][1]) + (v[j][2] * v[j][2] + v[j][3] * v[j][3]); } \
        const float rstd_ = 1.0f / sqrtf(wave_sum(ss_) * (1.0f / D) + EPS); \
        GAS f32x4* o_ = (GAS f32x4*)(a.out + (size_t)(nw + 2048 * (k_)) * D) + F.lane; \
        _Pragma("unroll") for (int j = 0; j < 8; ++j) o_[64 * j] = (v[j] * rstd_) * *(const LAS f32x4*)(GL + 256 * j + 4 * F.lane); } while (0)
    FN_LOAD(r0, 0); FN_LOAD(r1, 1); FN_LOAD(r2, 2); FN_LOAD(r3, 3); FN_LOAD(r4, 4); FN_LOAD(r5, 5); FN_LOAD(r6, 6); FN_LOAD(r7, 7);
    for (int q = F.tid; q < D / 4; q += NWAVES * 64) ((LAS f32x4*)GL)[q] = ((const GAS f32x4*)gain)[q];
    asm volatile("s_waitcnt lgkmcnt(0)" ::: "memory"); __builtin_amdgcn_s_barrier(); asm volatile("" ::: "memory");
    FN_FINISH(r0, 0); FN_FINISH(r1, 1); FN_FINISH(r2, 2); FN_FINISH(r3, 3); FN_FINISH(r4, 4); FN_FINISH(r5, 5); FN_FINISH(r6, 6); FN_FINISH(r7, 7);
#undef FN_LOAD
#undef FN_FINISH
}
__device__ __forceinline__ void final_norm_phase(const Args& a, Frame& F) {
    relaunder(F);
    const int gw = F.vcu * NWAVES + F.wave, NGW = F.G * NWAVES;
    const bf16* X = (const bf16*)(a.ws + WS_X); const float* gain = a.in[17];
    for (int r = gw; r < ML; r += NGW) {
        const GAS v2u* xr = (const GAS v2u*)(X + (size_t)r * D) + F.lane;
        f32x4 v[8]; float ss = 0.f;
#pragma unroll
        for (int j = 0; j < 8; ++j) { const v2u w = xr[64 * j]; v[j] = (f32x4){xlo(w.x), xhi(w.x), xlo(w.y), xhi(w.y)}; ss += (v[j][0] * v[j][0] + v[j][1] * v[j][1]) + (v[j][2] * v[j][2] + v[j][3] * v[j][3]); }
        const float rstd = 1.0f / sqrtf(wave_sum(ss) * (1.0f / D) + EPS);
        GAS f32x4* o = (GAS f32x4*)(a.out + (size_t)r * D) + F.lane;
#pragma unroll
        for (int j = 0; j < 8; ++j) o[64 * j] = (v[j] * rstd) * *(const GAS f32x4*)(gain + 256 * j + 4 * F.lane);
    }
}

template <bool HG>
__device__ __forceinline__ void mixer_phase(const Args& a, Frame& F, int j_layer, bool ctx_out) {
    relaunder(F);
    constexpr int DPL = HG ? 2 : 4, HD = HG ? 128 : 256, NH = HG ? 16 : 8, NEB = HD / 64, CH = 32;
    constexpr int QB = CH * HD * 2;
    constexpr int NQ = HG ? 3 : 2;
    constexpr int VB_OFF = NQ * QB, BUF = VB_OFF + CH * 128;
    static_assert(2 * BUF <= RING_BYTES, "mixer LDS");
    const bf16* act = (const bf16*)(a.ws + WS_ACT);
    const int lane = F.lane, w = F.wave, tid = F.tid;
    for (int task = F.vcu; task < BATCH * NH * 2 * NEB; task += F.G) {
        const int eb = task % NEB, dir = (task / NEB) & 1, h = (task / (2 * NEB)) % NH, b = task / (2 * NEB * NH);
        bf16* O = (bf16*)(a.ws + (dir ? WS_OB : WS_OF));
        const bf16* src0 = act;
        const bf16* src1 = act + (size_t)(HG ? (1 + 2 * dir) : 1) * ACT_STRIDE;
        const bf16* src2 = act + (size_t)(2 + 2 * dir) * ACT_STRIDE;
        const bf16* srcv = act + (size_t)(HG ? 5 : 2) * ACT_STRIDE;
        float gamma = 0.f;
        if (!HG) { const float lg = a.in[10][(j_layer * 2 + dir) * 8 + h]; gamma = 1.0f / (1.0f + expf(-lg)); }
        float S[DPL][8];
#pragma unroll
        for (int i = 0; i < DPL; ++i)
#pragma unroll
            for (int jj = 0; jj < 8; ++jj) S[i][jj] = 0.f;
        constexpr int NCH = (CTXL + SEQ) / CH;
        constexpr int NPQ = HG ? 1 : 2;
        v4u rq[NQ][NPQ]; v4u rv = {0u, 0u, 0u, 0u};
#define MIX_ROWLO(c) (((c) < CTXL / CH) ? (ML + b * CTXL + (dir ? (CTXL / CH - 1 - (c)) : (c)) * CH) : (b * SEQ + (dir ? (SEQ / CH - 1 - ((c) - CTXL / CH)) : ((c) - CTXL / CH)) * CH))
#define MIX_LOAD(c) do { const int rlo_ = MIX_ROWLO(c); \
        _Pragma("unroll") for (int p_ = 0; p_ < NPQ; ++p_) { const int pc_ = tid + 512 * p_; const int row_ = HG ? (pc_ >> 4) : (pc_ >> 5), cc_ = HG ? (pc_ & 15) : (pc_ & 31); \
            const size_t go_ = (size_t)(rlo_ + row_) * D + h * HD + cc_ * 8; \
            rq[0][p_] = *(const GAS v4u*)(src0 + go_); rq[1][p_] = *(const GAS v4u*)(src1 + go_); if (HG) rq[NQ - 1][p_] = *(const GAS v4u*)(src2 + go_); } \
        if (tid < 256) { const int row_ = tid >> 3, cc_ = tid & 7; rv = *(const GAS v4u*)(srcv + (size_t)(rlo_ + row_) * D + h * HD + eb * 64 + cc_ * 8); } } while (0)
#define MIX_STORE(bufp) do { \
        _Pragma("unroll") for (int p_ = 0; p_ < NPQ; ++p_) { const int pc_ = tid + 512 * p_; \
            _Pragma("unroll") for (int q_ = 0; q_ < NQ; ++q_) *(LAS v4u*)((bufp) + q_ * QB + pc_ * 16) = rq[q_][p_]; } \
        if (tid < 256) *(LAS v4u*)((bufp) + VB_OFF + tid * 16) = rv; } while (0)
        __syncthreads();
        MIX_LOAD(0); MIX_STORE(F.lds);
        __syncthreads();
        for (int c = 0; c < NCH; ++c) {
            LAS unsigned char* cur = F.lds + (c & 1) * BUF; LAS unsigned char* nxt = F.lds + ((c + 1) & 1) * BUF;
            if (c + 1 < NCH) MIX_LOAD(c + 1);
            const int rlo = MIX_ROWLO(c);
            const bool do_out = ctx_out || c >= CTXL / CH;
#pragma unroll 2
            for (int s = 0; s < CH; ++s) {
                const int lrow = dir ? (CH - 1 - s) : s;
                float q[DPL], k[DPL], f[DPL];
                if (HG) {
                    const unsigned qw = *(const LAS unsigned*)(cur + lrow * 256 + lane * 4), lw = *(const LAS unsigned*)(cur + QB + lrow * 256 + lane * 4), kw = *(const LAS unsigned*)(cur + 2 * QB + lrow * 256 + lane * 4);
                    q[0] = bflo(qw); q[1] = bfhi(qw); f[0] = __expf(bflo(lw)); f[1] = __expf(bfhi(lw)); k[0] = bflo(kw); k[1] = bfhi(kw);
                } else {
                    const v2u qw = *(const LAS v2u*)(cur + lrow * 512 + lane * 8), kw = *(const LAS v2u*)(cur + QB + lrow * 512 + lane * 8);
                    q[0] = bflo(qw.x); q[1] = bfhi(qw.x); q[DPL - 2] = bflo(qw.y); q[DPL - 1] = bfhi(qw.y);
                    k[0] = bflo(kw.x); k[1] = bfhi(kw.x); k[DPL - 2] = bflo(kw.y); k[DPL - 1] = bfhi(kw.y);
#pragma unroll
                    for (int i = 0; i < DPL; ++i) f[i] = gamma;
                }
                const v4u vw = *(const LAS v4u*)(cur + VB_OFF + lrow * 128 + w * 16);
                const float v[8] = {bflo(vw.x), bfhi(vw.x), bflo(vw.y), bfhi(vw.y), bflo(vw.z), bfhi(vw.z), bflo(vw.w), bfhi(vw.w)};
                float p[8];
#pragma unroll
                for (int jj = 0; jj < 8; ++jj) {
                    float acc = 0.f;
#pragma unroll
                    for (int i = 0; i < DPL; ++i) { S[i][jj] = fmaf(f[i], S[i][jj], k[i] * v[jj]); acc = fmaf(q[i], S[i][jj], acc); }
                    p[jj] = acc;
                }
                if (do_out) {
                    const bool h1 = (lane & 32) != 0, h2 = (lane & 16) != 0, h3 = (lane & 8) != 0;
                    float a4[4], a2[2];
#pragma unroll
                    for (int jj = 0; jj < 4; ++jj) { const float snd = h1 ? p[jj] : p[jj + 4]; const float rcv = __shfl_xor(snd, 32); a4[jj] = (h1 ? p[jj + 4] : p[jj]) + rcv; }
#pragma unroll
                    for (int jj = 0; jj < 2; ++jj) { const float snd = h2 ? a4[jj] : a4[jj + 2]; const float rcv = __shfl_xor(snd, 16); a2[jj] = (h2 ? a4[jj + 2] : a4[jj]) + rcv; }
                    float r1; { const float snd = h3 ? a2[0] : a2[1]; const float rcv = __shfl_xor(snd, 8); r1 = (h3 ? a2[1] : a2[0]) + rcv; }
                    r1 += __shfl_xor(r1, 4); r1 += __shfl_xor(r1, 2); r1 += __shfl_xor(r1, 1);
                    if ((lane & 7) == 0) O[(size_t)(rlo + lrow) * D + h * HD + eb * 64 + w * 8 + (lane >> 3)] = (bf16)f2bf(r1);
                }
            }
            if (c + 1 < NCH) MIX_STORE(nxt);
            __syncthreads();
        }
#undef MIX_ROWLO
#undef MIX_LOAD
#undef MIX_STORE
    }
}


typedef short mx_bf16x8 __attribute__((ext_vector_type(8)));
typedef short mx_s4 __attribute__((ext_vector_type(4)));
#ifndef MX_SWZ
#define MX_SWZ 0
#endif
constexpr int MX_PS = MX_SWZ ? 128 : 144;
__device__ __forceinline__ int sw16(int row) { return MX_SWZ ? 2 * (row & 3) + 8 * ((row >> 3) & 1) : 0; }
__device__ __forceinline__ int sw8(int row) { return MX_SWZ ? (row >> 1) & 7 : 0; }
__device__ __forceinline__ mx_bf16x8 frag_row(const LAS unsigned char* img, int stride, int row0, int k0, int lane) {
    const int row = row0 + (lane & 15);
    return *(const LAS mx_bf16x8*)(img + row * stride + 16 * (((k0 >> 3) + (lane >> 4)) ^ sw16(row)));
}
__device__ __forceinline__ mx_bf16x8 frag_row8(const LAS unsigned char* img, int row0, int k0, int lane) {
    const int row = row0 + (lane & 15);
    return *(const LAS mx_bf16x8*)(img + row * MX_PS + 16 * (((k0 >> 3) + (lane >> 4)) ^ sw8(row)));
}
__device__ __forceinline__ mx_bf16x8 frag_tr(const LAS unsigned char* img, int stride, int k0, int c0, int lane) {
    const int g = lane >> 4, i = lane & 15, q = i >> 2, p = i & 3;
    const int row = k0 + 8 * g + q;
    const LAS unsigned char* ad = img + row * stride + 16 * (((c0 >> 3) + (p >> 1)) ^ sw16(row)) + 8 * (p & 1);
    const mx_s4 x = __builtin_amdgcn_ds_read_tr16_b64_v4i16((LAS mx_s4*)ad);
    const mx_s4 y = __builtin_amdgcn_ds_read_tr16_b64_v4i16((LAS mx_s4*)(ad + 4 * stride));
    return (mx_bf16x8){x[0], x[1], x[2], x[3], y[0], y[1], y[2], y[3]};
}
#define MX_MFMA(a, b, c) __builtin_amdgcn_mfma_f32_16x16x32_bf16((a), (b), (c), 0, 0, 0)
#define MX_BAR() do { asm volatile("s_waitcnt lgkmcnt(0)" ::: "memory"); __builtin_amdgcn_s_barrier(); if (MXP_BAR > 1) __builtin_amdgcn_s_barrier(); asm volatile("" ::: "memory"); } while (0)

template <bool HG, int VAR = 0>
__device__ __forceinline__ void mixer_mfma(const Args& a, Frame& F, int j_layer, bool ctx_out) {
    relaunder(F);
    float zf_ = 0.f; asm volatile("" : "+v"(zf_));
    const f32x4 ZERO4 = {zf_, zf_, zf_, zf_};
    constexpr int HD = HG ? 128 : 256, NH = HG ? 16 : 8, NEB = HD / 64, C = 64, NCTX = CTXL / C, NCH = (CTXL + SEQ) / C;
    constexpr int KS = HD / 32;
    constexpr int DT = HD / 128;
    constexpr int QS = HD * 2 + (MX_SWZ ? 0 : 16);
    constexpr int IMG = 64 * QS;
    constexpr int PS = MX_PS;
    constexpr int NI = HG ? 4 : 2;
    constexpr int O_VT = NI * IMG, O_P = O_VT + 64 * PS, O_ST = O_P + 64 * PS, O_TOT = O_ST + IMG, O_END = O_TOT + 4 * 128 * 4 + 128 * 4;
    static_assert(O_END <= RING_BYTES, "mixer LDS");
    const int lane = F.lane, w = F.wave, tid = F.tid, g = lane >> 4, i = lane & 15;
    const int rg = w >> 1, cg = w & 1, nq0 = 16 * rg;
    LAS unsigned char* const L = F.lds;
    const bf16* act = (const bf16*)(a.ws + WS_ACT);
    for (int task = F.vcu; task < BATCH * NH * 2 * NEB; task += F.G) {
        const int eb = task % NEB, dir = (task / NEB) & 1, h = (task / (2 * NEB)) % NH, b = task / (2 * NEB * NH);
        bf16* O = (bf16*)(a.ws + (dir ? WS_OB : WS_OF));
        const bf16* src0 = act;
        const bf16* src1 = act + (size_t)(HG ? (2 + 2 * dir) : 1) * ACT_STRIDE;
        const bf16* src2 = act + (size_t)(1 + 2 * dir) * ACT_STRIDE;
        const bf16* srcv = act + (size_t)(HG ? 5 : 2) * ACT_STRIDE;
        float lg2 = 0.f;
        if (!HG) { const float x = a.in[10][(j_layer * 2 + dir) * 8 + h]; lg2 = -log1pf(expf(-x)) * 1.4426950408889634f; }
        const float r1 = HG ? 1.f : exp2f((float)(nq0 + i - 63) * lg2), r2 = HG ? 1.f : exp2f((float)(nq0 + i + 1) * lg2), cdec = HG ? 1.f : exp2f(64.f * lg2);
        const int vrow = tid & 63, vcc = tid >> 6;
        const int vs = dir ? 63 - vrow : vrow;
        const float kdec = HG ? 1.f : exp2f((float)(63 - vs) * lg2);
        f32x4 accS[DT][4];
#pragma unroll
        for (int td = 0; td < DT; ++td)
#pragma unroll
            for (int te = 0; te < 4; ++te) accS[td][te] = ZERO4;
        constexpr int NPQ = HG ? 2 : 4;
        constexpr int PF = HG ? MX_PF_HG : MX_PF_RET;
        static_assert(NCH % PF == 0, "prefetch depth must divide the chunk count");
        v4u rq[PF][HG ? 3 : 2][NPQ]; v4u rv[PF];
#define MX_ROWLO(c) (((c) < NCTX) ? (ML + b * CTXL + (dir ? (NCTX - 1 - (c)) : (c)) * C) : (b * SEQ + (dir ? (SEQ / C - 1 - ((c) - NCTX)) : ((c) - NCTX)) * C))
#define MX_LOAD(c, SET) do { const int rlo_ = (VAR & 1) ? MX_ROWLO(0) : MX_ROWLO(c); \
        _Pragma("unroll") for (int p_ = 0; p_ < NPQ; ++p_) { const int pc_ = tid + 512 * p_; const int row_ = pc_ / (HD / 8), cc_ = pc_ % (HD / 8); \
            const size_t go_ = (size_t)(rlo_ + row_) * D + h * HD + cc_ * 8; \
            rq[SET][0][p_] = *(const GAS v4u*)(src0 + go_); rq[SET][1][p_] = *(const GAS v4u*)(src1 + go_); if (HG) rq[SET][HG ? 2 : 1][p_] = *(const GAS v4u*)(src2 + go_); } \
        rv[SET] = *(const GAS v4u*)(srcv + (size_t)(rlo_ + vrow) * D + h * HD + eb * 64 + vcc * 8); } while (0)
#define MX_STAGE(SET) do { \
        _Pragma("unroll") for (int p_ = 0; p_ < NPQ; ++p_) { const int pc_ = tid + 512 * p_; const int row_ = pc_ / (HD / 8), cc_ = pc_ % (HD / 8); const int s_ = dir ? 63 - row_ : row_; \
            const int so_ = s_ * QS + 16 * (cc_ ^ sw16(s_)); *(LAS v4u*)(L + so_) = rq[SET][0][p_]; *(LAS v4u*)(L + IMG + so_) = rq[SET][1][p_]; if (HG) *(LAS v4u*)(L + 2 * IMG + so_) = rq[SET][HG ? 2 : 1][p_]; } \
        { const unsigned vw_[4] = {rv[SET].x, rv[SET].y, rv[SET].z, rv[SET].w}; \
          _Pragma("unroll") for (int jj_ = 0; jj_ < 4; ++jj_) { \
              *(LAS unsigned short*)(L + O_VT + (vcc * 8 + 2 * jj_) * PS + 16 * ((vs >> 3) ^ sw8(vcc * 8 + 2 * jj_)) + (vs & 7) * 2) = (unsigned short)(pk2(bflo(vw_[jj_]) * kdec, bfhi(vw_[jj_]) * kdec) & 0xffffu); \
              *(LAS unsigned short*)(L + O_VT + (vcc * 8 + 2 * jj_ + 1) * PS + 16 * ((vs >> 3) ^ sw8(vcc * 8 + 2 * jj_ + 1)) + (vs & 7) * 2) = (unsigned short)(pk2(bflo(vw_[jj_]) * kdec, bfhi(vw_[jj_]) * kdec) >> 16); } } } while (0)
        __syncthreads();
        for (int u = tid; u < IMG / 16; u += NWAVES * 64) { const unsigned zu_ = __builtin_bit_cast(unsigned, zf_); *(LAS v4u*)(L + O_ST + u * 16) = (v4u){zu_, zu_, zu_, zu_}; }
#pragma unroll
        for (int u = 0; u < PF; ++u) MX_LOAD(u, u);
        for (int c0 = 0; c0 < NCH; c0 += PF)
#pragma unroll
        for (int u = 0; u < PF; ++u) {
            const int c = c0 + u;
            MX_STAGE(u);
            if (MXP_STG > 1) { asm volatile("" ::: "memory"); MX_STAGE(u); }
            if (HG) {
                MX_BAR();
                const int d = tid & 127, qr = tid >> 7;
                float cl[16], qv[16], kv[16]; float run = 0.f;
#pragma unroll
                for (int ii = 0; ii < 16; ++ii) { const int s = 16 * qr + ii;
                    const int eo = s * QS + 16 * ((d >> 3) ^ sw16(s)) + (d & 7) * 2;
                    run += bflo((unsigned)*(const LAS unsigned short*)(L + 2 * IMG + eo)); cl[ii] = run;
                    qv[ii] = bflo((unsigned)*(const LAS unsigned short*)(L + eo)); kv[ii] = bflo((unsigned)*(const LAS unsigned short*)(L + IMG + eo)); }
                LAS float* tot = (LAS float*)(L + O_TOT);
                tot[qr * 128 + d] = run;
                MX_BAR();
                const float t0 = tot[d], t1 = tot[128 + d], t2 = tot[256 + d], t3 = tot[384 + d];
                const float off = (qr == 0) ? 0.f : (qr == 1) ? t0 : (qr == 2) ? (t0 + t1) : (t0 + t1 + t2);
                const float cref = t0 + t1, cend = (t0 + t1) + (t2 + t3);
                if (qr == 0) tot[512 + d] = cend;
#pragma unroll
                for (int ii = 0; ii < 16; ++ii) { const int s = 16 * qr + ii; const float cm = off + cl[ii]; const int eo = s * QS + 16 * ((d >> 3) ^ sw16(s)) + (d & 7) * 2;
                    const float e1 = __expf(fminf(cm - cref, 80.f)), e2 = __expf(fminf(cref - cm, 80.f)), e3 = __expf(cm), e4 = __expf(cend - cm);
                    const unsigned w12 = pk2(qv[ii] * e1, kv[ii] * e2), w34 = pk2(qv[ii] * e3, kv[ii] * e4);
                    *(LAS unsigned short*)(L + eo) = (unsigned short)(w12 & 0xffffu);
                    *(LAS unsigned short*)(L + IMG + eo) = (unsigned short)(w12 >> 16);
                    *(LAS unsigned short*)(L + 2 * IMG + eo) = (unsigned short)(w34 & 0xffffu);
                    *(LAS unsigned short*)(L + 3 * IMG + eo) = (unsigned short)(w34 >> 16); }
            }
            MX_BAR();
            { const int cn = (c + PF < NCH) ? c + PF : NCH - 1; MX_LOAD(cn, u); }
            if (MXP_SLEEP > 0) __builtin_amdgcn_s_sleep(MXP_SLEEP);
            const int rlo = MX_ROWLO(c);
            const bool do_out = ctx_out || c >= NCTX;
            mx_bf16x8 aq[KS];
            if (do_out) {
#pragma unroll
                for (int ks = 0; ks < KS; ++ks) aq[ks] = frag_row(L, QS, nq0, 32 * ks, lane);
                for (int rep1 = 0; rep1 < MXP_S1; ++rep1) {
                f32x4 pt0 = ZERO4, pt1 = ZERO4;
#pragma unroll
                for (int kb = 0; kb < KS; kb += 4) {
                    mx_bf16x8 kf[2][4];
#pragma unroll
                    for (int ks = 0; ks < 4; ++ks) { kf[0][ks] = frag_row(L + IMG, QS, 32 * cg, 32 * (kb + ks), lane); kf[1][ks] = frag_row(L + IMG, QS, 32 * cg + 16, 32 * (kb + ks), lane); }
                    __builtin_amdgcn_sched_barrier(0);
#pragma unroll
                    for (int ks = 0; ks < 4; ++ks) { pt0 = MX_MFMA(kf[0][ks], aq[kb + ks], pt0); pt1 = MX_MFMA(kf[1][ks], aq[kb + ks], pt1); }
                    __builtin_amdgcn_sched_barrier(0);
                }
                const int m0 = 32 * cg + 4 * g, n = nq0 + i;
                v2u pw; pw.x = pk2((m0 <= n) ? pt0[0] : 0.f, (m0 + 1 <= n) ? pt0[1] : 0.f); pw.y = pk2((m0 + 2 <= n) ? pt0[2] : 0.f, (m0 + 3 <= n) ? pt0[3] : 0.f);
                *(LAS v2u*)(L + O_P + n * PS + 16 * ((m0 >> 3) ^ sw8(n)) + (m0 & 7) * 2) = pw;
                const int m1 = m0 + 16;
                pw.x = pk2((m1 <= n) ? pt1[0] : 0.f, (m1 + 1 <= n) ? pt1[1] : 0.f); pw.y = pk2((m1 + 2 <= n) ? pt1[2] : 0.f, (m1 + 3 <= n) ? pt1[3] : 0.f);
                *(LAS v2u*)(L + O_P + n * PS + 16 * ((m1 >> 3) ^ sw8(n)) + (m1 & 7) * 2) = pw;
                }
            }
            {
                mx_bf16x8 vt[4][2], ak[DT][2]; f32x4 dec[DT];
#pragma unroll
                for (int te = 0; te < 4; ++te) { vt[te][0] = frag_row8(L + O_VT, 16 * te, 0, lane); vt[te][1] = frag_row8(L + O_VT, 16 * te, 32, lane); }
#pragma unroll
                for (int td = 0; td < DT; ++td) { const int d0 = 16 * (DT * w + td);
                    ak[td][0] = frag_tr(L + (HG ? 3 : 1) * IMG, QS, 0, d0, lane); ak[td][1] = frag_tr(L + (HG ? 3 : 1) * IMG, QS, 32, d0, lane);
                    dec[td] = (f32x4){cdec, cdec, cdec, cdec};
                    if (HG) { const f32x4 ce = *(const LAS f32x4*)(L + O_TOT + 2048 + (d0 + 4 * g) * 4); dec[td] = (f32x4){__expf(ce[0]), __expf(ce[1]), __expf(ce[2]), __expf(ce[3])}; } }
                __builtin_amdgcn_sched_barrier(0);
#pragma unroll
                for (int td = 0; td < DT; ++td)
#pragma unroll
                    for (int te = 0; te < 4; ++te) accS[td][te] = MX_MFMA(ak[td][0], vt[te][0], accS[td][te] * dec[td]);
#pragma unroll
                for (int td = 0; td < DT; ++td)
#pragma unroll
                    for (int te = 0; te < 4; ++te) accS[td][te] = MX_MFMA(ak[td][1], vt[te][1], accS[td][te]);
            }
            MX_BAR();
            if (do_out) {
                if (HG) {
#pragma unroll
                    for (int ks = 0; ks < KS; ++ks) aq[ks] = frag_row(L + 2 * IMG, QS, nq0, 32 * ks, lane);
                }
                mx_bf16x8 vo[2][2];
                const mx_bf16x8 bp0 = frag_row8(L + O_P, nq0, 0, lane), bp1 = frag_row8(L + O_P, nq0, 32, lane);
#pragma unroll
                for (int te = 0; te < 2; ++te) { vo[te][0] = frag_row8(L + O_VT, 32 * cg + 16 * te, 0, lane); vo[te][1] = frag_row8(L + O_VT, 32 * cg + 16 * te, 32, lane); }
                const int grow = rlo + (dir ? 63 - (nq0 + i) : (nq0 + i));
                for (int rep2 = 0; rep2 < MXP_S2; ++rep2) {
                f32x4 o1a = ZERO4, o1b = o1a, o2a = o1a, o2b = o1a;
#pragma unroll
                for (int kb = 0; kb < KS; kb += 4) {
                    mx_bf16x8 st[2][4];
#pragma unroll
                    for (int ks = 0; ks < 4; ++ks) { st[0][ks] = frag_row(L + O_ST, QS, 32 * cg, 32 * (kb + ks), lane); st[1][ks] = frag_row(L + O_ST, QS, 32 * cg + 16, 32 * (kb + ks), lane); }
                    __builtin_amdgcn_sched_barrier(0);
                    if (kb == 0) { o1a = MX_MFMA(vo[0][0], bp0, o1a); o1b = MX_MFMA(vo[1][0], bp0, o1b); o1a = MX_MFMA(vo[0][1], bp1, o1a); o1b = MX_MFMA(vo[1][1], bp1, o1b); }
#pragma unroll
                    for (int ks = 0; ks < 4; ++ks) { o2a = MX_MFMA(st[0][ks], aq[kb + ks], o2a); o2b = MX_MFMA(st[1][ks], aq[kb + ks], o2b); }
                    __builtin_amdgcn_sched_barrier(0);
                }
                bf16* op = O + (size_t)grow * D + h * HD + eb * 64 + 32 * cg + 4 * g;
                if (!(VAR & 2)) { const f32x4 ya = o1a * r1 + o2a * r2, yb = o1b * r1 + o2b * r2; v2u wa, wb; wa.x = pk2(ya[0], ya[1]); wa.y = pk2(ya[2], ya[3]); wb.x = pk2(yb[0], yb[1]); wb.y = pk2(yb[2], yb[3]);
                    *(GAS v2u*)(op) = wa; *(GAS v2u*)(op + 16) = wb; }
                else { asm volatile("" :: "v"(o1a), "v"(o1b), "v"(o2a), "v"(o2b)); }
                }
            }
            MX_BAR();
#pragma unroll
            for (int td = 0; td < DT; ++td)
#pragma unroll
                for (int te = 0; te < 4; ++te) { const int d0 = 16 * (DT * w + td); const f32x4 s = accS[td][te];
                    v2u sw; sw.x = pk2(s[0], s[1]); sw.y = pk2(s[2], s[3]);
                    *(LAS v2u*)(L + O_ST + (16 * te + i) * QS + 16 * (((d0 + 4 * g) >> 3) ^ sw16(16 * te + i)) + ((d0 + 4 * g) & 7) * 2) = sw; }
        }
#undef MX_ROWLO
#undef MX_LOAD
#undef MX_STAGE
    }
}

__device__ __forceinline__ void mixer_hg2(const Args& a, Frame& F, bool ctx_out) {
    relaunder(F);
    float zf_ = 0.f; asm volatile("" : "+v"(zf_));
    const f32x4 ZERO4 = {zf_, zf_, zf_, zf_};
    constexpr int HD = 128, NH = 16, NEB = 2, C = 64, NCTX = CTXL / C, NCH = (CTXL + SEQ) / C, KS = HD / 32;
    constexpr int QS = HD * 2 + 16, IMG = 64 * QS, PS = MX_PS;
    constexpr int O_VT = 3 * IMG, O_P = O_VT + 64 * PS, O_ST = O_P + 64 * PS, O_END = O_ST + IMG;
    static_assert(O_END <= RING_BYTES && MX_SWZ == 0, "mixer_hg2 LDS (padded images)");
    const int lane = F.lane, w = F.wave, tid = F.tid, g = lane >> 4, i = lane & 15;
    const int rg = w >> 1, cg = w & 1, nq0 = 16 * rg;
    LAS unsigned char* const L = F.lds;
    const bf16* act = (const bf16*)(a.ws + WS_ACT);
    for (int task = F.vcu; task < BATCH * NH * 2 * NEB; task += F.G) {
        const int eb = task % NEB, dir = (task / NEB) & 1, h = (task / (2 * NEB)) % NH, b = task / (2 * NEB * NH);
        bf16* O = (bf16*)(a.ws + (dir ? WS_OB : WS_OF));
        const bf16* src0 = act;
        const bf16* src1 = act + (size_t)(2 + 2 * dir) * ACT_STRIDE;
        const bf16* src2 = act + (size_t)(1 + 2 * dir) * ACT_STRIDE;
        const bf16* srcv = act + (size_t)5 * ACT_STRIDE;
        const int vrow = tid & 63, vcc = tid >> 6, vs = dir ? 63 - vrow : vrow;
        f32x4 accS[4];
#pragma unroll
        for (int te = 0; te < 4; ++te) accS[te] = ZERO4;
        constexpr int PF = MX_PF_HG;
        static_assert(NCH % PF == 0, "prefetch depth must divide the chunk count");
        v4u rq[PF][3][2]; v4u rv[PF];
#define H2_ROWLO(c) (((c) < NCTX) ? (ML + b * CTXL + (dir ? (NCTX - 1 - (c)) : (c)) * C) : (b * SEQ + (dir ? (SEQ / C - 1 - ((c) - NCTX)) : ((c) - NCTX)) * C))
#define H2_LOAD(c, SET) do { const int rlo_ = H2_ROWLO(c); \
        _Pragma("unroll") for (int p_ = 0; p_ < 2; ++p_) { const int pc_ = tid + 512 * p_; const size_t go_ = (size_t)(rlo_ + (pc_ >> 4)) * D + h * HD + (pc_ & 15) * 8; \
            rq[SET][0][p_] = *(const GAS v4u*)(src0 + go_); rq[SET][1][p_] = *(const GAS v4u*)(src1 + go_); rq[SET][2][p_] = *(const GAS v4u*)(src2 + go_); } \
        rv[SET] = *(const GAS v4u*)(srcv + (size_t)(rlo_ + vrow) * D + h * HD + eb * 64 + vcc * 8); } while (0)
#define H2_STAGE(SET) do { \
        _Pragma("unroll") for (int p_ = 0; p_ < 2; ++p_) { const int pc_ = tid + 512 * p_; const int row_ = pc_ >> 4; const int s_ = dir ? 63 - row_ : row_; const int so_ = s_ * QS + (pc_ & 15) * 16; \
            *(LAS v4u*)(L + so_) = rq[SET][0][p_]; *(LAS v4u*)(L + IMG + so_) = rq[SET][1][p_]; *(LAS v4u*)(L + 2 * IMG + so_) = rq[SET][2][p_]; } \
        { const unsigned vw_[4] = {rv[SET].x, rv[SET].y, rv[SET].z, rv[SET].w}; \
          _Pragma("unroll") for (int jj_ = 0; jj_ < 4; ++jj_) { \
              *(LAS unsigned short*)(L + O_VT + (vcc * 8 + 2 * jj_) * PS + vs * 2) = (unsigned short)(vw_[jj_] & 0xffffu); \
              *(LAS unsigned short*)(L + O_VT + (vcc * 8 + 2 * jj_ + 1) * PS + vs * 2) = (unsigned short)(vw_[jj_] >> 16); } } } while (0)
        __syncthreads();
#pragma unroll
        for (int u = 0; u < PF; ++u) H2_LOAD(u, u);
        for (int c0 = 0; c0 < NCH; c0 += PF)
#pragma unroll
        for (int u = 0; u < PF; ++u) {
            const int c = c0 + u;
            H2_STAGE(u);
            MX_BAR();
            { const int cn = (c + PF < NCH) ? c + PF : NCH - 1; H2_LOAD(cn, u); }
            f32x4 fe, fu;
            {
                unsigned one2_ = 0x3F803F80u; asm volatile("" : "+v"(one2_));
                typedef unsigned u4_ __attribute__((ext_vector_type(4)));
                const mx_bf16x8 ones = __builtin_bit_cast(mx_bf16x8, (u4_){one2_, one2_, one2_, one2_});
                const mx_bf16x8 a0 = frag_tr(L + 2 * IMG, QS, 0, 16 * w, lane), a1 = frag_tr(L + 2 * IMG, QS, 32, 16 * w, lane);
                mx_bf16x8 bt0, bt1;
                { int ln_ = lane; asm volatile("" : "+v"(ln_)); const int g_ = ln_ >> 4, i_ = ln_ & 15;
#pragma unroll
                  for (int j = 0; j < 8; ++j) { bt0[j] = (8 * g_ + j <= i_) ? (short)0x3F80 : (short)0; bt1[j] = (8 * g_ + j <= 16 + i_) ? (short)0x3F80 : (short)0; } }
                const f32x4 z = ZERO4;
                f32x4 ct[4];
                ct[0] = MX_MFMA(a0, bt0, z); ct[1] = MX_MFMA(a0, bt1, z);
                const f32x4 cref = MX_MFMA(a0, ones, z);
                ct[2] = MX_MFMA(a1, bt0, cref); ct[3] = MX_MFMA(a1, bt1, cref);
                const f32x4 cend = MX_MFMA(a1, ones, cref);
                fe = (f32x4){__expf(cend[0]), __expf(cend[1]), __expf(cend[2]), __expf(cend[3])};
                fu = (f32x4){__expf(cend[0] - cref[0]), __expf(cend[1] - cref[1]), __expf(cend[2] - cref[2]), __expf(cend[3] - cref[3])};
                const f32x4 fs = {__expf(cref[0]), __expf(cref[1]), __expf(cref[2]), __expf(cref[3])};
#pragma unroll
                for (int te = 0; te < 4; ++te) { const f32x4 s = accS[te] * fs; v2u sw; sw.x = pk2(s[0], s[1]); sw.y = pk2(s[2], s[3]);
                    *(LAS v2u*)(L + O_ST + (16 * te + i) * QS + (16 * w + 4 * g) * 2) = sw; }
#pragma unroll
                for (int t = 0; t < 4; ++t) {
                    LAS unsigned char* pq = L + (16 * t + i) * QS + (16 * w + 4 * g) * 2;
                    const v2u qw = *(const LAS v2u*)pq, kw = *(const LAS v2u*)(pq + IMG);
                    f32x4 e1;
#pragma unroll
                    for (int r = 0; r < 4; ++r) e1[r] = __expf(fminf(fmaxf(ct[t][r] - cref[r], -80.f), 80.f));
                    const f32x4 e2 = {__builtin_amdgcn_rcpf(e1[0]), __builtin_amdgcn_rcpf(e1[1]), __builtin_amdgcn_rcpf(e1[2]), __builtin_amdgcn_rcpf(e1[3])};
                    v2u qo, ko;
                    qo.x = pk2(bflo(qw.x) * e1[0], bfhi(qw.x) * e1[1]); qo.y = pk2(bflo(qw.y) * e1[2], bfhi(qw.y) * e1[3]);
                    ko.x = pk2(bflo(kw.x) * e2[0], bfhi(kw.x) * e2[1]); ko.y = pk2(bflo(kw.y) * e2[2], bfhi(kw.y) * e2[3]);
                    *(LAS v2u*)pq = qo; *(LAS v2u*)(pq + IMG) = ko;
                }
            }
            MX_BAR();
            const int rlo = H2_ROWLO(c);
            const bool do_out = ctx_out || c >= NCTX;
            mx_bf16x8 aq[KS];
            {
                mx_bf16x8 kf[2][KS], vt[4][2];
                if (do_out) {
#pragma unroll
                    for (int ks = 0; ks < KS; ++ks) { aq[ks] = frag_row(L, QS, nq0, 32 * ks, lane); kf[0][ks] = frag_row(L + IMG, QS, 32 * cg, 32 * ks, lane); kf[1][ks] = frag_row(L + IMG, QS, 32 * cg + 16, 32 * ks, lane); }
                }
#pragma unroll
                for (int te = 0; te < 4; ++te) { vt[te][0] = frag_row8(L + O_VT, 16 * te, 0, lane); vt[te][1] = frag_row8(L + O_VT, 16 * te, 32, lane); }
                const mx_bf16x8 ak0 = frag_tr(L + IMG, QS, 0, 16 * w, lane), ak1 = frag_tr(L + IMG, QS, 32, 16 * w, lane);
                __builtin_amdgcn_sched_barrier(0);
                f32x4 pt0 = ZERO4, pt1 = ZERO4;
                if (do_out) {
#pragma unroll
                    for (int ks = 0; ks < KS; ++ks) { pt0 = MX_MFMA(kf[0][ks], aq[ks], pt0); pt1 = MX_MFMA(kf[1][ks], aq[ks], pt1); }
                }
                f32x4 uu[4];
#pragma unroll
                for (int te = 0; te < 4; ++te) { const f32x4 z4 = ZERO4; uu[te] = MX_MFMA(ak0, vt[te][0], z4); }
#pragma unroll
                for (int te = 0; te < 4; ++te) uu[te] = MX_MFMA(ak1, vt[te][1], uu[te]);
                __builtin_amdgcn_sched_barrier(0);
                if (do_out) {
                    const int m0 = 32 * cg + 4 * g, m1 = m0 + 16, n = nq0 + i;
                    v2u pw; pw.x = pk2((m0 <= n) ? pt0[0] : 0.f, (m0 + 1 <= n) ? pt0[1] : 0.f); pw.y = pk2((m0 + 2 <= n) ? pt0[2] : 0.f, (m0 + 3 <= n) ? pt0[3] : 0.f);
                    *(LAS v2u*)(L + O_P + n * PS + m0 * 2) = pw;
                    pw.x = pk2((m1 <= n) ? pt1[0] : 0.f, (m1 + 1 <= n) ? pt1[1] : 0.f); pw.y = pk2((m1 + 2 <= n) ? pt1[2] : 0.f, (m1 + 3 <= n) ? pt1[3] : 0.f);
                    *(LAS v2u*)(L + O_P + n * PS + m1 * 2) = pw;
                }
#pragma unroll
                for (int te = 0; te < 4; ++te) accS[te] = accS[te] * fe + uu[te] * fu;
            }
            mx_bf16x8 st[2][KS], vo[2][2];
            if (do_out) {
#pragma unroll
                for (int te = 0; te < 2; ++te) { vo[te][0] = frag_row8(L + O_VT, 32 * cg + 16 * te, 0, lane); vo[te][1] = frag_row8(L + O_VT, 32 * cg + 16 * te, 32, lane);
#pragma unroll
                    for (int ks = 0; ks < KS; ++ks) st[te][ks] = frag_row(L + O_ST, QS, 32 * cg + 16 * te, 32 * ks, lane); }
            }
            MX_BAR();
            if (do_out) {
                const mx_bf16x8 bp0 = frag_row8(L + O_P, nq0, 0, lane), bp1 = frag_row8(L + O_P, nq0, 32, lane);
                __builtin_amdgcn_sched_barrier(0);
                f32x4 oa = ZERO4, ob = oa;
                oa = MX_MFMA(vo[0][0], bp0, oa); ob = MX_MFMA(vo[1][0], bp0, ob);
#pragma unroll
                for (int ks = 0; ks < KS; ++ks) { oa = MX_MFMA(st[0][ks], aq[ks], oa); ob = MX_MFMA(st[1][ks], aq[ks], ob); }
                oa = MX_MFMA(vo[0][1], bp1, oa); ob = MX_MFMA(vo[1][1], bp1, ob);
                bf16* op = O + (size_t)(rlo + (dir ? 63 - (nq0 + i) : (nq0 + i))) * D + h * HD + eb * 64 + 32 * cg + 4 * g;
                v2u wa, wb; wa.x = pk2(oa[0], oa[1]); wa.y = pk2(oa[2], oa[3]); wb.x = pk2(ob[0], ob[1]); wb.y = pk2(ob[2], ob[3]);
                *(GAS v2u*)(op) = wa; *(GAS v2u*)(op + 16) = wb;
            }
            MX_BAR();
        }
#undef H2_ROWLO
#undef H2_LOAD
#undef H2_STAGE
    }
}

__device__ __forceinline__ void mixer_ret3(const Args& a, Frame& F, int j_layer, bool ctx_out) {
    relaunder(F);
    float zf_ = 0.f; asm volatile("" : "+v"(zf_));
    const f32x4 ZERO4 = {zf_, zf_, zf_, zf_};
    constexpr int HD = 256, NH = 8, NEB = 4, C = 64, NCTX = CTXL / C, NCH = (CTXL + SEQ) / C, KS = HD / 32;
    constexpr int QS = HD * 2 + 16, IMG = 64 * QS, PS = MX_PS, VTB = 64 * PS;
    constexpr int O_VT = 2 * IMG, O_P = O_VT + 2 * VTB, O_ST = O_P + VTB, O_END = O_ST + IMG;
    static_assert(O_END <= RING_BYTES && MX_SWZ == 0, "mixer_ret3 LDS (padded images)");
    const int lane = F.lane, w = F.wave, tid = F.tid, g = lane >> 4, i = lane & 15;
    const int rg = w >> 1, cg = w & 1, nq0 = 16 * rg;
    LAS unsigned char* const L = F.lds;
    const bf16* act = (const bf16*)(a.ws + WS_ACT);
    for (int task = F.vcu; task < BATCH * NH * 2 * NEB; task += F.G) {
        const int eb = task % NEB, dir = (task / NEB) & 1, h = (task / (2 * NEB)) % NH, b = task / (2 * NEB * NH);
        bf16* O = (bf16*)(a.ws + (dir ? WS_OB : WS_OF));
        const bf16* src0 = act; const bf16* src1 = act + ACT_STRIDE; const bf16* srcv = act + (size_t)2 * ACT_STRIDE;
        const float x = a.in[10][(j_layer * 2 + dir) * 8 + h];
        const float lg2 = -log1pf(expf(-x)) * 1.4426950408889634f;
        const float r1 = exp2f((float)(nq0 + i - 63) * lg2), r2 = exp2f((float)(nq0 + i + 1) * lg2), cdec = exp2f(64.f * lg2);
        const int vrow = tid & 63, vcc = tid >> 6, vs = dir ? 63 - vrow : vrow;
        const float kdec = exp2f((float)(63 - vs) * lg2);
        f32x4 accS[2][4];
#pragma unroll
        for (int td = 0; td < 2; ++td)
#pragma unroll
            for (int te = 0; te < 4; ++te) accS[td][te] = ZERO4;
        v4u rq[2][4]; v4u rv;
#define R3_ROWLO(c) (((c) < NCTX) ? (ML + b * CTXL + (dir ? (NCTX - 1 - (c)) : (c)) * C) : (b * SEQ + (dir ? (SEQ / C - 1 - ((c) - NCTX)) : ((c) - NCTX)) * C))
#define R3_LOAD(c) do { const int rlo_ = R3_ROWLO(c); \
        _Pragma("unroll") for (int p_ = 0; p_ < 4; ++p_) { const int pc_ = tid + 512 * p_; const size_t go_ = (size_t)(rlo_ + (pc_ >> 5)) * D + h * HD + (pc_ & 31) * 8; \
            rq[0][p_] = *(const GAS v4u*)(src0 + go_); rq[1][p_] = *(const GAS v4u*)(src1 + go_); } \
        rv = *(const GAS v4u*)(srcv + (size_t)(rlo_ + vrow) * D + h * HD + eb * 64 + vcc * 8); } while (0)
#define R3_STAGE(vb) do { \
        _Pragma("unroll") for (int p_ = 0; p_ < 4; ++p_) { const int pc_ = tid + 512 * p_; const int row_ = pc_ >> 5; const int s_ = dir ? 63 - row_ : row_; const int so_ = s_ * QS + (pc_ & 31) * 16; \
            *(LAS v4u*)(L + so_) = rq[0][p_]; *(LAS v4u*)(L + IMG + so_) = rq[1][p_]; } \
        { const unsigned vw_[4] = {rv.x, rv.y, rv.z, rv.w}; \
          _Pragma("unroll") for (int jj_ = 0; jj_ < 4; ++jj_) { const unsigned pw_ = pk2(bflo(vw_[jj_]) * kdec, bfhi(vw_[jj_]) * kdec); \
              *(LAS unsigned short*)(L + O_VT + (vb) * VTB + (vcc * 8 + 2 * jj_) * PS + vs * 2) = (unsigned short)(pw_ & 0xffffu); \
              *(LAS unsigned short*)(L + O_VT + (vb) * VTB + (vcc * 8 + 2 * jj_ + 1) * PS + vs * 2) = (unsigned short)(pw_ >> 16); } } } while (0)
        __syncthreads();
        { const unsigned zu_ = __builtin_bit_cast(unsigned, zf_); for (int u = tid; u < IMG / 16; u += NWAVES * 64) *(LAS v4u*)(L + O_ST + u * 16) = (v4u){zu_, zu_, zu_, zu_}; }
        R3_LOAD(0);
        R3_STAGE(0);
        R3_LOAD(1);
        MX_BAR();
        for (int c = 0; c < NCH; ++c) {
            const int vb = c & 1;
            LAS unsigned char* const Vc = L + O_VT + vb * VTB;
            const int rlo = R3_ROWLO(c);
            const bool do_out = ctx_out || c >= NCTX;
            if (c > 0) {
#pragma unroll
                for (int td = 0; td < 2; ++td)
#pragma unroll
                    for (int te = 0; te < 4; ++te) { const int d0 = 16 * (2 * w + td); const f32x4 s = accS[td][te];
                        v2u sw; sw.x = pk2(s[0], s[1]); sw.y = pk2(s[2], s[3]);
                        *(LAS v2u*)(L + O_ST + (16 * te + i) * QS + (d0 + 4 * g) * 2) = sw; }
            }
            mx_bf16x8 aq[KS];
            if (do_out) {
#pragma unroll
                for (int ks = 0; ks < KS; ++ks) aq[ks] = frag_row(L, QS, nq0, 32 * ks, lane);
                f32x4 pt0 = ZERO4, pt1 = ZERO4;
#pragma unroll
                for (int kb = 0; kb < KS; kb += 4) {
                    mx_bf16x8 kf[2][4];
#pragma unroll
                    for (int ks = 0; ks < 4; ++ks) { kf[0][ks] = frag_row(L + IMG, QS, 32 * cg, 32 * (kb + ks), lane); kf[1][ks] = frag_row(L + IMG, QS, 32 * cg + 16, 32 * (kb + ks), lane); }
                    __builtin_amdgcn_sched_barrier(0);
#pragma unroll
                    for (int ks = 0; ks < 4; ++ks) { pt0 = MX_MFMA(kf[0][ks], aq[kb + ks], pt0); pt1 = MX_MFMA(kf[1][ks], aq[kb + ks], pt1); }
                    __builtin_amdgcn_sched_barrier(0);
                }
                const int m0 = 32 * cg + 4 * g, m1 = m0 + 16, n = nq0 + i;
                v2u pw; pw.x = pk2((m0 <= n) ? pt0[0] : 0.f, (m0 + 1 <= n) ? pt0[1] : 0.f); pw.y = pk2((m0 + 2 <= n) ? pt0[2] : 0.f, (m0 + 3 <= n) ? pt0[3] : 0.f);
                *(LAS v2u*)(L + O_P + n * PS + m0 * 2) = pw;
                pw.x = pk2((m1 <= n) ? pt1[0] : 0.f, (m1 + 1 <= n) ? pt1[1] : 0.f); pw.y = pk2((m1 + 2 <= n) ? pt1[2] : 0.f, (m1 + 3 <= n) ? pt1[3] : 0.f);
                *(LAS v2u*)(L + O_P + n * PS + m1 * 2) = pw;
            }
            {
                mx_bf16x8 vt[4][2], ak[2][2];
#pragma unroll
                for (int te = 0; te < 4; ++te) { vt[te][0] = frag_row8(Vc, 16 * te, 0, lane); vt[te][1] = frag_row8(Vc, 16 * te, 32, lane); }
#pragma unroll
                for (int td = 0; td < 2; ++td) { ak[td][0] = frag_tr(L + IMG, QS, 0, 16 * (2 * w + td), lane); ak[td][1] = frag_tr(L + IMG, QS, 32, 16 * (2 * w + td), lane); }
                __builtin_amdgcn_sched_barrier(0);
#pragma unroll
                for (int td = 0; td < 2; ++td)
#pragma unroll
                    for (int te = 0; te < 4; ++te) accS[td][te] = MX_MFMA(ak[td][0], vt[te][0], accS[td][te] * cdec);
#pragma unroll
                for (int td = 0; td < 2; ++td)
#pragma unroll
                    for (int te = 0; te < 4; ++te) accS[td][te] = MX_MFMA(ak[td][1], vt[te][1], accS[td][te]);
            }
            MX_BAR();
            if (do_out) {
                mx_bf16x8 vo[2][2];
                const mx_bf16x8 bp0 = frag_row8(L + O_P, nq0, 0, lane), bp1 = frag_row8(L + O_P, nq0, 32, lane);
#pragma unroll
                for (int te = 0; te < 2; ++te) { vo[te][0] = frag_row8(Vc, 32 * cg + 16 * te, 0, lane); vo[te][1] = frag_row8(Vc, 32 * cg + 16 * te, 32, lane); }
                f32x4 o1a = ZERO4, o1b = ZERO4, o2a = ZERO4, o2b = ZERO4;
#pragma unroll
                for (int kb = 0; kb < KS; kb += 4) {
                    mx_bf16x8 st[2][4];
#pragma unroll
                    for (int ks = 0; ks < 4; ++ks) { st[0][ks] = frag_row(L + O_ST, QS, 32 * cg, 32 * (kb + ks), lane); st[1][ks] = frag_row(L + O_ST, QS, 32 * cg + 16, 32 * (kb + ks), lane); }
                    __builtin_amdgcn_sched_barrier(0);
                    if (kb == 0) { o1a = MX_MFMA(vo[0][0], bp0, o1a); o1b = MX_MFMA(vo[1][0], bp0, o1b); o1a = MX_MFMA(vo[0][1], bp1, o1a); o1b = MX_MFMA(vo[1][1], bp1, o1b); }
#pragma unroll
                    for (int ks = 0; ks < 4; ++ks) { o2a = MX_MFMA(st[0][ks], aq[kb + ks], o2a); o2b = MX_MFMA(st[1][ks], aq[kb + ks], o2b); }
                    __builtin_amdgcn_sched_barrier(0);
                }
                bf16* op = O + (size_t)(rlo + (dir ? 63 - (nq0 + i) : (nq0 + i))) * D + h * HD + eb * 64 + 32 * cg + 4 * g;
                const f32x4 ya = o1a * r1 + o2a * r2, yb = o1b * r1 + o2b * r2; v2u wa, wb; wa.x = pk2(ya[0], ya[1]); wa.y = pk2(ya[2], ya[3]); wb.x = pk2(yb[0], yb[1]); wb.y = pk2(yb[2], yb[3]);
                *(GAS v2u*)(op) = wa; *(GAS v2u*)(op + 16) = wb;
            }
            if (c + 1 < NCH) R3_STAGE(vb ^ 1);
            { const int cn = (c + 2 < NCH) ? c + 2 : NCH - 1; R3_LOAD(cn); }
            MX_BAR();
        }
#undef R3_ROWLO
#undef R3_LOAD
#undef R3_STAGE
    }
}
#ifndef MIX_MFMA_RET
#define MIX_MFMA_RET 1
#endif
#ifndef MIX_RET_V3
#define MIX_RET_V3 0
#endif
#ifndef MIX_HG_V2
#define MIX_HG_V2 1
#endif
#ifndef MIX_MFMA_HG
#define MIX_MFMA_HG 1
#endif
#ifndef REP_NORM
#define REP_NORM 1
#endif
#ifndef REP_GEMM_IN
#define REP_GEMM_IN 1
#endif
#ifndef REP_MIX_RET
#define REP_MIX_RET 1
#endif
#ifndef REP_MIX_HG
#define REP_MIX_HG 1
#endif
#ifndef REP_READ
#define REP_READ 1
#endif
#ifndef REP_GU
#define REP_GU 1
#endif
__global__ void __launch_bounds__(NWAVES * 64, 2) fwd_kernel(Args args_in) {
    const Args& args = args_in;
    extern __shared__ __attribute__((aligned(16))) unsigned char lds[];
    Frame F;
    F.lds = (LAS unsigned char*)lds;
    volatile LAS unsigned* MISC = (volatile LAS unsigned*)(F.lds + MISC_OFF);
    F.tid = threadIdx.x; F.lane = F.tid & 63; F.wave = __builtin_amdgcn_readfirstlane(F.tid >> 6);
    F.G = gridDim.x; { const int bx = blockIdx.x; F.vcu = (F.G % 8 == 0) ? (bx % 8) * (F.G / 8) + bx / 8 : bx; }
    unsigned char* ws = args.ws;
    F.ctl = (gu32*)(ws + WS_CTL);
    for (int u = F.tid; u < (LDS_BYTES - LDSCTL_OFF) / 4; u += NWAVES * 64) ((LAS unsigned*)(F.lds + LDSCTL_OFF))[u] = 0u;
    __syncthreads();
    if (F.lane == 0) *(volatile LAS unsigned*)(F.lds + TIDTAB_OFF + 4 * mk_hwkey()) = (unsigned)F.wave;
    XcdBarrier bar; bar.bar = (unsigned*)(F.ctl + CW_BAR); bar.x = 0; bar.st = nullptr;
    if (MK_N_LAUNCHES == 1) bar = xcd_barrier_post((unsigned*)(F.ctl + CW_BAR), MISC + 8);
    const int lo = args.ph_lo, hi = args.ph_hi;
#define IN(k) (lo <= (k) && (k) < hi)
#define SEAM(k) do { if (IN(k) && IN((k) + 1)) { XcdBarrier b_ = bar; asm volatile("" : "+s"(b_.bar), "+s"(b_.x));     \
        xcd_barrier(b_); if (REP_BAR > 1) xcd_barrier(b_); } } while (0)
    if (IN(0)) { p0_prologue(args, F); }
    SEAM(0);
    if (IN(1)) { p1_modreduce(args, F); }
    SEAM(1);

    for (int layer = 0; layer < DEPTH; ++layer) {
        asm volatile("" : "+s"(ws));
        const Args* kap = (const Args*)__builtin_amdgcn_kernarg_segment_ptr(); asm volatile("" : "+s"(kap));
        const Args& args = *kap;
        const float* MOD = (const float*)(ws + WS_MOD);
        const float* TAB = (const float*)(ws + WS_TAB);
        bf16* X = (bf16*)(ws + WS_X);
        bf16* HN = (bf16*)(ws + WS_HN);
        bf16* ACT = (bf16*)(ws + WS_ACT);
        const int pb = 2 + 8 * layer;
        const bool last = (layer == DEPTH - 1), hg = (layer & 1) != 0;
        const int j = layer >> 1;
        const int Mr = last ? ML : M;
        const bool tc = TAIL_CONVERT != 0 && !last && F.G == 256 && MK_N_LAUNCHES == 1;
        const int tc_slot = ((int)blockIdx.x & 7) * 32 + ((int)blockIdx.x >> 3);
        const int tc_rem1 = (hg ? (M / 256) * 40 : (M / 256) * 32) % 256, tc_idle1 = 256 - tc_rem1;
        const float* modl = MOD + (size_t)layer * 5 * MOD_LD;
        unsigned char* wb = ws + WS_W + (size_t)layer * W_LAYER;
        if (IN(pb + 0)) NORM_FN(args, F, args.in[6] + (size_t)layer * D, modl, 0, D, M, layer > 0 ? (modl - 5 * MOD_LD) + 4 * MOD_LD + 5 * D : nullptr);
        SEAM(pb + 0);
        if (!hg) {
            if (IN(pb + 1)) {
                pg8::Gemm g{HN, (const bf16*)(wb + W_IN), M, 4 * D, D, D, D}; pg8::StaticOrder S; S.init(M, 4 * D, F.G, (int)blockIdx.x);
                pg8::EpiRetIn E{ACT, ACT_STRIDE, TAB + TAB_COS / 4, TAB + TAB_SIN / 4, NLP};
                for (int rep = 0; rep < REP_GEMM_IN; ++rep) pg8::gemm_phase<pg8::EpiRetIn, pg8::StaticOrder, GEMM_ALIGN, GEMM_SP2>(F.lds, g, S, E);
                if (tc && tc_slot >= tc_rem1) tail_convert(args, F, layer + 1, 1, tc_slot - tc_rem1, tc_idle1, tc_idle1);
            }
            SEAM(pb + 1);
            if (IN(pb + 2)) for (int rep = 0; rep < REP_MIX_RET; ++rep) { if (MIX_RET_V3) mixer_ret3(args, F, j, !last); else if (MIX_MFMA_RET) mixer_mfma<false>(args, F, j, !last); else mixer_phase<false>(args, F, j, !last); if (MXV_RET) mixer_mfma<false, MXV_RET>(args, F, j, !last); }
            SEAM(pb + 2);
            if (IN(pb + 3)) for (int rep = 0; rep < REP_READ; ++rep) { if (NORM_PIPE && F.G == 256) readout_phase2<false>(args, F, nullptr, Mr); else readout_phase<false>(args, F, nullptr, Mr); }
            SEAM(pb + 3);
        } else {
            if (IN(pb + 1)) {
                pg8::Gemm g{HN, (const bf16*)(wb + W_IN), M, 5 * D, D, D, D}; pg8::StaticOrder S; S.init(M, 5 * D, F.G, (int)blockIdx.x);
                pg8::EpiHgIn E{ACT, ACT_STRIDE, TAB + TAB_LB / 4 + (size_t)j * D};
                for (int rep = 0; rep < REP_GEMM_IN; ++rep) pg8::gemm_phase<pg8::EpiHgIn, pg8::StaticOrder, GEMM_ALIGN, GEMM_SP2>(F.lds, g, S, E);
                if (tc && tc_slot >= tc_rem1) tail_convert(args, F, layer + 1, 1, tc_slot - tc_rem1, tc_idle1, tc_idle1);
            }
            SEAM(pb + 1);
            if (IN(pb + 2)) for (int rep = 0; rep < REP_MIX_HG; ++rep) { if (MIX_HG_V2) mixer_hg2(args, F, !last); else if (MIX_MFMA_HG) mixer_mfma<true>(args, F, j, !last); else mixer_phase<true>(args, F, j, !last); if (MXV_HG) mixer_mfma<true, MXV_HG>(args, F, j, !last); }
            SEAM(pb + 2);
            if (IN(pb + 3)) for (int rep = 0; rep < REP_READ; ++rep) { if (NORM_PIPE && F.G == 256) readout_phase2<true>(args, F, args.in[13] + (size_t)j * D, Mr); else readout_phase<true>(args, F, args.in[13] + (size_t)j * D, Mr); }
            SEAM(pb + 3);
        }
        if (IN(pb + 4)) {
            pg8::Gemm g{HN, (const bf16*)(wb + W_OUT), ML, D, D, D, D}; pg8::StaticOrder S; S.init(ML, D, F.G, (int)blockIdx.x);
            pg8::EpiResid E{X, modl + 2 * D, MOD_LD, NLP};
            pg8::gemm_phase<pg8::EpiResid, pg8::StaticOrder, RESID_ALIGN, GEMM_SP2>(F.lds, g, S, E);
            if (!last) {
                pg8::Gemm g2{HN, (const bf16*)(wb + W_OUT), M, D, D / 4, D, D}; pg8::SplitKOrder S2{F.G, (int)blockIdx.x, NLP, D / 4};
                pg8::EpiSlab E2{(float*)(ws + WS_SLAB), NLP, D / 4, (size_t)MC * D};
                pg8::gemm_phase<pg8::EpiSlab, pg8::SplitKOrder, true, true>(F.lds, g2, S2, E2);
                if (tc && (int)blockIdx.x >= 128) tail_convert(args, F, layer + 1, 2, (int)blockIdx.x - 128, 128, tc_idle1);
            }
        }
        SEAM(pb + 4);
        if (IN(pb + 5)) NORM_FN(args, F, args.in[7] + (size_t)layer * D, modl, 3 * D, 4 * D, Mr, last ? nullptr : modl + 4 * MOD_LD + 2 * D);
        SEAM(pb + 5);
        if (IN(pb + 6)) {
            pg8::Gemm g{HN, (const bf16*)(wb + W_GU), Mr, 2 * FF, D, D, D}; pg8::StaticOrder S; S.init(Mr, 2 * FF, F.G, (int)blockIdx.x, GU_WGM);
            if (KPROBE_GU) { pg8::TwiceOrder S2; S2.init(Mr, 2 * FF, F.G, (int)blockIdx.x); pg8::EpiGateUp E{ACT, FF, 0.5f}; pg8::gemm_phase<pg8::EpiGateUp, pg8::TwiceOrder, true, true>(F.lds, g, S2, E); }
            else { pg8::EpiGateUp E{ACT, FF, 1.0f};
            for (int rep = 0; rep < REP_GU; ++rep) pg8::gemm_phase<pg8::EpiGateUp, pg8::StaticOrder, GEMM_ALIGN, GEMM_SP2>(F.lds, g, S, E); }
            if (tc && tc_slot >= 176) tail_convert(args, F, layer + 1, 3, tc_slot - 176, 80, tc_idle1);
        }
        SEAM(pb + 6);
        if (IN(pb + 7)) {
            pg8::Gemm g{ACT, (const bf16*)(wb + W_DN), ML, D, FF, FF, FF}; pg8::StaticOrder S; S.init(ML, D, F.G, (int)blockIdx.x);
            pg8::EpiResid E{X, modl + 5 * D, MOD_LD, NLP};
            pg8::gemm_phase<pg8::EpiResid, pg8::StaticOrder, RESID_ALIGN, GEMM_SP2>(F.lds, g, S, E);
            if (!last) {
                pg8::Gemm g2{ACT, (const bf16*)(wb + W_DN), M, D, FF / 4, FF, FF}; pg8::SplitKOrder S2{F.G, (int)blockIdx.x, NLP, FF / 4};
                pg8::EpiSlab E2{(float*)(ws + WS_SLAB), NLP, FF / 4, (size_t)MC * D};
                pg8::gemm_phase<pg8::EpiSlab, pg8::SplitKOrder, true, true>(F.lds, g2, S2, E2);
                if (tc && (int)blockIdx.x >= 128) tail_convert(args, F, layer + 1, 4, (int)blockIdx.x - 128, 128, tc_idle1);
            }
        }
        SEAM(pb + 7);
    }
    if (IN(N_PHASES - 1)) { if (NORM_PIPE && F.G == 256) final_norm_phase2(args, F); else final_norm_phase(args, F); }
#undef IN
#undef SEAM
}

extern "C" void kernel_launch(void* const* d_in, const int* in_sizes, int n_in, void* d_out, int out_size, void* d_ws, size_t ws_size, hipStream_t stream) {
    static int grid = 0;
    if (grid == 0) {
        if (n_in != 18 || in_sizes[0] != ML * D || out_size != ML * D || ws_size < WS_END) { fprintf(stderr, "kernel_launch: unexpected shapes (n_in %d, in0 %d, out %d, ws %zu < %zu); nothing launched\n", n_in, n_in > 0 ? in_sizes[0] : -1, out_size, ws_size, (size_t)WS_END); grid = -1; return; }
        int dev = 0, cus = 0, per_cu = 0;
        if (hipGetDevice(&dev) != hipSuccess || hipDeviceGetAttribute(&cus, hipDeviceAttributeMultiprocessorCount, dev) != hipSuccess) { grid = -1; return; }
        if (hipFuncSetAttribute((const void*)fwd_kernel, hipFuncAttributeMaxDynamicSharedMemorySize, LDS_BYTES) != hipSuccess) { fprintf(stderr, "kernel_launch: hipFuncSetAttribute failed\n"); grid = -1; return; }
        if (hipOccupancyMaxActiveBlocksPerMultiprocessor(&per_cu, (const void*)fwd_kernel, NWAVES * 64, LDS_BYTES) != hipSuccess || per_cu < 1) { fprintf(stderr, "kernel_launch: occupancy query says %d blocks per CU\n", per_cu); (void)hipGetLastError(); grid = -1; return; }
        grid = cus;
    }
    if (grid < 0) return;
    if (hipMemsetAsync((char*)d_ws, 0, ZERO_BYTES, stream) != hipSuccess) return;
    Args a{};
    for (int i = 0; i < 18; ++i) a.in[i] = (const float*)d_in[i];
    a.out = (float*)d_out; a.ws = (unsigned char*)d_ws;
    if (MK_N_LAUNCHES == 1) {
        a.ph_lo = 0; a.ph_hi = N_PHASES;
        hipLaunchKernelGGL(fwd_kernel, dim3(grid), dim3(NWAVES * 64), LDS_BYTES, stream, a);
    } else {
        for (int p = 0; p < N_PHASES; ++p) { a.ph_lo = p; a.ph_hi = p + 1; hipLaunchKernelGGL(fwd_kernel, dim3(grid), dim3(NWAVES * 64), LDS_BYTES, stream, a); }
    }
}
```

```cpp
#include <hip/hip_runtime.h>
#include <cstdio>
#include <cstdint>
#ifndef REP_EPI
#define REP_EPI 1
#endif
#ifndef REP_PRO
#define REP_PRO 1
#endif
#ifndef REP_BAR
#define REP_BAR 1
#endif
#ifndef RESID_ATOMIC
#define RESID_ATOMIC 1
#endif
#ifndef REP_RESID
#define REP_RESID 1
#endif
#ifndef MXP_STG
#define MXP_STG 1
#endif
#ifndef MXP_S1
#define MXP_S1 1
#endif
#ifndef MXP_S2
#define MXP_S2 1
#endif
#ifndef MX_PF_HG
#define MX_PF_HG 1
#endif
#ifndef MX_PF_RET
#define MX_PF_RET 1
#endif
#ifndef MXP_SLEEP
#define MXP_SLEEP 0
#endif
#ifndef MXP_BAR
#define MXP_BAR 1
#endif
#ifndef MXV_RET
#define MXV_RET 0
#endif
#ifndef MXV_HG
#define MXV_HG 0
#endif
#ifndef REP_BIAS
#define REP_BIAS 1
#endif
#ifndef KPROBE_GU
#define KPROBE_GU 0
#endif
#ifndef STEAL_TICKS_UNIT
#define STEAL_TICKS_UNIT 4000u
#endif
#ifndef STEAL_TICKS_OUT
#define STEAL_TICKS_OUT 900u
#endif
#ifndef STEAL_TICKS_DOWN
#define STEAL_TICKS_DOWN 2800u
#endif
#ifndef STEAL_BATCH
#define STEAL_BATCH 4
#endif
#ifndef RESID_ALIGN
#define RESID_ALIGN false
#endif
#ifndef GEMM_ALIGN
#define GEMM_ALIGN true
#endif
#ifndef PG8_WGM
#define PG8_WGM 4
#endif
#ifndef GEMM_SP2
#define GEMM_SP2 true
#endif
#ifndef PG8_ROUND_MAJOR
#define PG8_ROUND_MAJOR 1
#endif
#ifndef PRO_NT
#define PRO_NT 1
#endif
#ifndef WT_STORES
#define WT_STORES 0
#endif
#ifndef GU_WGM
#define GU_WGM 8
#endif
#ifndef EW_NT
#define EW_NT 1
#endif
#ifndef EPI_NT
#define EPI_NT 0
#endif
#ifndef RESID_NT
#define RESID_NT 0
#endif
#ifndef ST16_GLOBAL
#define ST16_GLOBAL 1
#endif
#ifndef TAIL_CONVERT
#define TAIL_CONVERT 1
#endif
#ifndef WT_NT_ST
#define WT_NT_ST 1
#endif
#ifndef EPI_DRAIN_OVERLAP
#define EPI_DRAIN_OVERLAP 1
#endif
#ifndef XRES_F16
#define XRES_F16 1
#endif
#ifndef NORM_PIPE
#define NORM_PIPE 1
#endif

#define TIDTAB_OFF 132416
#define MK_LAS __attribute__((address_space(3)))
__device__ __forceinline__ unsigned mk_hwkey() { unsigned hw; asm volatile("s_getreg_b32 %0, hwreg(HW_REG_HW_ID, 0, 6)" : "=s"(hw)); return hw; }
__device__ __forceinline__ int mk_wave() {
    extern __shared__ __attribute__((aligned(16))) unsigned char lds[];
    const unsigned hw = mk_hwkey();
    return __builtin_amdgcn_readfirstlane((int)*(volatile MK_LAS unsigned*)((MK_LAS unsigned char*)lds + TIDTAB_OFF + 4 * hw));
}
__device__ __forceinline__ int mk_lane() { int l; asm volatile("v_mbcnt_lo_u32_b32 %0, -1, 0\n\tv_mbcnt_hi_u32_b32 %0, -1, %0" : "=v"(l)); return l; }
__device__ __forceinline__ int mk_tid() { return mk_wave() * 64 + mk_lane(); }
namespace pg8 {
#define PG8_LAS __attribute__((address_space(3)))
typedef unsigned short bf16_t;
typedef short bf16x8 __attribute__((ext_vector_type(8)));
typedef float f32x4 __attribute__((ext_vector_type(4)));
typedef unsigned u32x4 __attribute__((ext_vector_type(4)));
constexpr int BM = 256, BK = 64, HALF = 128, HTB = HALF * BK * 2  , STAGE_BYTES = 8 * HTB, NXCD = 8, WGM = PG8_WGM;

__host__ __device__ __forceinline__ int lds_byte(int r, int c) { const int st = (r >> 4) * 2 + (c >> 5), rr = r & 15, cc = c & 31, ob = rr * 64 + cc * 2; return st * 1024 + (ob ^ (((ob >> 9) & 1) << 5)); }
__host__ __device__ __forceinline__ void stage_rc(int b, int& R, int& C) { const int st = b / 1024, sb = b % 1024, swz = sb ^ (((sb >> 9) & 1) << 5); R = (st >> 1) * 16 + swz / 64; C = (st & 1) * 32 + (swz % 64) / 2; }
__host__ __device__ __forceinline__ int perm32(int rho) { const int n = rho >> 4, i = rho & 15; return 8 * (i >> 2) + 4 * n + (i & 3); }

struct Unit { int pm, pn, k0; };
struct Gemm { const bf16_t* A; const bf16_t* Bt; int M, N, K, lda, ldb; };

struct StaticOrder {
    static constexpr bool KTWICE = false;
    int nM, nN, nwg, G, c, wgm;
    __host__ __device__ void init(int M, int N, int G_, int c_, int wgm_ = WGM) { nM = M / BM; nN = N / BM; nwg = nM * nN; G = G_; c = c_; wgm = wgm_; }
    __host__ __device__ bool next(int i, Unit& u) const {
        const long L = (long)i * G + c; if (!(PG8_ROUND_MAJOR && G % NXCD == 0) && L >= nwg) return false; if ((long)i * G >= nwg) return false;
        int wgid = (int)L;
        if (PG8_ROUND_MAJOR && G % NXCD == 0) { const int per = G / NXCD; wgid = ((i * NXCD) + (c % NXCD)) * per + (c / NXCD); if (wgid >= nwg) return false; }
        else { const int q = nwg / NXCD, r = nwg % NXCD, xcd = wgid % NXCD, off = wgid / NXCD; wgid = (xcd < r ? xcd * (q + 1) : r * (q + 1) + (xcd - r) * q) + off; }
        const int nig = wgm * nN, gid = wgid / nig, fm = gid * wgm, gsz = (nM - fm) < wgm ? (nM - fm) : wgm;
        u.pm = fm + ((wgid % nig) % gsz); u.pn = (wgid % nig) / gsz; u.k0 = 0; return true;
    }
    __device__ __forceinline__ void a_ready(const Unit&) const {}
    __device__ __forceinline__ void done(const Unit&) const {}
};
struct TwiceOrder : StaticOrder {
    static constexpr bool KTWICE = true;
    __host__ __device__ bool next(int i, Unit& u) const { return StaticOrder::next(i >> 1, u); }
};
struct SplitKOrder {
    static constexpr bool KTWICE = false;
    int G, c, pm0, ksub;
    __device__ __forceinline__ bool next(int i, Unit& u) const { const int s = i * G + c; if (s >= 128) return false; const int t = s >> 2; u.pm = pm0 + (t & 3); u.pn = t >> 2; u.k0 = (s & 3) * ksub; return true; }
    __device__ __forceinline__ void a_ready(const Unit&) const {}
    __device__ __forceinline__ void done(const Unit&) const {}
};
__device__ __forceinline__ unsigned cvt_pk_bf16(float lo, float hi) { unsigned r; asm volatile("v_cvt_pk_bf16_f32 %0, %1, %2" : "=v"(r) : "v"(lo), "v"(hi)); return r; }
#define PG8_GAS __attribute__((address_space(1)))
#if ST16_GLOBAL
#define ST16_AS PG8_GAS
#else
#define ST16_AS
#endif
__device__ __forceinline__ float fast_sigmoid(float x) { return __builtin_amdgcn_rcpf(1.0f + __expf(-x)); }
__device__ __forceinline__ f32x4 sigm4(f32x4 v) { const f32x4 t = v * -1.4426950408889634f; f32x4 e = {__builtin_amdgcn_exp2f(t[0]), __builtin_amdgcn_exp2f(t[1]), __builtin_amdgcn_exp2f(t[2]), __builtin_amdgcn_exp2f(t[3])};
    e = e + 1.0f; return (f32x4){__builtin_amdgcn_rcpf(e[0]), __builtin_amdgcn_rcpf(e[1]), __builtin_amdgcn_rcpf(e[2]), __builtin_amdgcn_rcpf(e[3])}; }
__device__ __forceinline__ f32x4 silu4(f32x4 v) { return v * sigm4(v); }
template <typename T> __device__ __forceinline__ void st16(T* base, unsigned elem_off, u32x4 v) {
#if WT_STORES
    const __amdgpu_buffer_rsrc_t r = __builtin_amdgcn_make_buffer_rsrc(base, 0, 0x7fffffff, 0x00020000);
    __builtin_amdgcn_raw_buffer_store_b128(v, r, (int)(elem_off * sizeof(T)), 0, 16);
#elif EPI_NT
    __builtin_nontemporal_store(v, (u32x4*)(base + elem_off));
#else
    *(ST16_AS u32x4*)((ST16_AS char*)base + (size_t)(elem_off * (unsigned)sizeof(T))) = v;
#endif
}
__device__ __forceinline__ u32x4 pack8(f32x4 v0, f32x4 v1) { u32x4 w; w.x = cvt_pk_bf16(v0[0], v0[1]); w.y = cvt_pk_bf16(v0[2], v0[3]); w.z = cvt_pk_bf16(v1[0], v1[1]); w.w = cvt_pk_bf16(v1[2], v1[3]); return w; }

struct EpiRetIn {
    static constexpr bool PERM = true, AFTER_DRAIN = false, REP2 = false;
    static constexpr bool DRAIN_OK = true;
    static constexpr int NVM = 16;
    bf16_t* act; size_t tstride; const float* cosT; const float* sinT; int n_lat_panels;
    __device__ __forceinline__ void store_rows(const f32x4& a0, const f32x4& a1, const f32x4& b0, const f32x4& b1, int type, bf16_t* base, size_t off) const {
        f32x4 x0 = a0, x1 = a1, y0 = b0, y1 = b1;
        if (type == 1) { x0 = x0 * 0.0625f; x1 = x1 * 0.0625f; y0 = y0 * 0.0625f; y1 = y1 * 0.0625f; }
        if (type == 3) { x0 = silu4(x0); x1 = silu4(x1); y0 = silu4(y0); y1 = silu4(y1); }
        st16(base, off, pack8(x0, x1));
        st16(base, off + HALF, pack8(y0, y1));
    }
    __device__ __forceinline__ void operator()(const f32x4 (&acc)[2][2][4][2], const Unit& u, int wr, int wc, int fr_in, int fq_in) const {
        int fr = fr_in, fq = fq_in; asm volatile("" : "+v"(fr), "+v"(fq));
        const int type = u.pn >> 3, head = u.pn & 7;
        bf16_t* base = act + (size_t)type * tstride; const size_t coff = head * 256 + wc * 32 + 8 * fq;
        const int row0 = u.pm * BM + wr * 64 + fr;
        const bool rope = (type < 2) && (u.pm < n_lat_panels);
        const int fidx = (wc & 1) * 32 + 8 * fq;
        if (!rope) {
#pragma unroll
            for (int ai = 0; ai < 2; ++ai)
#pragma unroll
                for (int m = 0; m < 4; ++m) store_rows(acc[ai][0][m][0], acc[ai][0][m][1], acc[ai][1][m][0], acc[ai][1][m][1], type, base, (size_t)(row0 + ai * HALF + m * 16) * 2048 + coff);
        } else if (wc < 2) {
#pragma unroll
            for (int ai = 0; ai < 2; ++ai) {
                const int pos = (4 * u.pm + 2 * ai + wr) & 63;
                const f32x4 c0 = *(const PG8_GAS f32x4*)(cosT + pos * 64 + fidx), c1 = *(const PG8_GAS f32x4*)(cosT + pos * 64 + fidx + 4), s0 = *(const PG8_GAS f32x4*)(sinT + pos * 64 + fidx), s1 = *(const PG8_GAS f32x4*)(sinT + pos * 64 + fidx + 4);
#pragma unroll
                for (int m = 0; m < 4; ++m) { const f32x4 a0 = acc[ai][0][m][0], a1 = acc[ai][0][m][1], b0 = acc[ai][1][m][0], b1 = acc[ai][1][m][1];
                    store_rows(a0 * c0 - b0 * s0, a1 * c1 - b1 * s1, a0 * s0 + b0 * c0, a1 * s1 + b1 * c1, type, base, (size_t)(row0 + ai * HALF + m * 16) * 2048 + coff); }
            }
        } else {
#pragma unroll
            for (int m = 0; m < 4; ++m) {
                const int pos = 16 * m + fr;
                const f32x4 c0 = *(const PG8_GAS f32x4*)(cosT + pos * 64 + fidx), c1 = *(const PG8_GAS f32x4*)(cosT + pos * 64 + fidx + 4), s0 = *(const PG8_GAS f32x4*)(sinT + pos * 64 + fidx), s1 = *(const PG8_GAS f32x4*)(sinT + pos * 64 + fidx + 4);
#pragma unroll
                for (int ai = 0; ai < 2; ++ai) { const f32x4 a0 = acc[ai][0][m][0], a1 = acc[ai][0][m][1], b0 = acc[ai][1][m][0], b1 = acc[ai][1][m][1];
                    store_rows(a0 * c0 - b0 * s0, a1 * c1 - b1 * s1, a0 * s0 + b0 * c0, a1 * s1 + b1 * c1, type, base, (size_t)(row0 + ai * HALF + m * 16) * 2048 + coff); }
            }
        }
    }
};

struct EpiHgIn {
    static constexpr bool PERM = true, AFTER_DRAIN = false, REP2 = false;
    static constexpr bool DRAIN_OK = true;
    static constexpr int NVM = 16;
    bf16_t* act; size_t tstride; const float* lb;
    __device__ __forceinline__ void operator()(const f32x4 (&acc)[2][2][4][2], const Unit& u, int wr, int wc, int fr_in, int fq_in) const {
        int fr = fr_in, fq = fq_in; asm volatile("" : "+v"(fr), "+v"(fq));
        const int type = u.pn >> 3, cb = (u.pn & 7) * 256 + wc * 32 + 8 * fq;
        const int row0 = u.pm * BM + wr * 64 + fr;
        const int slot = (type == 0) ? 0 : (type == 1) ? 1 : (type == 2) ? 3 : (type == 3) ? 5 : 6;
        bf16_t* base = act + (size_t)slot * tstride;
        f32x4 lbv[2][2];
#pragma unroll
        for (int bj = 0; bj < 2; ++bj)
#pragma unroll
            for (int n = 0; n < 2; ++n) lbv[bj][n] = (type == 1 || type == 2) ? *(const PG8_GAS f32x4*)(lb + cb + bj * HALF + 4 * n) : (f32x4){0.f, 0.f, 0.f, 0.f};
#pragma unroll
        for (int ai = 0; ai < 2; ++ai)
#pragma unroll
            for (int m = 0; m < 4; ++m) {
                const int r = row0 + ai * HALF + m * 16;
                const size_t roff = (size_t)r * 2048 + cb;
#pragma unroll
                for (int bj = 0; bj < 2; ++bj) {
                    f32x4 v0 = acc[ai][bj][m][0], v1 = acc[ai][bj][m][1];
                    if (type == 0) { v0 = silu4(v0); v1 = silu4(v1); }
                    if (type == 4) { v0 = sigm4(v0); v1 = sigm4(v1); }
                    if (type == 1 || type == 2) {
                        f32x4 k0, k1;
#pragma unroll
                        for (int j = 0; j < 4; ++j) {
                            { const float z = fminf(fmaxf(v0[j], -80.f), 80.f), e = __expf(-z), sg = __builtin_amdgcn_rcpf(1.0f + e), l = lbv[bj][0][j];
                              v0[j] = __logf(l + (1.0f - l) * sg); k0[j] = (1.0f - l) * (e * sg); }
                            { const float z = fminf(fmaxf(v1[j], -80.f), 80.f), e = __expf(-z), sg = __builtin_amdgcn_rcpf(1.0f + e), l = lbv[bj][1][j];
                              v1[j] = __logf(l + (1.0f - l) * sg); k1[j] = (1.0f - l) * (e * sg); }
                        }
                        st16(base + tstride, roff + bj * HALF, pack8(k0, k1));
                    }
                    st16(base, roff + bj * HALF, pack8(v0, v1));
                }
            }
    }
};

typedef _Float16 x_h2 __attribute__((ext_vector_type(2)));
typedef float x_f2 __attribute__((ext_vector_type(2)));
__device__ __forceinline__ float x_lo(unsigned w) { if (XRES_F16) { const x_h2 h = __builtin_bit_cast(x_h2, w); return (float)h[0]; } return __builtin_bit_cast(float, w << 16); }
__device__ __forceinline__ float x_hi(unsigned w) { if (XRES_F16) { const x_h2 h = __builtin_bit_cast(x_h2, w); return (float)h[1]; } return __builtin_bit_cast(float, w & 0xffff0000u); }
__device__ __forceinline__ unsigned x_pk(float lo, float hi) { if (XRES_F16) { const x_f2 v = {lo, hi}; const x_h2 h = __builtin_convertvector(v, x_h2); return __builtin_bit_cast(unsigned, h); } return cvt_pk_bf16(lo, hi); }
__device__ __forceinline__ u32x4 x_pack8(f32x4 v0, f32x4 v1) { u32x4 w; w.x = x_pk(v0[0], v0[1]); w.y = x_pk(v0[2], v0[3]); w.z = x_pk(v1[0], v1[1]); w.w = x_pk(v1[2], v1[3]); return w; }
struct EpiResid {
    static constexpr bool PERM = true, AFTER_DRAIN = false, REP2 = false;
    static constexpr bool DRAIN_OK = true;
    static constexpr int NVM = 36;
    bf16_t* X; const float* gate; int gstride; int n_lat_panels;
    __device__ __forceinline__ void operator()(const f32x4 (&acc)[2][2][4][2], const Unit& u, int wr, int wc, int fr, int fq) const {
        const int row0 = u.pm * BM + wr * 64 + fr, col0 = u.pn * BM + wc * 32 + 8 * fq;
        const int b = (u.pm < n_lat_panels) ? (u.pm >> 4) : 4;
        const float* g = gate + (size_t)b * gstride + col0;
        bf16_t* xb = X + (size_t)row0 * 2048 + col0;
        f32x4 gv[2][2];
#pragma unroll
        for (int bj = 0; bj < 2; ++bj)
#pragma unroll
            for (int n = 0; n < 2; ++n) gv[bj][n] = *(const f32x4*)(g + bj * HALF + 4 * n);
        u32x4 xa[2][2], xc[2][2];
#define ER_LOAD(dst, ai, mp) do { _Pragma("unroll") for (int mm = 0; mm < 2; ++mm) _Pragma("unroll") for (int bj = 0; bj < 2; ++bj) \
            dst[mm][bj] = *(const u32x4*)(xb + (size_t)((ai) * HALF + (2 * (mp) + mm) * 16) * 2048 + bj * HALF); } while (0)
#define ER_STORE(src, ai, mp) do { _Pragma("unroll") for (int mm = 0; mm < 2; ++mm) _Pragma("unroll") for (int bj = 0; bj < 2; ++bj) { const u32x4 w_ = src[mm][bj]; \
            const f32x4 lo_ = (f32x4){x_lo(w_.x), x_hi(w_.x), x_lo(w_.y), x_hi(w_.y)} + gv[bj][0] * acc[ai][bj][2 * (mp) + mm][0]; \
            const f32x4 hi_ = (f32x4){x_lo(w_.z), x_hi(w_.z), x_lo(w_.w), x_hi(w_.w)} + gv[bj][1] * acc[ai][bj][2 * (mp) + mm][1]; \
            *(u32x4*)(xb + (size_t)((ai) * HALF + (2 * (mp) + mm) * 16) * 2048 + bj * HALF) = x_pack8(lo_, hi_); } } while (0)
        ER_LOAD(xa, 0, 0); ER_LOAD(xc, 0, 1);
        ER_STORE(xa, 0, 0); ER_LOAD(xa, 1, 0);
        ER_STORE(xc, 0, 1); ER_LOAD(xc, 1, 1);
        ER_STORE(xa, 1, 0); ER_STORE(xc, 1, 1);
#undef ER_LOAD
#undef ER_STORE
    }
};

struct EpiGateUp {
    static constexpr bool PERM = true, AFTER_DRAIN = false, REP2 = true;
    static constexpr bool DRAIN_OK = true;
    static constexpr int NVM = 8;
    bf16_t* H; int ldh; float pre;
    __device__ __forceinline__ void operator()(const f32x4 (&acc)[2][2][4][2], const Unit& u, int wr, int wc, int fr, int fq) const {
        const int row0 = u.pm * BM + wr * 64 + fr, col0 = u.pn * HALF + wc * 32 + 8 * fq;
#pragma unroll
        for (int ai = 0; ai < 2; ++ai)
#pragma unroll
            for (int m = 0; m < 4; ++m) {
                const f32x4 h0 = silu4(acc[ai][0][m][0] * pre) * (acc[ai][1][m][0] * pre), h1 = silu4(acc[ai][0][m][1] * pre) * (acc[ai][1][m][1] * pre);
                st16(H, (size_t)(row0 + ai * HALF + m * 16) * ldh + col0, pack8(h0, h1));
            }
    }
};


struct EpiSlab {
    static constexpr bool PERM = false, AFTER_DRAIN = false, REP2 = false;
    static constexpr bool DRAIN_OK = true;
    static constexpr int NVM = 32;
    float* slab; int pm0, ksub; size_t kstride;
    __device__ __forceinline__ void operator()(const f32x4 (&acc)[2][2][4][2], const Unit& u, int wr, int wc, int fr, int fq) const {
        float* base = slab + (size_t)(u.k0 / ksub) * kstride + (size_t)((u.pm - pm0) * BM + wr * 64 + fr) * 2048 + u.pn * BM + wc * 32 + 4 * fq;
#pragma unroll
        for (int ai = 0; ai < 2; ++ai)
#pragma unroll
            for (int m = 0; m < 4; ++m) { float* rowp = base + (size_t)(ai * HALF + m * 16) * 2048;
#pragma unroll
                for (int bj = 0; bj < 2; ++bj)
#pragma unroll
                    for (int n = 0; n < 2; ++n) *(PG8_GAS f32x4*)(rowp + bj * HALF + n * 16) = acc[ai][bj][m][n]; }
    }
};
template <class Epi, class Sched, bool ALIGN_EPI = false, bool SP2 = false>
__device__ __forceinline__ void gemm_phase(PG8_LAS unsigned char* lds, const Gemm g, const Sched& S, const Epi& E) {
    int tid_ = mk_tid(); asm volatile("" : "+v"(tid_));
    const int tid = tid_, wid = __builtin_amdgcn_readfirstlane(tid >> 6), lane = tid & 63, wr = wid >> 2, wc = wid & 3, fr = lane & 15, fq = lane >> 4;
    const int K = g.K, nt = K / BK;
    unsigned voffA[2], voffB[2];
#pragma unroll
    for (int i = 0; i < 2; ++i) { int R, C; stage_rc(tid * 16 + i * 8192, R, C); const int Rb = Epi::PERM ? ((R & ~31) + perm32(R & 31)) : R;
        voffA[i] = (unsigned)(R * g.lda + C) * 2u; voffB[i] = (unsigned)(Rb * g.ldb + C) * 2u; }
    const size_t kstep = (size_t)(BK * 2);
    const size_t hsA = (size_t)HALF * g.lda * 2, hsB = (size_t)HALF * g.ldb * 2;
    const size_t tsA = 2 * hsA, tsB = 2 * hsB;
    const unsigned ldsbase = (unsigned)(unsigned long long)lds;
    const unsigned ldsw = (unsigned)wid * 1024u;
    const int aoff = lds_byte(wr * 64 + fr, fq * 8), boff = lds_byte(wc * 32 + fr, fq * 8);
#define PG8_SA(b, h) (((b) * 2 + (h)) * HTB)
#define PG8_SB(b, h) ((4 + (b) * 2 + (h)) * HTB)
#define PG8_STAGE(bufoff, gbase, voff) do { _Pragma("unroll") for (int _i = 0; _i < 2; ++_i) { \
        const unsigned m0_ = ldsbase + (unsigned)(bufoff) + ldsw + (unsigned)_i * 8192u; \
        asm volatile("s_mov_b32 m0, %2\n\ts_nop 0\n\tglobal_load_lds_dwordx4 %0, %1" :: "v"((voff)[_i]), "s"((const char*)(gbase)), "s"(m0_) : "memory", "m0"); } } while (0)
#define PG8_LDA(dst, b, h) do { _Pragma("unroll") for (int m = 0; m < 4; ++m) _Pragma("unroll") for (int k = 0; k < 2; ++k) dst[m][k] = *(const PG8_LAS bf16x8*)(lds + PG8_SA(b, h) + aoff + m * 2048 + k * 1024); } while (0)
#define PG8_LDB(dst, b, h) do { _Pragma("unroll") for (int n = 0; n < 2; ++n) _Pragma("unroll") for (int k = 0; k < 2; ++k) dst[n][k] = *(const PG8_LAS bf16x8*)(lds + PG8_SB(b, h) + boff + n * 2048 + k * 1024); } while (0)
#define PG8_MMA(ai, bj, At, Bt) do { __builtin_amdgcn_s_setprio(1); _Pragma("unroll") for (int m = 0; m < 4; ++m) _Pragma("unroll") for (int n = 0; n < 2; ++n) _Pragma("unroll") for (int k = 0; k < 2; ++k) \
        acc[ai][bj][m][n] = __builtin_amdgcn_mfma_f32_16x16x32_bf16(Bt[n][k], At[m][k], acc[ai][bj][m][n], 0, 0, 0); __builtin_amdgcn_s_setprio(0); } while (0)
#define PG8_WAIT_V(n) asm volatile("s_waitcnt vmcnt(" #n ")" ::: "memory")
#define PG8_WAIT_L(n) asm volatile("s_waitcnt lgkmcnt(" #n ")" ::: "memory")
#define PG8_BAR __builtin_amdgcn_s_barrier()
#define PG8_SCHED __builtin_amdgcn_sched_barrier(0)
    Unit cur, nxt; int ui = 0; bool epi_ran = false;
    if (!S.next(0, cur)) return;
    f32x4 acc[2][2][4][2];
#pragma unroll
    for (int a = 0; a < 2; ++a)
#pragma unroll
        for (int b = 0; b < 2; ++b)
#pragma unroll
            for (int m = 0; m < 4; ++m)
#pragma unroll
                for (int n = 0; n < 2; ++n) acc[a][b][m][n] = (f32x4){0.f, 0.f, 0.f, 0.f};
    bf16x8 At[4][2], B0[2][2], B1[2][2];
    const char* cA = (const char*)g.A + (size_t)cur.pm * tsA + (size_t)cur.k0 * 2; const char* cB = (const char*)g.Bt + (size_t)cur.pn * tsB + (size_t)cur.k0 * 2;
    S.a_ready(cur);
    if constexpr (SP2) {
        PG8_STAGE(PG8_SB(0, 0), cB, voffB); PG8_STAGE(PG8_SB(0, 1), cB + hsB, voffB); PG8_STAGE(PG8_SA(0, 0), cA, voffA); PG8_STAGE(PG8_SA(0, 1), cA + hsA, voffA);
        if (wr == 1) PG8_BAR;
        PG8_WAIT_V(2); PG8_BAR;
        PG8_STAGE(PG8_SB(1, 0), cB + kstep, voffB); PG8_STAGE(PG8_SA(1, 0), cA + kstep, voffA); PG8_STAGE(PG8_SB(1, 1), cB + hsB + kstep, voffB);
        PG8_WAIT_V(6); PG8_BAR;
    } else {
        PG8_STAGE(PG8_SB(0, 0), cB, voffB); PG8_STAGE(PG8_SA(0, 0), cA, voffA); PG8_STAGE(PG8_SB(0, 1), cB + hsB, voffB); PG8_STAGE(PG8_SA(0, 1), cA + hsA, voffA);
        if (wr == 1) PG8_BAR;
        PG8_WAIT_V(4); PG8_BAR;
        PG8_STAGE(PG8_SB(1, 0), cB + kstep, voffB); PG8_STAGE(PG8_SA(1, 0), cA + kstep, voffA); PG8_STAGE(PG8_SB(1, 1), cB + hsB + kstep, voffB);
        PG8_WAIT_V(6); PG8_BAR;
    }
    constexpr bool DRO = SP2 && (EPI_DRAIN_OVERLAP != 0) && !Sched::KTWICE && !Epi::AFTER_DRAIN && Epi::DRAIN_OK;
#define PG8_TRIP(STAGE11, WV) do { \
            PG8_LDB(B0, 0, 0); PG8_LDB(B1, 0, 1); PG8_SCHED; PG8_LDA(At, 0, 0); if (STAGE11) PG8_STAGE(PG8_SA(1, 1), a1 + hsA, voffA); \
            WV; PG8_WAIT_L(0); PG8_BAR; PG8_MMA(0, 0, At, B0); PG8_MMA(0, 1, At, B1); PG8_BAR; PG8_SCHED; \
              \
            PG8_LDA(At, 0, 1); PG8_STAGE(PG8_SB(0, 0), b2, voffB); PG8_STAGE(PG8_SB(0, 1), b2 + hsB, voffB); PG8_STAGE(PG8_SA(0, 0), a2, voffA); \
            WV; PG8_WAIT_L(0); PG8_BAR; PG8_MMA(1, 0, At, B0); PG8_MMA(1, 1, At, B1); PG8_BAR; PG8_SCHED; \
              \
            PG8_LDB(B0, 1, 0); PG8_LDB(B1, 1, 1); PG8_SCHED; PG8_LDA(At, 1, 0); PG8_STAGE(PG8_SA(0, 1), a2 + hsA, voffA); \
            WV; PG8_WAIT_L(0); PG8_BAR; PG8_MMA(0, 0, At, B0); PG8_MMA(0, 1, At, B1); PG8_BAR; PG8_SCHED; \
              \
            PG8_LDA(At, 1, 1); PG8_STAGE(PG8_SB(1, 0), b3, voffB); PG8_STAGE(PG8_SB(1, 1), b3 + hsB, voffB); PG8_STAGE(PG8_SA(1, 0), a3, voffA); \
            PG8_WAIT_V(8); PG8_WAIT_L(0); PG8_BAR; PG8_MMA(1, 0, At, B0); PG8_MMA(1, 1, At, B1); PG8_BAR; PG8_SCHED; } while (0)
    for (;;) {
        const bool has_next = S.next(ui + 1, nxt);
        const char* nA = has_next ? (const char*)g.A + (size_t)nxt.pm * tsA + (size_t)nxt.k0 * 2 : cA; const char* nB = has_next ? (const char*)g.Bt + (size_t)nxt.pn * tsB + (size_t)nxt.k0 * 2 : cB;
        for (int t = (DRO && ui > 0) ? 2 : 0; t < nt; t += 2) {
            const bool last = (t == nt - 2);
            const char* a1 = cA + (size_t)(t + 1) * kstep;
            const char* a2 = last ? nA : cA + (size_t)(t + 2) * kstep; const char* b2 = last ? nB : cB + (size_t)(t + 2) * kstep;
            const char* a3 = a2 + kstep; const char* b3 = b2 + kstep;
            if (last && has_next) S.a_ready(nxt);
            if constexpr (SP2) {
            PG8_TRIP(true, PG8_WAIT_V(8));
            } else {
            PG8_LDB(B0, 0, 0); PG8_SCHED; PG8_LDA(At, 0, 0); PG8_STAGE(PG8_SA(1, 1), a1 + hsA, voffA);
            PG8_WAIT_L(8); PG8_BAR; PG8_WAIT_L(0); PG8_MMA(0, 0, At, B0); PG8_BAR; PG8_SCHED;
            PG8_LDB(B1, 0, 1); PG8_STAGE(PG8_SB(0, 0), b2, voffB);
            PG8_BAR; PG8_WAIT_L(0); PG8_MMA(0, 1, At, B1); PG8_BAR;
            PG8_LDA(At, 0, 1); PG8_STAGE(PG8_SA(0, 0), a2, voffA);
            PG8_BAR; PG8_WAIT_L(0); PG8_MMA(1, 0, At, B0); PG8_BAR; PG8_SCHED;
            PG8_STAGE(PG8_SB(0, 1), b2 + hsB, voffB);
            PG8_WAIT_V(6); PG8_BAR; PG8_MMA(1, 1, At, B1); PG8_BAR;
            PG8_LDB(B0, 1, 0); PG8_SCHED; PG8_LDA(At, 1, 0); PG8_STAGE(PG8_SA(0, 1), a2 + hsA, voffA);
            PG8_WAIT_L(8); PG8_BAR; PG8_WAIT_L(0); PG8_MMA(0, 0, At, B0); PG8_BAR; PG8_SCHED;
            PG8_LDB(B1, 1, 1); PG8_STAGE(PG8_SB(1, 0), b3, voffB);
            PG8_BAR; PG8_WAIT_L(0); PG8_MMA(0, 1, At, B1); PG8_BAR;
            PG8_LDA(At, 1, 1); PG8_STAGE(PG8_SA(1, 0), a3, voffA);
            PG8_BAR; PG8_WAIT_L(0); PG8_MMA(1, 0, At, B0); PG8_BAR; PG8_SCHED;
            PG8_STAGE(PG8_SB(1, 1), b3 + hsB, voffB);
            PG8_WAIT_V(6); PG8_BAR; PG8_MMA(1, 1, At, B1); PG8_BAR;
            }
        }
        if constexpr (DRO) { asm volatile("" ::: "memory"); PG8_STAGE(PG8_SA(1, 1), nA + kstep + hsA, voffA); asm volatile("" ::: "memory"); }
        const bool kp_first = Sched::KTWICE && ((ui & 1) == 0);
        (void)epi_ran;
        if constexpr (ALIGN_EPI) { if (wr == 0) PG8_BAR; }
        if (!kp_first) if constexpr (!Epi::AFTER_DRAIN) { E(acc, cur, wr, wc, fr, fq); if constexpr (REP_EPI > 1 && Epi::REP2) { asm volatile("" ::: "memory"); E(acc, cur, wr, wc, fr, fq); } S.done(cur); }
        asm volatile("" ::: "memory");
        if (!has_next) break;
        if (!kp_first)
#pragma unroll
        for (int a = 0; a < 2; ++a)
#pragma unroll
            for (int b = 0; b < 2; ++b)
#pragma unroll
                for (int m = 0; m < 4; ++m)
#pragma unroll
                    for (int n = 0; n < 2; ++n) acc[a][b][m][n] = (f32x4){0.f, 0.f, 0.f, 0.f};
        cur = nxt; cA = nA; cB = nB; ++ui;
        if constexpr (ALIGN_EPI) { if (wr == 1) PG8_BAR; }
        if constexpr (DRO) {
            const char* a1 = cA + kstep; const char* a2 = cA + 2 * kstep; const char* b2 = cB + 2 * kstep; const char* a3 = a2 + kstep; const char* b3 = b2 + kstep;
            PG8_TRIP(false, asm volatile("s_waitcnt vmcnt(%0)" :: "n"(8 + Epi::NVM) : "memory"));
        }
    }
    PG8_WAIT_V(0);
    if constexpr (!ALIGN_EPI) { if (wr == 0) PG8_BAR; }
    PG8_BAR;
    if constexpr (Epi::AFTER_DRAIN) { E.fused(acc, cur, wr, wc, fr, fq, lds, wid, lane); S.done(cur); }
#undef PG8_SA
#undef PG8_SB
#undef PG8_STAGE
#undef PG8_LDA
#undef PG8_LDB
#undef PG8_MMA
#undef PG8_WAIT_V
#undef PG8_TRIP
#undef PG8_WAIT_L
#undef PG8_BAR
#undef PG8_SCHED
}
}

#ifndef MK_N_LAUNCHES
#define MK_N_LAUNCHES 1
#endif
constexpr int NWAVES = 8;
constexpr int D = 2048, BATCH = 4, SEQ = 4096, CTXL = 256, DEPTH = 4, FF = 5632;
constexpr int ML = BATCH * SEQ, MC = BATCH * CTXL, M = ML + MC;
constexpr int NLP = ML / 256;
constexpr int MOD_LD = 6 * D;
constexpr float EPS = 1e-6f;
constexpr int N_PHASES = 3 + 8 * DEPTH;

constexpr size_t MiB = 1u << 20;
constexpr size_t WS_CTL = 0, WS_MOD = 1 * MiB, ZERO_BYTES = 64 * 1024;
constexpr size_t WS_TAB = 2 * MiB;
constexpr size_t TAB_COS = 0, TAB_SIN = 16384, TAB_LB = 32768;
constexpr size_t WS_X = 4 * MiB;
constexpr size_t WS_HN = 140 * MiB;
constexpr size_t WS_ACT = 208 * MiB;
constexpr size_t ACT_STRIDE = (size_t)M * D;
constexpr size_t WS_OF = 684 * MiB, WS_OB = 820 * MiB;
constexpr size_t WS_W = 956 * MiB, W_LAYER = 114 * MiB;
constexpr size_t W_IN = 0, W_OUT = 40 * MiB, W_GU = 48 * MiB, W_DN = 92 * MiB;
constexpr size_t WS_SLAB = WS_W + 4 * W_LAYER;
constexpr size_t WS_END = WS_SLAB + 32 * MiB;
constexpr int CW_BAR = 4096;

constexpr int RING_BYTES = 131072;
constexpr int LDSCTL_OFF = RING_BYTES, MISC_OFF = LDSCTL_OFF + 320;
constexpr int LDS_BYTES = 147456;

#define GAS __attribute__((address_space(1)))
#define LAS __attribute__((address_space(3)))
typedef unsigned short bf16;
typedef unsigned v4u __attribute__((ext_vector_type(4)));
typedef unsigned v2u __attribute__((ext_vector_type(2)));
typedef float f32x4 __attribute__((ext_vector_type(4)));
typedef GAS unsigned gu32;
#define LDS_WAIT() asm volatile("s_waitcnt lgkmcnt(0)" ::: "memory")
__device__ __forceinline__ unsigned f2bf(float f) { unsigned u = __builtin_bit_cast(unsigned, f); return (u + 0x7fffu + ((u >> 16) & 1u)) >> 16; }
typedef float f32x2_t __attribute__((ext_vector_type(2)));
typedef __bf16 bf16x2_t __attribute__((ext_vector_type(2)));
__device__ __forceinline__ unsigned pk2(float lo, float hi) { const f32x2_t v = {lo, hi}; const bf16x2_t b = __builtin_convertvector(v, bf16x2_t); return __builtin_bit_cast(unsigned, b); }
__device__ __forceinline__ float bflo(unsigned w) { return __builtin_bit_cast(float, w << 16); }
typedef _Float16 f16x2_t __attribute__((ext_vector_type(2)));
__device__ __forceinline__ unsigned xpk2(float lo, float hi) { if (XRES_F16) { const f32x2_t v = {lo, hi}; const f16x2_t h = __builtin_convertvector(v, f16x2_t); return __builtin_bit_cast(unsigned, h); } return pk2(lo, hi); }
__device__ __forceinline__ float xlo(unsigned w) { if (XRES_F16) { const f16x2_t h = __builtin_bit_cast(f16x2_t, w); return (float)h[0]; } return __builtin_bit_cast(float, w << 16); }
__device__ __forceinline__ float xhi(unsigned w) { if (XRES_F16) { const f16x2_t h = __builtin_bit_cast(f16x2_t, w); return (float)h[1]; } return __builtin_bit_cast(float, w & 0xffff0000u); }
__device__ __forceinline__ float bfhi(unsigned w) { return __builtin_bit_cast(float, w & 0xffff0000u); }
template <int CTRL> __device__ __forceinline__ float dpp_mov(float v) { return __builtin_bit_cast(float, __builtin_amdgcn_update_dpp(0, __builtin_bit_cast(int, v), CTRL, 0xF, 0xF, true)); }
__device__ __forceinline__ float wave_sum(float v) {
    v += dpp_mov<0xB1>(v);
    v += dpp_mov<0x4E>(v);
    v += dpp_mov<0x141>(v);
    v += dpp_mov<0x140>(v);
    const int iv = __builtin_bit_cast(int, v);
    const float a = __builtin_bit_cast(float, __builtin_amdgcn_readlane(iv, 0)), b = __builtin_bit_cast(float, __builtin_amdgcn_readlane(iv, 16));
    const float c = __builtin_bit_cast(float, __builtin_amdgcn_readlane(iv, 32)), d = __builtin_bit_cast(float, __builtin_amdgcn_readlane(iv, 48));
    return (a + b) + (c + d);
}
#define XB_TMO      128
#define XB_XCNT(j)  (256  + 64 * (j))
#define XB_XSUB(j)  (1280 + 64 * (j))
#define XB_XGEN(j)  (2304 + 64 * (j))
#define XB_TOP      3328
#define XB_TOPGEN   3392
#define XCD_BAR_WORDS 3456
#define XB_SPIN_CAP (1u << 18)

__device__ __forceinline__ unsigned xb_ld(unsigned* p)              { return __hip_atomic_load(p, __ATOMIC_RELAXED, __HIP_MEMORY_SCOPE_AGENT); }
__device__ __forceinline__ unsigned xb_add(unsigned* p, unsigned v) { return __hip_atomic_fetch_add(p, v, __ATOMIC_RELAXED, __HIP_MEMORY_SCOPE_AGENT); }
__device__ __forceinline__ unsigned xb_xcc_id() { return (unsigned)__builtin_amdgcn_s_getreg((3 << 11) | 20) & 0xFu; }
#define XB_SPIN(cond, bar) do { unsigned _sp = 0; while (cond) { __builtin_amdgcn_s_sleep(1); \
    if ((++_sp & 255u) == 0u) { if (xb_ld(&(bar)[XB_TMO])) break; if (_sp > XB_SPIN_CAP) { atomicAdd(&(bar)[XB_TMO], 1u); break; } } } } while (0)

struct XcdBarrier {
    unsigned* bar; unsigned x;
    volatile LAS unsigned* st;
};

__device__ __forceinline__ XcdBarrier xcd_barrier_post(unsigned* bar, volatile LAS unsigned* st) {
    XcdBarrier b; b.bar = bar; b.x = xb_xcc_id(); b.st = st;
    if (threadIdx.x == 0) (void)xb_add(&bar[XB_XCNT(b.x)], 1u);
    return b;
}
__device__ __forceinline__ void xcd_barrier_complete(unsigned* bar, unsigned x, unsigned& nloc, unsigned& nx) {
    const unsigned G = gridDim.x * gridDim.y * gridDim.z;
    unsigned sum, cnt, mine, sp = 0u;
    for (;;) {
        sum = 0u; cnt = 0u; mine = 0u;
#pragma unroll
        for (unsigned j = 0; j < 16; ++j) { const unsigned c = xb_ld(&bar[XB_XCNT(j)]); sum += c; cnt += (c > 0u) ? 1u : 0u; mine = (j == x) ? c : mine; }
        if (sum == G) break;
        __builtin_amdgcn_s_sleep(1);
        if ((++sp & 255u) == 0u) { if (xb_ld(&bar[XB_TMO])) break; if (sp > XB_SPIN_CAP) { atomicAdd(&bar[XB_TMO], 1u); break; } }
    }
    nloc = mine > 0u ? mine : 1u; nx = cnt > 0u ? cnt : 1u;
}

__device__ __forceinline__ void xcd_barrier(const XcdBarrier& b) {
    asm volatile("s_waitcnt vmcnt(0)" ::: "memory");
    __syncthreads();
    if (mk_tid() == 0) {
        unsigned* bar = b.bar;
        __builtin_amdgcn_s_waitcnt(0);
        unsigned nloc = b.st[0], nx = b.st[1];
        if (nloc == 0u) { xcd_barrier_complete(bar, b.x, nloc, nx); b.st[0] = nloc; b.st[1] = nx; }
        const unsigned old = xb_add(&bar[XB_XSUB(b.x)], 1u);
        const unsigned gen = old / nloc;
        if (old + 1u == (gen + 1u) * nloc) {
            __builtin_amdgcn_fence(__ATOMIC_RELEASE, "agent");
            asm volatile("s_waitcnt vmcnt(0)" ::: "memory");
            const unsigned og = xb_add(&bar[XB_TOP], 1u);
            const unsigned tg = og / nx;
            if (og + 1u == (tg + 1u) * nx) xb_add(&bar[XB_TOPGEN], 1u);
            else XB_SPIN(xb_ld(&bar[XB_TOPGEN]) == tg, bar);
            __builtin_amdgcn_fence(__ATOMIC_ACQUIRE, "agent");
            xb_add(&bar[XB_XGEN(b.x)], 1u);
            asm volatile("s_waitcnt vmcnt(0)" ::: "memory");
        } else {
            XB_SPIN(xb_ld(&bar[XB_XGEN(b.x)]) == gen, bar);
            __builtin_amdgcn_fence(__ATOMIC_ACQUIRE, "agent");
            asm volatile("s_waitcnt vmcnt(0)" ::: "memory");
        }
    }
    __syncthreads();
}

struct Args { const float* in[18]; float* out; unsigned char* ws; int ph_lo, ph_hi; };
struct Frame {
    LAS unsigned char* lds;
    gu32* ctl;
    int tid, lane, wave, vcu, G;
};
__device__ __forceinline__ void relaunder(Frame& F) { int t = mk_tid(); asm volatile("" : "+v"(t)); F.tid = t; F.lane = t & 63; F.wave = __builtin_amdgcn_readfirstlane(t >> 6); }

__device__ __forceinline__ void p0_transpose_item(const float* W, int K, int N, bf16* WT, int dst_row0, LAS float* scr, int k0, int n0, int lane) {
    float r[32];
    const GAS float* wp = (const GAS float*)W + (size_t)(k0 + (lane >> 5)) * N + n0 + (lane & 31);
#pragma unroll
    for (int i = 0; i < 32; ++i) r[i] = PRO_NT ? __builtin_nontemporal_load(wp + (size_t)(2 * i) * N) : wp[(size_t)(2 * i) * N];
#pragma unroll
    for (int i = 0; i < 32; ++i) scr[(2 * i + (lane >> 5)) * 33 + (lane & 31)] = r[i];
    LDS_WAIT(); asm volatile("" ::: "memory");
    const int c = lane & 7;
#pragma unroll
    for (int j = 0; j < 4; ++j) { const int n = (lane >> 3) + 8 * j; const LAS float* s = scr + (8 * c) * 33 + n;
        v4u o; o.x = pk2(s[0 * 33], s[1 * 33]); o.y = pk2(s[2 * 33], s[3 * 33]); o.z = pk2(s[4 * 33], s[5 * 33]); o.w = pk2(s[6 * 33], s[7 * 33]);
        if (WT_NT_ST) __builtin_nontemporal_store(o, (GAS v4u*)(WT + (size_t)(dst_row0 + n) * K + k0 + 8 * c)); else *(GAS v4u*)(WT + (size_t)(dst_row0 + n) * K + k0 + 8 * c) = o; }
    LDS_WAIT(); asm volatile("" ::: "memory");
}
__device__ __forceinline__ bool p0_matrix(int& it, const float* W, int K, int N, bf16* WT, bool gu, LAS float* scr, int lane) {
    const int nblk = N / 32, items = (K / 64) * nblk;
    if (it >= items) { it -= items; return false; }
    const int kb = it / nblk, nb = it % nblk, n0 = 32 * nb;
    int dst = n0;
    if (gu) { const int half = n0 / FF, w = n0 % FF; dst = (w / 128) * 256 + half * 128 + (w % 128); }
    p0_transpose_item(W, K, N, WT, dst, scr, 64 * kb, n0, lane);
    return true;
}
__device__ __forceinline__ void sincos_pos(float x, float& s, float& c) {
    const float n = rintf(x * 0.63661977236758f);
    float r = fmaf(n, -1.5707962512969971f, x); r = fmaf(n, -7.5497894158615964e-08f, r);
    const float r2 = r * r;
    const float sp = r + r * r2 * (-1.6666667e-1f + r2 * (8.3333333e-3f + r2 * (-1.9841270e-4f + r2 * 2.7557319e-6f)));
    const float cp = 1.0f + r2 * (-0.5f + r2 * (4.1666667e-2f + r2 * (-1.3888889e-3f + r2 * (2.4801587e-5f + r2 * -2.7557319e-7f))));
    const int q = ((int)n) & 3;
    s = (q == 0) ? sp : (q == 1) ? cp : (q == 2) ? -sp : -cp;
    c = (q == 0) ? cp : (q == 1) ? -sp : (q == 2) ? -cp : sp;
}
constexpr int I_RET = 32 * 256 + 32 * 64 + 32 * 352 + 88 * 64, I_HG = 32 * 320 + 32 * 64 + 32 * 352 + 88 * 64;
__device__ __forceinline__ void p0_convert_item(const Args& a, int layer, int it, LAS float* scr, int lane) {
    unsigned char* wb = a.ws + WS_W + (size_t)layer * W_LAYER;
    const int j = layer >> 1;
    if (layer & 1) { if (p0_matrix(it, a.in[11] + (size_t)j * D * 5 * D, D, 5 * D, (bf16*)(wb + W_IN), false, scr, lane)) return;
                     if (p0_matrix(it, a.in[12] + (size_t)j * D * D, D, D, (bf16*)(wb + W_OUT), false, scr, lane)) return; }
    else           { if (p0_matrix(it, a.in[8] + (size_t)j * D * 4 * D, D, 4 * D, (bf16*)(wb + W_IN), false, scr, lane)) return;
                     if (p0_matrix(it, a.in[9] + (size_t)j * D * D, D, D, (bf16*)(wb + W_OUT), false, scr, lane)) return; }
    if (p0_matrix(it, a.in[15] + (size_t)layer * D * 2 * FF, D, 2 * FF, (bf16*)(wb + W_GU), true, scr, lane)) return;
    p0_matrix(it, a.in[16] + (size_t)layer * FF * D, FF, D, (bf16*)(wb + W_DN), false, scr, lane);
}
__device__ __forceinline__ void tail_convert(const Args& a, Frame& F, int layer_next, int window, int widx, int nidle, int nidle1) {
    relaunder(F);
    const int T = (layer_next & 1) ? I_HG : I_RET;
    const int n1 = nidle1 * NWAVES * 12, n2 = n1 + 128 * NWAVES * 4, n3 = n2 + 80 * NWAVES * 12;
    const int lo = window == 1 ? 0 : window == 2 ? n1 : window == 3 ? n2 : n3, hi_ = window == 1 ? n1 : window == 2 ? n2 : window == 3 ? n3 : T;
    const int hi = hi_ < T ? hi_ : T;
    LAS float* scr = (LAS float*)(F.lds + F.wave * 9216);
    for (int it = lo + widx * NWAVES + F.wave; it < hi; it += nidle * NWAVES) p0_convert_item(a, layer_next, it, scr, F.lane);
}
__device__ __forceinline__ void p0_prologue(const Args& a, Frame& F) {
    relaunder(F);
    LAS float* scr = (LAS float*)(F.lds + F.wave * 9216);
    LAS float* act = (LAS float*)(F.lds + 73728);
    for (int i = F.tid; i < 5 * D; i += NWAVES * 64) { const float v = (i < 4 * D) ? a.in[1][i] : a.in[3][i - 4 * D]; act[i] = v / (1.f + __expf(-v)); }
    __syncthreads();
    const int gw = F.vcu * NWAVES + F.wave, NGW = F.G * NWAVES;
    for (int t = gw; t < DEPTH * 48 * 32; t += NGW) {
        const int layer = t / (48 * 32), rem = t % (48 * 32), cb = rem >> 5, ks = rem & 31;
        const int col = cb * 256 + F.lane * 4;
        const float* wp = a.in[4] + ((size_t)layer * D + ks * 64) * MOD_LD + col;
        f32x4 acc0 = {0.f, 0.f, 0.f, 0.f}, acc1 = acc0, acc2 = acc0, acc3 = acc0, acc4 = acc0;
        for (int kk = 0; kk < 64; kk += 16) {
            f32x4 w[16];
#pragma unroll
            for (int u = 0; u < 16; ++u) w[u] = PRO_NT ? __builtin_nontemporal_load((const GAS f32x4*)(wp + (size_t)(kk + u) * MOD_LD)) : *(const GAS f32x4*)(wp + (size_t)(kk + u) * MOD_LD);
#pragma unroll
            for (int u = 0; u < 16; ++u) { const int k = ks * 64 + kk + u;
                acc0 += act[k] * w[u]; acc1 += act[D + k] * w[u]; acc2 += act[2 * D + k] * w[u]; acc3 += act[3 * D + k] * w[u]; acc4 += act[4 * D + k] * w[u]; }
        }
        float* pp = (float*)(a.ws + WS_SLAB) + ((size_t)(layer * 32 + ks) * 5) * MOD_LD + col;
        *(GAS f32x4*)(pp) = acc0; *(GAS f32x4*)(pp + MOD_LD) = acc1; *(GAS f32x4*)(pp + 2 * MOD_LD) = acc2; *(GAS f32x4*)(pp + 3 * MOD_LD) = acc3; *(GAS f32x4*)(pp + 4 * MOD_LD) = acc4;
    }
    {
        const int gt = (F.vcu * NWAVES + F.wave) * 64 + F.lane;
        float* tab = (float*)(a.ws + WS_TAB);
        if (gt < 4096) { const int pos = gt >> 6, f = gt & 63; const float inv = expf(-(float)f * (9.210340371976184f / 64.0f)); float s, c; sincos_pos((float)pos * inv, s, c);
            tab[TAB_COS / 4 + gt] = c; tab[TAB_SIN / 4 + gt] = s; }
        else if (gt < 4096 + D) { const int ch = gt - 4096; const float b0 = a.in[14][ch], b1 = a.in[14][D + ch], mx = fmaxf(b0, b1), e0 = __expf(b0 - mx), e1 = __expf(b1 - mx), p0 = e0 / (e0 + e1), p1 = e1 / (e0 + e1);
            tab[TAB_LB / 4 + ch] = p0 - p0; tab[TAB_LB / 4 + D + ch] = (p0 + p1) - p0; }
    }
    for (int rep_ = 0; rep_ < REP_PRO; ++rep_) {
    {
        bf16* Xb = (bf16*)(a.ws + WS_X);
        for (int r0_ = gw; r0_ < M; r0_ += 4 * NGW) {
            f32x4 t[4][8];
#pragma unroll
            for (int u = 0; u < 4; ++u) { const int r = r0_ + u * NGW; if (r < M) { const GAS f32x4* xr = (const GAS f32x4*)((r < ML) ? a.in[0] + (size_t)r * D : a.in[2] + (size_t)(r - ML) * D) + F.lane;
#pragma unroll
                for (int j = 0; j < 8; ++j) t[u][j] = __builtin_nontemporal_load(xr + 64 * j); } }
#pragma unroll
            for (int u = 0; u < 4; ++u) { const int r = r0_ + u * NGW; if (r < M) { GAS v2u* o = (GAS v2u*)(Xb + (size_t)r * D) + F.lane;
#pragma unroll
                for (int j = 0; j < 8; ++j) { v2u w; w.x = xpk2(t[u][j][0], t[u][j][1]); w.y = xpk2(t[u][j][2], t[u][j][3]); o[64 * j] = w; } } }
        }
    }
    if (TAIL_CONVERT && F.G == 256) {
        for (int it = gw; it < I_RET; it += NGW) p0_convert_item(a, 0, it, scr, F.lane);
    } else {
        for (int it0 = gw; it0 < 2 * (I_RET + I_HG); it0 += NGW) {
            int it = it0; const int lp = it / (I_RET + I_HG); it -= lp * (I_RET + I_HG);
            int layer = 2 * lp; if (it >= I_RET) { it -= I_RET; layer += 1; }
            p0_convert_item(a, layer, it, scr, F.lane);
        }
    }
    }
}

__device__ __forceinline__ void p1_modreduce(const Args& a, Frame& F) {
    relaunder(F);
    static_assert((size_t)DEPTH * 32 * 5 * MOD_LD * 4 <= 32 * MiB, "the GEMV partials fit the slab region");
    for (int q = (F.vcu * NWAVES + F.wave) * 64 + F.lane; q < DEPTH * 5 * (MOD_LD / 4); q += F.G * NWAVES * 64) {
        const int layer = q / (5 * (MOD_LD / 4)), rem = q % (5 * (MOD_LD / 4)), row = rem / (MOD_LD / 4), c4 = rem % (MOD_LD / 4);
        const GAS f32x4* pp = (const GAS f32x4*)((const float*)(a.ws + WS_SLAB) + ((size_t)(layer * 32) * 5 + row) * MOD_LD) + c4;
        f32x4 t[32];
#pragma unroll
        for (int ks = 0; ks < 32; ++ks) t[ks] = pp[(size_t)ks * 5 * (MOD_LD / 4)];
        f32x4 sum = *(const GAS f32x4*)(a.in[5] + (size_t)layer * MOD_LD + 4 * c4);
#pragma unroll
        for (int ks = 0; ks < 32; ++ks) sum += t[ks];
        *((GAS f32x4*)((float*)(a.ws + WS_MOD) + ((size_t)layer * 5 + row) * MOD_LD) + c4) = sum;
    }
}

__device__ __forceinline__ void norm_mod_phase(const Args& a, Frame& F, const float* gain, const float* modl, int sh_off, int sc_off, int nrows, const float* slab_gate) {
    relaunder(F);
    const int gw = F.vcu * NWAVES + F.wave, NGW = F.G * NWAVES;
    bf16* X = (bf16*)(a.ws + WS_X); bf16* HN = (bf16*)(a.ws + WS_HN);
    for (int r = gw; r < nrows; r += NGW) {
        const int b = (r < ML) ? (r >> 12) : 4;
        const GAS v2u* xr = (const GAS v2u*)(X + (size_t)r * D) + F.lane;
        f32x4 v[8]; float ss = 0.f;
#pragma unroll
        for (int j = 0; j < 8; ++j) { const v2u w = xr[64 * j]; v[j] = (f32x4){xlo(w.x), xhi(w.x), xlo(w.y), xhi(w.y)}; }
        if (slab_gate != nullptr && r >= ML) {
            const GAS f32x4* sl = (const GAS f32x4*)((const float*)(a.ws + WS_SLAB) + (size_t)(r - ML) * D) + F.lane;
#pragma unroll
            for (int j = 0; j < 8; ++j) { const f32x4 p = (sl[64 * j] + sl[64 * j + (size_t)MC * D / 4]) + (sl[64 * j + 2 * ((size_t)MC * D / 4)] + sl[64 * j + 3 * ((size_t)MC * D / 4)]);
                v[j] += *(const GAS f32x4*)(slab_gate + 256 * j + 4 * F.lane) * p; v2u w; w.x = xpk2(v[j][0], v[j][1]); w.y = xpk2(v[j][2], v[j][3]); ((GAS v2u*)(X + (size_t)r * D) + F.lane)[64 * j] = w;
                v[j] = (f32x4){xlo(w.x), xhi(w.x), xlo(w.y), xhi(w.y)}; }
        }
#pragma unroll
        for (int j = 0; j < 8; ++j) ss += (v[j][0] * v[j][0] + v[j][1] * v[j][1]) + (v[j][2] * v[j][2] + v[j][3] * v[j][3]);
        const float rstd = 1.0f / sqrtf(wave_sum(ss) * (1.0f / D) + EPS);
        const float* mb = modl + (size_t)b * MOD_LD;
        GAS v2u* o8 = (GAS v2u*)(HN + (size_t)r * D) + F.lane;
#pragma unroll
        for (int j = 0; j < 8; ++j) { const int c = 256 * j + 4 * F.lane;
            const f32x4 g = *(const GAS f32x4*)(gain + c), sh = *(const GAS f32x4*)(mb + sh_off + c), sc = *(const GAS f32x4*)(mb + sc_off + c);
            const f32x4 y = (v[j] * rstd) * g * (sc + 1.0f) + sh;
            v2u w; w.x = pk2(y[0], y[1]); w.y = pk2(y[2], y[3]); o8[64 * j] = w; }
    }
}
#define NORM_FN(...) do { if (NORM_PIPE && F.G == 256) norm_mod_phase2(__VA_ARGS__); else norm_mod_phase(__VA_ARGS__); } while (0)
__device__ __forceinline__ void norm_mod_phase2(const Args& a, Frame& F, const float* gain, const float* modl, int sh_off, int sc_off, int nrows, const float* slab_gate) {
    relaunder(F);
    static_assert(ML == 8 * 2048 && MC <= 2048, "8 latent rows and at most one context row per wave of 2048");
    const int nw = F.vcu * NWAVES + F.wave;
    bf16* X = (bf16*)(a.ws + WS_X); bf16* HN = (bf16*)(a.ws + WS_HN);
    LAS float* CA = (LAS float*)F.lds; LAS float* CB = CA + 5 * D;
    v2u r0[8], r1[8], r2[8], r3[8], r4[8], r5[8], r6[8], r7[8];
#define NR_LOAD(dst, k_) do { const GAS v2u* xr_ = (const GAS v2u*)(X + (size_t)(nw + 2048 * (k_)) * D) + F.lane; \
        _Pragma("unroll") for (int j = 0; j < 8; ++j) dst[j] = __builtin_nontemporal_load(xr_ + 64 * j); } while (0)
#define NR_FINISH(raw, r_, b_) do { const int rr_ = (r_); float ss_ = 0.f; f32x4 v[8]; \
        _Pragma("unroll") for (int j = 0; j < 8; ++j) { v[j] = (f32x4){xlo(raw[j].x), xhi(raw[j].x), xlo(raw[j].y), xhi(raw[j].y)}; ss_ += (v[j][0] * v[j][0] + v[j][1] * v[j][1]) + (v[j][2] * v[j][2] + v[j][3] * v[j][3]); } \
        const float rstd_ = 1.0f / sqrtf(wave_sum(ss_) * (1.0f / D) + EPS); \
        GAS v2u* ho_ = (GAS v2u*)(HN + (size_t)rr_ * D) + F.lane; \
        _Pragma("unroll") for (int j = 0; j < 8; ++j) { const int c_ = 256 * j + 4 * F.lane; \
            const f32x4 y_ = (v[j] * rstd_) * *(const LAS f32x4*)(CA + (b_) * D + c_) + *(const LAS f32x4*)(CB + (b_) * D + c_); v2u w_; w_.x = pk2(y_[0], y_[1]); w_.y = pk2(y_[2], y_[3]); \
            ho_[64 * j] = w_; } } while (0)
    NR_LOAD(r0, 0); NR_LOAD(r1, 1); NR_LOAD(r2, 2); NR_LOAD(r3, 3); NR_LOAD(r4, 4); NR_LOAD(r5, 5); NR_LOAD(r6, 6); NR_LOAD(r7, 7);
    { const GAS f32x4* g4 = (const GAS f32x4*)gain;
      for (int q = F.tid; q < 5 * D / 4; q += NWAVES * 64) { const int bq = q >> 9, cq = q & 511; const GAS f32x4* mb4 = (const GAS f32x4*)(modl + (size_t)bq * MOD_LD);
          ((LAS f32x4*)CA)[q] = g4[cq] * (mb4[sc_off / 4 + cq] + 1.0f); ((LAS f32x4*)CB)[q] = mb4[sh_off / 4 + cq]; } }
    asm volatile("s_waitcnt lgkmcnt(0)" ::: "memory"); __builtin_amdgcn_s_barrier(); asm volatile("" ::: "memory");
    NR_FINISH(r0, nw,            (nw) >> 12);
    NR_FINISH(r1, nw + 2048,     (nw + 2048) >> 12);
    NR_FINISH(r2, nw + 2 * 2048, (nw + 2 * 2048) >> 12);
    NR_FINISH(r3, nw + 3 * 2048, (nw + 3 * 2048) >> 12);
    NR_FINISH(r4, nw + 4 * 2048, (nw + 4 * 2048) >> 12);
    NR_FINISH(r5, nw + 5 * 2048, (nw + 5 * 2048) >> 12);
    NR_FINISH(r6, nw + 6 * 2048, (nw + 6 * 2048) >> 12);
    NR_FINISH(r7, nw + 7 * 2048, (nw + 7 * 2048) >> 12);
    if (ML + nw < nrows) {
        const int r = ML + nw, rc = nw;
        const GAS v2u* xr = (const GAS v2u*)(X + (size_t)r * D) + F.lane;
#pragma unroll
        for (int j = 0; j < 8; ++j) r0[j] = xr[64 * j];
        if (slab_gate != nullptr) { const GAS f32x4* sl = (const GAS f32x4*)((const float*)(a.ws + WS_SLAB) + (size_t)rc * D) + F.lane;
#pragma unroll
            for (int j = 0; j < 8; ++j) { const f32x4 p = (sl[64 * j] + sl[64 * j + (size_t)MC * D / 4]) + (sl[64 * j + 2 * ((size_t)MC * D / 4)] + sl[64 * j + 3 * ((size_t)MC * D / 4)]);
                const f32x4 x = (f32x4){xlo(r0[j].x), xhi(r0[j].x), xlo(r0[j].y), xhi(r0[j].y)} + *(const GAS f32x4*)(slab_gate + 256 * j + 4 * F.lane) * p;
                v2u w; w.x = xpk2(x[0], x[1]); w.y = xpk2(x[2], x[3]); ((GAS v2u*)(X + (size_t)r * D) + F.lane)[64 * j] = w; r0[j] = w; } }
        NR_FINISH(r0, r, 4);
    }
    __syncthreads();
#undef NR_LOAD
#undef NR_FINISH
}

template <bool HG>
__device__ __forceinline__ void readout_phase(const Args& a, Frame& F, const float* gain, int nrows) {
    relaunder(F);
    const int gw = F.vcu * NWAVES + F.wave, NGW = F.G * NWAVES;
    const bf16* OF = (const bf16*)(a.ws + WS_OF); const bf16* OB = (const bf16*)(a.ws + WS_OB);
    const bf16* G = (const bf16*)(a.ws + WS_ACT) + (size_t)(HG ? 6 : 3) * ACT_STRIDE; bf16* HN = (bf16*)(a.ws + WS_HN);
    for (int r = gw; r < nrows; r += NGW) {
        const GAS v2u* f = (const GAS v2u*)(OF + (size_t)r * D) + F.lane; const GAS v2u* bk = (const GAS v2u*)(OB + (size_t)r * D) + F.lane;
        const GAS v2u* g8 = (const GAS v2u*)(G + (size_t)r * D) + F.lane;
        f32x4 v[8]; float ssj[8]; float tot = 0.f;
#pragma unroll
        for (int j = 0; j < 8; ++j) { const v2u fa = EW_NT ? __builtin_nontemporal_load(f + 64 * j) : f[64 * j], fb = EW_NT ? __builtin_nontemporal_load(bk + 64 * j) : bk[64 * j]; v[j] = (f32x4){bflo(fa.x) + bflo(fb.x), bfhi(fa.x) + bfhi(fb.x), bflo(fa.y) + bflo(fb.y), bfhi(fa.y) + bfhi(fb.y)}; ssj[j] = (v[j][0] * v[j][0] + v[j][1] * v[j][1]) + (v[j][2] * v[j][2] + v[j][3] * v[j][3]); tot += ssj[j]; }
        float rs_all = 0.f;
        if (HG) rs_all = 1.0f / sqrtf(wave_sum(tot) * (1.0f / D) + EPS);
        GAS v2u* o8 = (GAS v2u*)(HN + (size_t)r * D) + F.lane;
#pragma unroll
        for (int j = 0; j < 8; ++j) {
            float rs = rs_all; f32x4 gn = {1.f, 1.f, 1.f, 1.f};
            if (!HG) rs = 1.0f / sqrtf(wave_sum(ssj[j]) * (1.0f / 256.0f) + EPS);
            else gn = *(const GAS f32x4*)(gain + 256 * j + 4 * F.lane);
            const v2u gw2 = EW_NT ? __builtin_nontemporal_load(g8 + 64 * j) : g8[64 * j];
            const f32x4 gt = {bflo(gw2.x), bfhi(gw2.x), bflo(gw2.y), bfhi(gw2.y)};
            const f32x4 y = (v[j] * rs) * gn * gt;
            v2u w; w.x = pk2(y[0], y[1]); w.y = pk2(y[2], y[3]); o8[64 * j] = w; }
    }
}
template <bool HG>
__device__ __forceinline__ void readout_phase2(const Args& a, Frame& F, const float* gain, int nrows) {
    relaunder(F);
    const int nw = F.vcu * NWAVES + F.wave;
    const bf16* OF = (const bf16*)(a.ws + WS_OF); const bf16* OB = (const bf16*)(a.ws + WS_OB);
    const bf16* G = (const bf16*)(a.ws + WS_ACT) + (size_t)(HG ? 6 : 3) * ACT_STRIDE; bf16* HN = (bf16*)(a.ws + WS_HN);
    LAS float* GL = (LAS float*)F.lds;
    v2u f0[8], b0[8], g0[8], f1[8], b1[8], g1[8], f2[8], b2[8], g2[8];
#define RO_LOAD(fs, bs, gs, r_) do { const size_t o_ = (size_t)(r_) * D; const GAS v2u* f_ = (const GAS v2u*)(OF + o_) + F.lane; const GAS v2u* k_ = (const GAS v2u*)(OB + o_) + F.lane; const GAS v2u* q_ = (const GAS v2u*)(G + o_) + F.lane; \
        _Pragma("unroll") for (int j = 0; j < 8; ++j) { fs[j] = __builtin_nontemporal_load(f_ + 64 * j); bs[j] = __builtin_nontemporal_load(k_ + 64 * j); gs[j] = __builtin_nontemporal_load(q_ + 64 * j); } } while (0)
#define RO_FINISH(fs, bs, gs, r_) do { f32x4 v[8]; float ssj[8]; float tot = 0.f; \
        _Pragma("unroll") for (int j = 0; j < 8; ++j) { v[j] = (f32x4){bflo(fs[j].x) + bflo(bs[j].x), bfhi(fs[j].x) + bfhi(bs[j].x), bflo(fs[j].y) + bflo(bs[j].y), bfhi(fs[j].y) + bfhi(bs[j].y)}; \
            ssj[j] = (v[j][0] * v[j][0] + v[j][1] * v[j][1]) + (v[j][2] * v[j][2] + v[j][3] * v[j][3]); tot += ssj[j]; } \
        float rs_all = 0.f; if (HG) rs_all = 1.0f / sqrtf(wave_sum(tot) * (1.0f / D) + EPS); \
        GAS v2u* o8 = (GAS v2u*)(HN + (size_t)(r_) * D) + F.lane; \
        _Pragma("unroll") for (int j = 0; j < 8; ++j) { float rs = rs_all; f32x4 gn = {1.f, 1.f, 1.f, 1.f}; \
            if (!HG) rs = 1.0f / sqrtf(wave_sum(ssj[j]) * (1.0f / 256.0f) + EPS); else gn = *(const LAS f32x4*)(GL + 256 * j + 4 * F.lane); \
            const f32x4 gt = {bflo(gs[j].x), bfhi(gs[j].x), bflo(gs[j].y), bfhi(gs[j].y)}; const f32x4 y = (v[j] * rs) * gn * gt; \
            v2u w; w.x = pk2(y[0], y[1]); w.y = pk2(y[2], y[3]); o8[64 * j] = w; } } while (0)
    RO_LOAD(f0, b0, g0, nw); RO_LOAD(f1, b1, g1, nw + 2048); RO_LOAD(f2, b2, g2, nw + 2 * 2048);
    if (HG) { for (int q = F.tid; q < D / 4; q += NWAVES * 64) ((LAS f32x4*)GL)[q] = ((const GAS f32x4*)gain)[q];
              asm volatile("s_waitcnt lgkmcnt(0)" ::: "memory"); __builtin_amdgcn_s_barrier(); asm volatile("" ::: "memory"); }
    RO_FINISH(f0, b0, g0, nw);            RO_LOAD(f0, b0, g0, nw + 3 * 2048);
    RO_FINISH(f1, b1, g1, nw + 2048);     RO_LOAD(f1, b1, g1, nw + 4 * 2048);
    RO_FINISH(f2, b2, g2, nw + 2 * 2048); RO_LOAD(f2, b2, g2, nw + 5 * 2048);
    RO_FINISH(f0, b0, g0, nw + 3 * 2048); RO_LOAD(f0, b0, g0, nw + 6 * 2048);
    RO_FINISH(f1, b1, g1, nw + 4 * 2048); RO_LOAD(f1, b1, g1, nw + 7 * 2048);
    RO_FINISH(f2, b2, g2, nw + 5 * 2048);
    const bool cx = ML + nw < nrows;
    RO_LOAD(f2, b2, g2, cx ? ML + nw : nw + 7 * 2048);
    RO_FINISH(f0, b0, g0, nw + 6 * 2048);
    RO_FINISH(f1, b1, g1, nw + 7 * 2048);
    if (cx) RO_FINISH(f2, b2, g2, ML + nw);
    if (HG) __syncthreads();
#undef RO_LOAD
#undef RO_FINISH
}
__device__ __forceinline__ void final_norm_phase2(const Args& a, Frame& F) {
    relaunder(F);
    const int nw = F.vcu * NWAVES + F.wave;
    const bf16* X = (const bf16*)(a.ws + WS_X); const float* gain = a.in[17];
    LAS float* GL = (LAS float*)F.lds;
    v2u r0[8], r1[8], r2[8], r3[8], r4[8], r5[8], r6[8], r7[8];
#define FN_LOAD(dst, k_) do { const GAS v2u* xr_ = (const GAS v2u*)(X + (size_t)(nw + 2048 * (k_)) * D) + F.lane; \
        _Pragma("unroll") for (int j = 0; j < 8; ++j) dst[j] = __builtin_nontemporal_load(xr_ + 64 * j); } while (0)
#define FN_FINISH(raw, k_) do { float ss_ = 0.f; f32x4 v[8]; \
        _Pragma("unroll") for (int j = 0; j < 8; ++j) { v[j] = (f32x4){xlo(raw[j].x), xhi(raw[j].x), xlo(raw[j].y), xhi(raw[j].y)}; ss_ += (v[j][0] * v[j][0] + v[j][1] * v[j][1]) + (v[j][2] * v[j][2] + v[j][3] * v[j][3]); } \
        const float rstd_ = 1.0f / sqrtf(wave_sum(ss_) * (1.0f / D) + EPS); \
        GAS f32x4* o_ = (GAS f32x4*)(a.out + (size_t)(nw + 2048 * (k_)) * D) + F.lane; \
        _Pragma("unroll") for (int j = 0; j < 8; ++j) o_[64 * j] = (v[j] * rstd_) * *(const LAS f32x4*)(GL + 256 * j + 4 * F.lane); } while (0)
    FN_LOAD(r0, 0); FN_LOAD(r1, 1); FN_LOAD(r2, 2); FN_LOAD(r3, 3); FN_LOAD(r4, 4); FN_LOAD(r5, 5); FN_LOAD(r6, 6); FN_LOAD(r7, 7);
    for (int q = F.tid; q < D / 4; q += NWAVES * 64) ((LAS f32x4*)GL)[q] = ((const GAS f32x4*)gain)[q];
    asm volatile("s_waitcnt lgkmcnt(0)" ::: "memory"); __builtin_amdgcn_s_barrier(); asm volatile("" ::: "memory");
    FN_FINISH(r0, 0); FN_FINISH(r1, 1); FN_FINISH(r2, 2); FN_FINISH(r3, 3); FN_FINISH(r4, 4); FN_FINISH(r5, 5); FN_FINISH(r6, 6); FN_FINISH(r7, 7);
#undef FN_LOAD
#undef FN_FINISH
}
__device__ __forceinline__ void final_norm_phase(const Args& a, Frame& F) {
    relaunder(F);
    const int gw = F.vcu * NWAVES + F.wave, NGW = F.G * NWAVES;
    const bf16* X = (const bf16*)(a.ws + WS_X); const float* gain = a.in[17];
    for (int r = gw; r < ML; r += NGW) {
        const GAS v2u* xr = (const GAS v2u*)(X + (size_t)r * D) + F.lane;
        f32x4 v[8]; float ss = 0.f;
#pragma unroll
        for (int j = 0; j < 8; ++j) { const v2u w = xr[64 * j]; v[j] = (f32x4){xlo(w.x), xhi(w.x), xlo(w.y), xhi(w.y)}; ss += (v[j][0] * v[j][0] + v[j][1] * v[j][1]) + (v[j][2] * v[j][2] + v[j][3] * v[j][3]); }
        const float rstd = 1.0f / sqrtf(wave_sum(ss) * (1.0f / D) + EPS);
        GAS f32x4* o = (GAS f32x4*)(a.out + (size_t)r * D) + F.lane;
#pragma unroll
        for (int j = 0; j < 8; ++j) o[64 * j] = (v[j] * rstd) * *(const GAS f32x4*)(gain + 256 * j + 4 * F.lane);
    }
}

template <bool HG>
__device__ __forceinline__ void mixer_phase(const Args& a, Frame& F, int j_layer, bool ctx_out) {
    relaunder(F);
    constexpr int DPL = HG ? 2 : 4, HD = HG ? 128 : 256, NH = HG ? 16 : 8, NEB = HD / 64, CH = 32;
    constexpr int QB = CH * HD * 2;
    constexpr int NQ = HG ? 3 : 2;
    constexpr int VB_OFF = NQ * QB, BUF = VB_OFF + CH * 128;
    static_assert(2 * BUF <= RING_BYTES, "mixer LDS");
    const bf16* act = (const bf16*)(a.ws + WS_ACT);
    const int lane = F.lane, w = F.wave, tid = F.tid;
    for (int task = F.vcu; task < BATCH * NH * 2 * NEB; task += F.G) {
        const int eb = task % NEB, dir = (task / NEB) & 1, h = (task / (2 * NEB)) % NH, b = task / (2 * NEB * NH);
        bf16* O = (bf16*)(a.ws + (dir ? WS_OB : WS_OF));
        const bf16* src0 = act;
        const bf16* src1 = act + (size_t)(HG ? (1 + 2 * dir) : 1) * ACT_STRIDE;
        const bf16* src2 = act + (size_t)(2 + 2 * dir) * ACT_STRIDE;
        const bf16* srcv = act + (size_t)(HG ? 5 : 2) * ACT_STRIDE;
        float gamma = 0.f;
        if (!HG) { const float lg = a.in[10][(j_layer * 2 + dir) * 8 + h]; gamma = 1.0f / (1.0f + expf(-lg)); }
        float S[DPL][8];
#pragma unroll
        for (int i = 0; i < DPL; ++i)
#pragma unroll
            for (int jj = 0; jj < 8; ++jj) S[i][jj] = 0.f;
        constexpr int NCH = (CTXL + SEQ) / CH;
        constexpr int NPQ = HG ? 1 : 2;
        v4u rq[NQ][NPQ]; v4u rv = {0u, 0u, 0u, 0u};
#define MIX_ROWLO(c) (((c) < CTXL / CH) ? (ML + b * CTXL + (dir ? (CTXL / CH - 1 - (c)) : (c)) * CH) : (b * SEQ + (dir ? (SEQ / CH - 1 - ((c) - CTXL / CH)) : ((c) - CTXL / CH)) * CH))
#define MIX_LOAD(c) do { const int rlo_ = MIX_ROWLO(c); \
        _Pragma("unroll") for (int p_ = 0; p_ < NPQ; ++p_) { const int pc_ = tid + 512 * p_; const int row_ = HG ? (pc_ >> 4) : (pc_ >> 5), cc_ = HG ? (pc_ & 15) : (pc_ & 31); \
            const size_t go_ = (size_t)(rlo_ + row_) * D + h * HD + cc_ * 8; \
            rq[0][p_] = *(const GAS v4u*)(src0 + go_); rq[1][p_] = *(const GAS v4u*)(src1 + go_); if (HG) rq[NQ - 1][p_] = *(const GAS v4u*)(src2 + go_); } \
        if (tid < 256) { const int row_ = tid >> 3, cc_ = tid & 7; rv = *(const GAS v4u*)(srcv + (size_t)(rlo_ + row_) * D + h * HD + eb * 64 + cc_ * 8); } } while (0)
#define MIX_STORE(bufp) do { \
        _Pragma("unroll") for (int p_ = 0; p_ < NPQ; ++p_) { const int pc_ = tid + 512 * p_; \
            _Pragma("unroll") for (int q_ = 0; q_ < NQ; ++q_) *(LAS v4u*)((bufp) + q_ * QB + pc_ * 16) = rq[q_][p_]; } \
        if (tid < 256) *(LAS v4u*)((bufp) + VB_OFF + tid * 16) = rv; } while (0)
        __syncthreads();
        MIX_LOAD(0); MIX_STORE(F.lds);
        __syncthreads();
        for (int c = 0; c < NCH; ++c) {
            LAS unsigned char* cur = F.lds + (c & 1) * BUF; LAS unsigned char* nxt = F.lds + ((c + 1) & 1) * BUF;
            if (c + 1 < NCH) MIX_LOAD(c + 1);
            const int rlo = MIX_ROWLO(c);
            const bool do_out = ctx_out || c >= CTXL / CH;
#pragma unroll 2
            for (int s = 0; s < CH; ++s) {
                const int lrow = dir ? (CH - 1 - s) : s;
                float q[DPL], k[DPL], f[DPL];
                if (HG) {
                    const unsigned qw = *(const LAS unsigned*)(cur + lrow * 256 + lane * 4), lw = *(const LAS unsigned*)(cur + QB + lrow * 256 + lane * 4), kw = *(const LAS unsigned*)(cur + 2 * QB + lrow * 256 + lane * 4);
                    q[0] = bflo(qw); q[1] = bfhi(qw); f[0] = __expf(bflo(lw)); f[1] = __expf(bfhi(lw)); k[0] = bflo(kw); k[1] = bfhi(kw);
                } else {
                    const v2u qw = *(const LAS v2u*)(cur + lrow * 512 + lane * 8), kw = *(const LAS v2u*)(cur + QB + lrow * 512 + lane * 8);
                    q[0] = bflo(qw.x); q[1] = bfhi(qw.x); q[DPL - 2] = bflo(qw.y); q[DPL - 1] = bfhi(qw.y);
                    k[0] = bflo(kw.x); k[1] = bfhi(kw.x); k[DPL - 2] = bflo(kw.y); k[DPL - 1] = bfhi(kw.y);
#pragma unroll
                    for (int i = 0; i < DPL; ++i) f[i] = gamma;
                }
                const v4u vw = *(const LAS v4u*)(cur + VB_OFF + lrow * 128 + w * 16);
                const float v[8] = {bflo(vw.x), bfhi(vw.x), bflo(vw.y), bfhi(vw.y), bflo(vw.z), bfhi(vw.z), bflo(vw.w), bfhi(vw.w)};
                float p[8];
#pragma unroll
                for (int jj = 0; jj < 8; ++jj) {
                    float acc = 0.f;
#pragma unroll
                    for (int i = 0; i < DPL; ++i) { S[i][jj] = fmaf(f[i], S[i][jj], k[i] * v[jj]); acc = fmaf(q[i], S[i][jj], acc); }
                    p[jj] = acc;
                }
                if (do_out) {
                    const bool h1 = (lane & 32) != 0, h2 = (lane & 16) != 0, h3 = (lane & 8) != 0;
                    float a4[4], a2[2];
#pragma unroll
                    for (int jj = 0; jj < 4; ++jj) { const float snd = h1 ? p[jj] : p[jj + 4]; const float rcv = __shfl_xor(snd, 32); a4[jj] = (h1 ? p[jj + 4] : p[jj]) + rcv; }
#pragma unroll
                    for (int jj = 0; jj < 2; ++jj) { const float snd = h2 ? a4[jj] : a4[jj + 2]; const float rcv = __shfl_xor(snd, 16); a2[jj] = (h2 ? a4[jj + 2] : a4[jj]) + rcv; }
                    float r1; { const float snd = h3 ? a2[0] : a2[1]; const float rcv = __shfl_xor(snd, 8); r1 = (h3 ? a2[1] : a2[0]) + rcv; }
                    r1 += __shfl_xor(r1, 4); r1 += __shfl_xor(r1, 2); r1 += __shfl_xor(r1, 1);
                    if ((lane & 7) == 0) O[(size_t)(rlo + lrow) * D + h * HD + eb * 64 + w * 8 + (lane >> 3)] = (bf16)f2bf(r1);
                }
            }
            if (c + 1 < NCH) MIX_STORE(nxt);
            __syncthreads();
        }
#undef MIX_ROWLO
#undef MIX_LOAD
#undef MIX_STORE
    }
}


typedef short mx_bf16x8 __attribute__((ext_vector_type(8)));
typedef short mx_s4 __attribute__((ext_vector_type(4)));
#ifndef MX_SWZ
#define MX_SWZ 0
#endif
constexpr int MX_PS = MX_SWZ ? 128 : 144;
__device__ __forceinline__ int sw16(int row) { return MX_SWZ ? 2 * (row & 3) + 8 * ((row >> 3) & 1) : 0; }
__device__ __forceinline__ int sw8(int row) { return MX_SWZ ? (row >> 1) & 7 : 0; }
__device__ __forceinline__ mx_bf16x8 frag_row(const LAS unsigned char* img, int stride, int row0, int k0, int lane) {
    const int row = row0 + (lane & 15);
    return *(const LAS mx_bf16x8*)(img + row * stride + 16 * (((k0 >> 3) + (lane >> 4)) ^ sw16(row)));
}
__device__ __forceinline__ mx_bf16x8 frag_row8(const LAS unsigned char* img, int row0, int k0, int lane) {
    const int row = row0 + (lane & 15);
    return *(const LAS mx_bf16x8*)(img + row * MX_PS + 16 * (((k0 >> 3) + (lane >> 4)) ^ sw8(row)));
}
__device__ __forceinline__ mx_bf16x8 frag_tr(const LAS unsigned char* img, int stride, int k0, int c0, int lane) {
    const int g = lane >> 4, i = lane & 15, q = i >> 2, p = i & 3;
    const int row = k0 + 8 * g + q;
    const LAS unsigned char* ad = img + row * stride + 16 * (((c0 >> 3) + (p >> 1)) ^ sw16(row)) + 8 * (p & 1);
    const mx_s4 x = __builtin_amdgcn_ds_read_tr16_b64_v4i16((LAS mx_s4*)ad);
    const mx_s4 y = __builtin_amdgcn_ds_read_tr16_b64_v4i16((LAS mx_s4*)(ad + 4 * stride));
    return (mx_bf16x8){x[0], x[1], x[2], x[3], y[0], y[1], y[2], y[3]};
}
#define MX_MFMA(a, b, c) __builtin_amdgcn_mfma_f32_16x16x32_bf16((a), (b), (c), 0, 0, 0)
#define MX_BAR() do { asm volatile("s_waitcnt lgkmcnt(0)" ::: "memory"); __builtin_amdgcn_s_barrier(); if (MXP_BAR > 1) __builtin_amdgcn_s_barrier(); asm volatile("" ::: "memory"); } while (0)

template <bool HG, int VAR = 0>
__device__ __forceinline__ void mixer_mfma(const Args& a, Frame& F, int j_layer, bool ctx_out) {
    relaunder(F);
    float zf_ = 0.f; asm volatile("" : "+v"(zf_));
    const f32x4 ZERO4 = {zf_, zf_, zf_, zf_};
    constexpr int HD = HG ? 128 : 256, NH = HG ? 16 : 8, NEB = HD / 64, C = 64, NCTX = CTXL / C, NCH = (CTXL + SEQ) / C;
    constexpr int KS = HD / 32;
    constexpr int DT = HD / 128;
    constexpr int QS = HD * 2 + (MX_SWZ ? 0 : 16);
    constexpr int IMG = 64 * QS;
    constexpr int PS = MX_PS;
    constexpr int NI = HG ? 4 : 2;
    constexpr int O_VT = NI * IMG, O_P = O_VT + 64 * PS, O_ST = O_P + 64 * PS, O_TOT = O_ST + IMG, O_END = O_TOT + 4 * 128 * 4 + 128 * 4;
    static_assert(O_END <= RING_BYTES, "mixer LDS");
    const int lane = F.lane, w = F.wave, tid = F.tid, g = lane >> 4, i = lane & 15;
    const int rg = w >> 1, cg = w & 1, nq0 = 16 * rg;
    LAS unsigned char* const L = F.lds;
    const bf16* act = (const bf16*)(a.ws + WS_ACT);
    for (int task = F.vcu; task < BATCH * NH * 2 * NEB; task += F.G) {
        const int eb = task % NEB, dir = (task / NEB) & 1, h = (task / (2 * NEB)) % NH, b = task / (2 * NEB * NH);
        bf16* O = (bf16*)(a.ws + (dir ? WS_OB : WS_OF));
        const bf16* src0 = act;
        const bf16* src1 = act + (size_t)(HG ? (2 + 2 * dir) : 1) * ACT_STRIDE;
        const bf16* src2 = act + (size_t)(1 + 2 * dir) * ACT_STRIDE;
        const bf16* srcv = act + (size_t)(HG ? 5 : 2) * ACT_STRIDE;
        float lg2 = 0.f;
        if (!HG) { const float x = a.in[10][(j_layer * 2 + dir) * 8 + h]; lg2 = -log1pf(expf(-x)) * 1.4426950408889634f; }
        const float r1 = HG ? 1.f : exp2f((float)(nq0 + i - 63) * lg2), r2 = HG ? 1.f : exp2f((float)(nq0 + i + 1) * lg2), cdec = HG ? 1.f : exp2f(64.f * lg2);
        const int vrow = tid & 63, vcc = tid >> 6;
        const int vs = dir ? 63 - vrow : vrow;
        const float kdec = HG ? 1.f : exp2f((float)(63 - vs) * lg2);
        f32x4 accS[DT][4];
#pragma unroll
        for (int td = 0; td < DT; ++td)
#pragma unroll
            for (int te = 0; te < 4; ++te) accS[td][te] = ZERO4;
        constexpr int NPQ = HG ? 2 : 4;
        constexpr int PF = HG ? MX_PF_HG : MX_PF_RET;
        static_assert(NCH % PF == 0, "prefetch depth must divide the chunk count");
        v4u rq[PF][HG ? 3 : 2][NPQ]; v4u rv[PF];
#define MX_ROWLO(c) (((c) < NCTX) ? (ML + b * CTXL + (dir ? (NCTX - 1 - (c)) : (c)) * C) : (b * SEQ + (dir ? (SEQ / C - 1 - ((c) - NCTX)) : ((c) - NCTX)) * C))
#define MX_LOAD(c, SET) do { const int rlo_ = (VAR & 1) ? MX_ROWLO(0) : MX_ROWLO(c); \
        _Pragma("unroll") for (int p_ = 0; p_ < NPQ; ++p_) { const int pc_ = tid + 512 * p_; const int row_ = pc_ / (HD / 8), cc_ = pc_ % (HD / 8); \
            const size_t go_ = (size_t)(rlo_ + row_) * D + h * HD + cc_ * 8; \
            rq[SET][0][p_] = *(const GAS v4u*)(src0 + go_); rq[SET][1][p_] = *(const GAS v4u*)(src1 + go_); if (HG) rq[SET][HG ? 2 : 1][p_] = *(const GAS v4u*)(src2 + go_); } \
        rv[SET] = *(const GAS v4u*)(srcv + (size_t)(rlo_ + vrow) * D + h * HD + eb * 64 + vcc * 8); } while (0)
#define MX_STAGE(SET) do { \
        _Pragma("unroll") for (int p_ = 0; p_ < NPQ; ++p_) { const int pc_ = tid + 512 * p_; const int row_ = pc_ / (HD / 8), cc_ = pc_ % (HD / 8); const int s_ = dir ? 63 - row_ : row_; \
            const int so_ = s_ * QS + 16 * (cc_ ^ sw16(s_)); *(LAS v4u*)(L + so_) = rq[SET][0][p_]; *(LAS v4u*)(L + IMG + so_) = rq[SET][1][p_]; if (HG) *(LAS v4u*)(L + 2 * IMG + so_) = rq[SET][HG ? 2 : 1][p_]; } \
        { const unsigned vw_[4] = {rv[SET].x, rv[SET].y, rv[SET].z, rv[SET].w}; \
          _Pragma("unroll") for (int jj_ = 0; jj_ < 4; ++jj_) { \
              *(LAS unsigned short*)(L + O_VT + (vcc * 8 + 2 * jj_) * PS + 16 * ((vs >> 3) ^ sw8(vcc * 8 + 2 * jj_)) + (vs & 7) * 2) = (unsigned short)(pk2(bflo(vw_[jj_]) * kdec, bfhi(vw_[jj_]) * kdec) & 0xffffu); \
              *(LAS unsigned short*)(L + O_VT + (vcc * 8 + 2 * jj_ + 1) * PS + 16 * ((vs >> 3) ^ sw8(vcc * 8 + 2 * jj_ + 1)) + (vs & 7) * 2) = (unsigned short)(pk2(bflo(vw_[jj_]) * kdec, bfhi(vw_[jj_]) * kdec) >> 16); } } } while (0)
        __syncthreads();
        for (int u = tid; u < IMG / 16; u += NWAVES * 64) { const unsigned zu_ = __builtin_bit_cast(unsigned, zf_); *(LAS v4u*)(L + O_ST + u * 16) = (v4u){zu_, zu_, zu_, zu_}; }
#pragma unroll
        for (int u = 0; u < PF; ++u) MX_LOAD(u, u);
        for (int c0 = 0; c0 < NCH; c0 += PF)
#pragma unroll
        for (int u = 0; u < PF; ++u) {
            const int c = c0 + u;
            MX_STAGE(u);
            if (MXP_STG > 1) { asm volatile("" ::: "memory"); MX_STAGE(u); }
            if (HG) {
                MX_BAR();
                const int d = tid & 127, qr = tid >> 7;
                float cl[16], qv[16], kv[16]; float run = 0.f;
#pragma unroll
                for (int ii = 0; ii < 16; ++ii) { const int s = 16 * qr + ii;
                    const int eo = s * QS + 16 * ((d >> 3) ^ sw16(s)) + (d & 7) * 2;
                    run += bflo((unsigned)*(const LAS unsigned short*)(L + 2 * IMG + eo)); cl[ii] = run;
                    qv[ii] = bflo((unsigned)*(const LAS unsigned short*)(L + eo)); kv[ii] = bflo((unsigned)*(const LAS unsigned short*)(L + IMG + eo)); }
                LAS float* tot = (LAS float*)(L + O_TOT);
                tot[qr * 128 + d] = run;
                MX_BAR();
                const float t0 = tot[d], t1 = tot[128 + d], t2 = tot[256 + d], t3 = tot[384 + d];
                const float off = (qr == 0) ? 0.f : (qr == 1) ? t0 : (qr == 2) ? (t0 + t1) : (t0 + t1 + t2);
                const float cref = t0 + t1, cend = (t0 + t1) + (t2 + t3);
                if (qr == 0) tot[512 + d] = cend;
#pragma unroll
                for (int ii = 0; ii < 16; ++ii) { const int s = 16 * qr + ii; const float cm = off + cl[ii]; const int eo = s * QS + 16 * ((d >> 3) ^ sw16(s)) + (d & 7) * 2;
                    const float e1 = __expf(fminf(cm - cref, 80.f)), e2 = __expf(fminf(cref - cm, 80.f)), e3 = __expf(cm), e4 = __expf(cend - cm);
                    const unsigned w12 = pk2(qv[ii] * e1, kv[ii] * e2), w34 = pk2(qv[ii] * e3, kv[ii] * e4);
                    *(LAS unsigned short*)(L + eo) = (unsigned short)(w12 & 0xffffu);
                    *(LAS unsigned short*)(L + IMG + eo) = (unsigned short)(w12 >> 16);
                    *(LAS unsigned short*)(L + 2 * IMG + eo) = (unsigned short)(w34 & 0xffffu);
                    *(LAS unsigned short*)(L + 3 * IMG + eo) = (unsigned short)(w34 >> 16); }
            }
            MX_BAR();
            { const int cn = (c + PF < NCH) ? c + PF : NCH - 1; MX_LOAD(cn, u); }
            if (MXP_SLEEP > 0) __builtin_amdgcn_s_sleep(MXP_SLEEP);
            const int rlo = MX_ROWLO(c);
            const bool do_out = ctx_out || c >= NCTX;
            mx_bf16x8 aq[KS];
            if (do_out) {
#pragma unroll
                for (int ks = 0; ks < KS; ++ks) aq[ks] = frag_row(L, QS, nq0, 32 * ks, lane);
                for (int rep1 = 0; rep1 < MXP_S1; ++rep1) {
                f32x4 pt0 = ZERO4, pt1 = ZERO4;
#pragma unroll
                for (int kb = 0; kb < KS; kb += 4) {
                    mx_bf16x8 kf[2][4];
#pragma unroll
                    for (int ks = 0; ks < 4; ++ks) { kf[0][ks] = frag_row(L + IMG, QS, 32 * cg, 32 * (kb + ks), lane); kf[1][ks] = frag_row(L + IMG, QS, 32 * cg + 16, 32 * (kb + ks), lane); }
                    __builtin_amdgcn_sched_barrier(0);
#pragma unroll
                    for (int ks = 0; ks < 4; ++ks) { pt0 = MX_MFMA(kf[0][ks], aq[kb + ks], pt0); pt1 = MX_MFMA(kf[1][ks], aq[kb + ks], pt1); }
                    __builtin_amdgcn_sched_barrier(0);
                }
                const int m0 = 32 * cg + 4 * g, n = nq0 + i;
                v2u pw; pw.x = pk2((m0 <= n) ? pt0[0] : 0.f, (m0 + 1 <= n) ? pt0[1] : 0.f); pw.y = pk2((m0 + 2 <= n) ? pt0[2] : 0.f, (m0 + 3 <= n) ? pt0[3] : 0.f);
                *(LAS v2u*)(L + O_P + n * PS + 16 * ((m0 >> 3) ^ sw8(n)) + (m0 & 7) * 2) = pw;
                const int m1 = m0 + 16;
                pw.x = pk2((m1 <= n) ? pt1[0] : 0.f, (m1 + 1 <= n) ? pt1[1] : 0.f); pw.y = pk2((m1 + 2 <= n) ? pt1[2] : 0.f, (m1 + 3 <= n) ? pt1[3] : 0.f);
                *(LAS v2u*)(L + O_P + n * PS + 16 * ((m1 >> 3) ^ sw8(n)) + (m1 & 7) * 2) = pw;
                }
            }
            {
                mx_bf16x8 vt[4][2], ak[DT][2]; f32x4 dec[DT];
#pragma unroll
                for (int te = 0; te < 4; ++te) { vt[te][0] = frag_row8(L + O_VT, 16 * te, 0, lane); vt[te][1] = frag_row8(L + O_VT, 16 * te, 32, lane); }
#pragma unroll
                for (int td = 0; td < DT; ++td) { const int d0 = 16 * (DT * w + td);
                    ak[td][0] = frag_tr(L + (HG ? 3 : 1) * IMG, QS, 0, d0, lane); ak[td][1] = frag_tr(L + (HG ? 3 : 1) * IMG, QS, 32, d0, lane);
                    dec[td] = (f32x4){cdec, cdec, cdec, cdec};
                    if (HG) { const f32x4 ce = *(const LAS f32x4*)(L + O_TOT + 2048 + (d0 + 4 * g) * 4); dec[td] = (f32x4){__expf(ce[0]), __expf(ce[1]), __expf(ce[2]), __expf(ce[3])}; } }
                __builtin_amdgcn_sched_barrier(0);
#pragma unroll
                for (int td = 0; td < DT; ++td)
#pragma unroll
                    for (int te = 0; te < 4; ++te) accS[td][te] = MX_MFMA(ak[td][0], vt[te][0], accS[td][te] * dec[td]);
#pragma unroll
                for (int td = 0; td < DT; ++td)
#pragma unroll
                    for (int te = 0; te < 4; ++te) accS[td][te] = MX_MFMA(ak[td][1], vt[te][1], accS[td][te]);
            }
            MX_BAR();
            if (do_out) {
                if (HG) {
#pragma unroll
                    for (int ks = 0; ks < KS; ++ks) aq[ks] = frag_row(L + 2 * IMG, QS, nq0, 32 * ks, lane);
                }
                mx_bf16x8 vo[2][2];
                const mx_bf16x8 bp0 = frag_row8(L + O_P, nq0, 0, lane), bp1 = frag_row8(L + O_P, nq0, 32, lane);
#pragma unroll
                for (int te = 0; te < 2; ++te) { vo[te][0] = frag_row8(L + O_VT, 32 * cg + 16 * te, 0, lane); vo[te][1] = frag_row8(L + O_VT, 32 * cg + 16 * te, 32, lane); }
                const int grow = rlo + (dir ? 63 - (nq0 + i) : (nq0 + i));
                for (int rep2 = 0; rep2 < MXP_S2; ++rep2) {
                f32x4 o1a = ZERO4, o1b = o1a, o2a = o1a, o2b = o1a;
#pragma unroll
                for (int kb = 0; kb < KS; kb += 4) {
                    mx_bf16x8 st[2][4];
#pragma unroll
                    for (int ks = 0; ks < 4; ++ks) { st[0][ks] = frag_row(L + O_ST, QS, 32 * cg, 32 * (kb + ks), lane); st[1][ks] = frag_row(L + O_ST, QS, 32 * cg + 16, 32 * (kb + ks), lane); }
                    __builtin_amdgcn_sched_barrier(0);
                    if (kb == 0) { o1a = MX_MFMA(vo[0][0], bp0, o1a); o1b = MX_MFMA(vo[1][0], bp0, o1b); o1a = MX_MFMA(vo[0][1], bp1, o1a); o1b = MX_MFMA(vo[1][1], bp1, o1b); }
#pragma unroll
                    for (int ks = 0; ks < 4; ++ks) { o2a = MX_MFMA(st[0][ks], aq[kb + ks], o2a); o2b = MX_MFMA(st[1][ks], aq[kb + ks], o2b); }
                    __builtin_amdgcn_sched_barrier(0);
                }
                bf16* op = O + (size_t)grow * D + h * HD + eb * 64 + 32 * cg + 4 * g;
                if (!(VAR & 2)) { const f32x4 ya = o1a * r1 + o2a * r2, yb = o1b * r1 + o2b * r2; v2u wa, wb; wa.x = pk2(ya[0], ya[1]); wa.y = pk2(ya[2], ya[3]); wb.x = pk2(yb[0], yb[1]); wb.y = pk2(yb[2], yb[3]);
                    *(GAS v2u*)(op) = wa; *(GAS v2u*)(op + 16) = wb; }
                else { asm volatile("" :: "v"(o1a), "v"(o1b), "v"(o2a), "v"(o2b)); }
                }
            }
            MX_BAR();
#pragma unroll
            for (int td = 0; td < DT; ++td)
#pragma unroll
                for (int te = 0; te < 4; ++te) { const int d0 = 16 * (DT * w + td); const f32x4 s = accS[td][te];
                    v2u sw; sw.x = pk2(s[0], s[1]); sw.y = pk2(s[2], s[3]);
                    *(LAS v2u*)(L + O_ST + (16 * te + i) * QS + 16 * (((d0 + 4 * g) >> 3) ^ sw16(16 * te + i)) + ((d0 + 4 * g) & 7) * 2) = sw; }
        }
#undef MX_ROWLO
#undef MX_LOAD
#undef MX_STAGE
    }
}

__device__ __forceinline__ void mixer_hg2(const Args& a, Frame& F, bool ctx_out) {
    relaunder(F);
    float zf_ = 0.f; asm volatile("" : "+v"(zf_));
    const f32x4 ZERO4 = {zf_, zf_, zf_, zf_};
    constexpr int HD = 128, NH = 16, NEB = 2, C = 64, NCTX = CTXL / C, NCH = (CTXL + SEQ) / C, KS = HD / 32;
    constexpr int QS = HD * 2 + 16, IMG = 64 * QS, PS = MX_PS;
    constexpr int O_VT = 3 * IMG, O_P = O_VT + 64 * PS, O_ST = O_P + 64 * PS, O_END = O_ST + IMG;
    static_assert(O_END <= RING_BYTES && MX_SWZ == 0, "mixer_hg2 LDS (padded images)");
    const int lane = F.lane, w = F.wave, tid = F.tid, g = lane >> 4, i = lane & 15;
    const int rg = w >> 1, cg = w & 1, nq0 = 16 * rg;
    LAS unsigned char* const L = F.lds;
    const bf16* act = (const bf16*)(a.ws + WS_ACT);
    mx_bf16x8 bt0, bt1;
#pragma unroll
    for (int j = 0; j < 8; ++j) { bt0[j] = (8 * g + j <= i) ? (short)0x3F80 : (short)0; bt1[j] = (8 * g + j <= 16 + i) ? (short)0x3F80 : (short)0; }
    for (int task = F.vcu; task < BATCH * NH * 2 * NEB; task += F.G) {
        const int eb = task % NEB, dir = (task / NEB) & 1, h = (task / (2 * NEB)) % NH, b = task / (2 * NEB * NH);
        bf16* O = (bf16*)(a.ws + (dir ? WS_OB : WS_OF));
        const bf16* src0 = act;
        const bf16* src1 = act + (size_t)(2 + 2 * dir) * ACT_STRIDE;
        const bf16* src2 = act + (size_t)(1 + 2 * dir) * ACT_STRIDE;
        const bf16* srcv = act + (size_t)5 * ACT_STRIDE;
        const int vrow = tid & 63, vcc = tid >> 6, vs = dir ? 63 - vrow : vrow;
        f32x4 accS[4];
#pragma unroll
        for (int te = 0; te < 4; ++te) accS[te] = ZERO4;
        constexpr int PF = MX_PF_HG;
        static_assert(NCH % PF == 0, "prefetch depth must divide the chunk count");
        v4u rq[PF][3][2]; v4u rv[PF];
#define H2_ROWLO(c) (((c) < NCTX) ? (ML + b * CTXL + (dir ? (NCTX - 1 - (c)) : (c)) * C) : (b * SEQ + (dir ? (SEQ / C - 1 - ((c) - NCTX)) : ((c) - NCTX)) * C))
#define H2_LOAD(c, SET) do { const int rlo_ = H2_ROWLO(c); \
        _Pragma("unroll") for (int p_ = 0; p_ < 2; ++p_) { const int pc_ = tid + 512 * p_; const size_t go_ = (size_t)(rlo_ + (pc_ >> 4)) * D + h * HD + (pc_ & 15) * 8; \
            rq[SET][0][p_] = *(const GAS v4u*)(src0 + go_); rq[SET][1][p_] = *(const GAS v4u*)(src1 + go_); rq[SET][2][p_] = *(const GAS v4u*)(src2 + go_); } \
        rv[SET] = *(const GAS v4u*)(srcv + (size_t)(rlo_ + vrow) * D + h * HD + eb * 64 + vcc * 8); } while (0)
#define H2_STAGE(SET) do { \
        _Pragma("unroll") for (int p_ = 0; p_ < 2; ++p_) { const int pc_ = tid + 512 * p_; const int row_ = pc_ >> 4; const int s_ = dir ? 63 - row_ : row_; const int so_ = s_ * QS + (pc_ & 15) * 16; \
            *(LAS v4u*)(L + so_) = rq[SET][0][p_]; *(LAS v4u*)(L + IMG + so_) = rq[SET][1][p_]; *(LAS v4u*)(L + 2 * IMG + so_) = rq[SET][2][p_]; } \
        { const unsigned vw_[4] = {rv[SET].x, rv[SET].y, rv[SET].z, rv[SET].w}; \
          _Pragma("unroll") for (int jj_ = 0; jj_ < 4; ++jj_) { \
              *(LAS unsigned short*)(L + O_VT + (vcc * 8 + 2 * jj_) * PS + vs * 2) = (unsigned short)(vw_[jj_] & 0xffffu); \
              *(LAS unsigned short*)(L + O_VT + (vcc * 8 + 2 * jj_ + 1) * PS + vs * 2) = (unsigned short)(vw_[jj_] >> 16); } } } while (0)
        __syncthreads();
#pragma unroll
        for (int u = 0; u < PF; ++u) H2_LOAD(u, u);
        for (int c0 = 0; c0 < NCH; c0 += PF)
#pragma unroll
        for (int u = 0; u < PF; ++u) {
            const int c = c0 + u;
            H2_STAGE(u);
            MX_BAR();
            { const int cn = (c + PF < NCH) ? c + PF : NCH - 1; H2_LOAD(cn, u); }
            f32x4 fe, fu;
            {
                unsigned one2_ = 0x3F803F80u; asm volatile("" : "+v"(one2_));
                typedef unsigned u4_ __attribute__((ext_vector_type(4)));
                const mx_bf16x8 ones = __builtin_bit_cast(mx_bf16x8, (u4_){one2_, one2_, one2_, one2_});
                const mx_bf16x8 a0 = frag_tr(L + 2 * IMG, QS, 0, 16 * w, lane), a1 = frag_tr(L + 2 * IMG, QS, 32, 16 * w, lane);
                const f32x4 z = ZERO4;
                f32x4 ct[4];
                ct[0] = MX_MFMA(a0, bt0, z); ct[1] = MX_MFMA(a0, bt1, z);
                const f32x4 cref = MX_MFMA(a0, ones, z);
                ct[2] = MX_MFMA(a1, bt0, cref); ct[3] = MX_MFMA(a1, bt1, cref);
                const f32x4 cend = MX_MFMA(a1, ones, cref);
                fe = (f32x4){__expf(cend[0]), __expf(cend[1]), __expf(cend[2]), __expf(cend[3])};
                fu = (f32x4){__expf(cend[0] - cref[0]), __expf(cend[1] - cref[1]), __expf(cend[2] - cref[2]), __expf(cend[3] - cref[3])};
                const f32x4 fs = {__expf(cref[0]), __expf(cref[1]), __expf(cref[2]), __expf(cref[3])};
#pragma unroll
                for (int te = 0; te < 4; ++te) { const f32x4 s = accS[te] * fs; v2u sw; sw.x = pk2(s[0], s[1]); sw.y = pk2(s[2], s[3]);
                    *(LAS v2u*)(L + O_ST + (16 * te + i) * QS + (16 * w + 4 * g) * 2) = sw; }
#pragma unroll
                for (int t = 0; t < 4; ++t) {
                    LAS unsigned char* pq = L + (16 * t + i) * QS + (16 * w + 4 * g) * 2;
                    const v2u qw = *(const LAS v2u*)pq, kw = *(const LAS v2u*)(pq + IMG);
                    f32x4 e1;
#pragma unroll
                    for (int r = 0; r < 4; ++r) e1[r] = __expf(fminf(fmaxf(ct[t][r] - cref[r], -80.f), 80.f));
                    const f32x4 e2 = {__builtin_amdgcn_rcpf(e1[0]), __builtin_amdgcn_rcpf(e1[1]), __builtin_amdgcn_rcpf(e1[2]), __builtin_amdgcn_rcpf(e1[3])};
                    v2u qo, ko;
                    qo.x = pk2(bflo(qw.x) * e1[0], bfhi(qw.x) * e1[1]); qo.y = pk2(bflo(qw.y) * e1[2], bfhi(qw.y) * e1[3]);
                    ko.x = pk2(bflo(kw.x) * e2[0], bfhi(kw.x) * e2[1]); ko.y = pk2(bflo(kw.y) * e2[2], bfhi(kw.y) * e2[3]);
                    *(LAS v2u*)pq = qo; *(LAS v2u*)(pq + IMG) = ko;
                }
            }
            MX_BAR();
            const int rlo = H2_ROWLO(c);
            const bool do_out = ctx_out || c >= NCTX;
            mx_bf16x8 aq[KS];
            {
                mx_bf16x8 kf[2][KS], vt[4][2];
                if (do_out) {
#pragma unroll
                    for (int ks = 0; ks < KS; ++ks) { aq[ks] = frag_row(L, QS, nq0, 32 * ks, lane); kf[0][ks] = frag_row(L + IMG, QS, 32 * cg, 32 * ks, lane); kf[1][ks] = frag_row(L + IMG, QS, 32 * cg + 16, 32 * ks, lane); }
                }
#pragma unroll
                for (int te = 0; te < 4; ++te) { vt[te][0] = frag_row8(L + O_VT, 16 * te, 0, lane); vt[te][1] = frag_row8(L + O_VT, 16 * te, 32, lane); }
                const mx_bf16x8 ak0 = frag_tr(L + IMG, QS, 0, 16 * w, lane), ak1 = frag_tr(L + IMG, QS, 32, 16 * w, lane);
                __builtin_amdgcn_sched_barrier(0);
                f32x4 pt0 = ZERO4, pt1 = ZERO4;
                if (do_out) {
#pragma unroll
                    for (int ks = 0; ks < KS; ++ks) { pt0 = MX_MFMA(kf[0][ks], aq[ks], pt0); pt1 = MX_MFMA(kf[1][ks], aq[ks], pt1); }
                }
                f32x4 uu[4];
#pragma unroll
                for (int te = 0; te < 4; ++te) { const f32x4 z4 = ZERO4; uu[te] = MX_MFMA(ak0, vt[te][0], z4); }
#pragma unroll
                for (int te = 0; te < 4; ++te) uu[te] = MX_MFMA(ak1, vt[te][1], uu[te]);
                __builtin_amdgcn_sched_barrier(0);
                if (do_out) {
                    const int m0 = 32 * cg + 4 * g, m1 = m0 + 16, n = nq0 + i;
                    v2u pw; pw.x = pk2((m0 <= n) ? pt0[0] : 0.f, (m0 + 1 <= n) ? pt0[1] : 0.f); pw.y = pk2((m0 + 2 <= n) ? pt0[2] : 0.f, (m0 + 3 <= n) ? pt0[3] : 0.f);
                    *(LAS v2u*)(L + O_P + n * PS + m0 * 2) = pw;
                    pw.x = pk2((m1 <= n) ? pt1[0] : 0.f, (m1 + 1 <= n) ? pt1[1] : 0.f); pw.y = pk2((m1 + 2 <= n) ? pt1[2] : 0.f, (m1 + 3 <= n) ? pt1[3] : 0.f);
                    *(LAS v2u*)(L + O_P + n * PS + m1 * 2) = pw;
                }
#pragma unroll
                for (int te = 0; te < 4; ++te) accS[te] = accS[te] * fe + uu[te] * fu;
            }
            mx_bf16x8 st[2][KS], vo[2][2];
            if (do_out) {
#pragma unroll
                for (int te = 0; te < 2; ++te)
#pragma unroll
                    for (int ks = 0; ks < KS; ++ks) st[te][ks] = frag_row(L + O_ST, QS, 32 * cg + 16 * te, 32 * ks, lane);
            }
            MX_BAR();
            if (do_out) {
                const mx_bf16x8 bp0 = frag_row8(L + O_P, nq0, 0, lane), bp1 = frag_row8(L + O_P, nq0, 32, lane);
#pragma unroll
                for (int te = 0; te < 2; ++te) { vo[te][0] = frag_row8(L + O_VT, 32 * cg + 16 * te, 0, lane); vo[te][1] = frag_row8(L + O_VT, 32 * cg + 16 * te, 32, lane); }
                __builtin_amdgcn_sched_barrier(0);
                f32x4 oa = ZERO4, ob = oa;
                oa = MX_MFMA(vo[0][0], bp0, oa); ob = MX_MFMA(vo[1][0], bp0, ob);
#pragma unroll
                for (int ks = 0; ks < KS; ++ks) { oa = MX_MFMA(st[0][ks], aq[ks], oa); ob = MX_MFMA(st[1][ks], aq[ks], ob); }
                oa = MX_MFMA(vo[0][1], bp1, oa); ob = MX_MFMA(vo[1][1], bp1, ob);
                bf16* op = O + (size_t)(rlo + (dir ? 63 - (nq0 + i) : (nq0 + i))) * D + h * HD + eb * 64 + 32 * cg + 4 * g;
                v2u wa, wb; wa.x = pk2(oa[0], oa[1]); wa.y = pk2(oa[2], oa[3]); wb.x = pk2(ob[0], ob[1]); wb.y = pk2(ob[2], ob[3]);
                *(GAS v2u*)(op) = wa; *(GAS v2u*)(op + 16) = wb;
            }
            MX_BAR();
        }
#undef H2_ROWLO
#undef H2_LOAD
#undef H2_STAGE
    }
}

__device__ __forceinline__ void mixer_ret3(const Args& a, Frame& F, int j_layer, bool ctx_out) {
    relaunder(F);
    float zf_ = 0.f; asm volatile("" : "+v"(zf_));
    const f32x4 ZERO4 = {zf_, zf_, zf_, zf_};
    constexpr int HD = 256, NH = 8, NEB = 4, C = 64, NCTX = CTXL / C, NCH = (CTXL + SEQ) / C, KS = HD / 32;
    constexpr int QS = HD * 2 + 16, IMG = 64 * QS, PS = MX_PS, VTB = 64 * PS;
    constexpr int O_VT = 2 * IMG, O_P = O_VT + 2 * VTB, O_ST = O_P + VTB, O_END = O_ST + IMG;
    static_assert(O_END <= RING_BYTES && MX_SWZ == 0, "mixer_ret3 LDS (padded images)");
    const int lane = F.lane, w = F.wave, tid = F.tid, g = lane >> 4, i = lane & 15;
    const int rg = w >> 1, cg = w & 1, nq0 = 16 * rg;
    LAS unsigned char* const L = F.lds;
    const bf16* act = (const bf16*)(a.ws + WS_ACT);
    for (int task = F.vcu; task < BATCH * NH * 2 * NEB; task += F.G) {
        const int eb = task % NEB, dir = (task / NEB) & 1, h = (task / (2 * NEB)) % NH, b = task / (2 * NEB * NH);
        bf16* O = (bf16*)(a.ws + (dir ? WS_OB : WS_OF));
        const bf16* src0 = act; const bf16* src1 = act + ACT_STRIDE; const bf16* srcv = act + (size_t)2 * ACT_STRIDE;
        const float x = a.in[10][(j_layer * 2 + dir) * 8 + h];
        const float lg2 = -log1pf(expf(-x)) * 1.4426950408889634f;
        const float r1 = exp2f((float)(nq0 + i - 63) * lg2), r2 = exp2f((float)(nq0 + i + 1) * lg2), cdec = exp2f(64.f * lg2);
        const int vrow = tid & 63, vcc = tid >> 6, vs = dir ? 63 - vrow : vrow;
        const float kdec = exp2f((float)(63 - vs) * lg2);
        f32x4 accS[2][4];
#pragma unroll
        for (int td = 0; td < 2; ++td)
#pragma unroll
            for (int te = 0; te < 4; ++te) accS[td][te] = ZERO4;
        v4u rq[2][4]; v4u rv;
#define R3_ROWLO(c) (((c) < NCTX) ? (ML + b * CTXL + (dir ? (NCTX - 1 - (c)) : (c)) * C) : (b * SEQ + (dir ? (SEQ / C - 1 - ((c) - NCTX)) : ((c) - NCTX)) * C))
#define R3_LOAD(c) do { const int rlo_ = R3_ROWLO(c); \
        _Pragma("unroll") for (int p_ = 0; p_ < 4; ++p_) { const int pc_ = tid + 512 * p_; const size_t go_ = (size_t)(rlo_ + (pc_ >> 5)) * D + h * HD + (pc_ & 31) * 8; \
            rq[0][p_] = *(const GAS v4u*)(src0 + go_); rq[1][p_] = *(const GAS v4u*)(src1 + go_); } \
        rv = *(const GAS v4u*)(srcv + (size_t)(rlo_ + vrow) * D + h * HD + eb * 64 + vcc * 8); } while (0)
#define R3_STAGE(vb) do { \
        _Pragma("unroll") for (int p_ = 0; p_ < 4; ++p_) { const int pc_ = tid + 512 * p_; const int row_ = pc_ >> 5; const int s_ = dir ? 63 - row_ : row_; const int so_ = s_ * QS + (pc_ & 31) * 16; \
            *(LAS v4u*)(L + so_) = rq[0][p_]; *(LAS v4u*)(L + IMG + so_) = rq[1][p_]; } \
        { const unsigned vw_[4] = {rv.x, rv.y, rv.z, rv.w}; \
          _Pragma("unroll") for (int jj_ = 0; jj_ < 4; ++jj_) { const unsigned pw_ = pk2(bflo(vw_[jj_]) * kdec, bfhi(vw_[jj_]) * kdec); \
              *(LAS unsigned short*)(L + O_VT + (vb) * VTB + (vcc * 8 + 2 * jj_) * PS + vs * 2) = (unsigned short)(pw_ & 0xffffu); \
              *(LAS unsigned short*)(L + O_VT + (vb) * VTB + (vcc * 8 + 2 * jj_ + 1) * PS + vs * 2) = (unsigned short)(pw_ >> 16); } } } while (0)
        __syncthreads();
        { const unsigned zu_ = __builtin_bit_cast(unsigned, zf_); for (int u = tid; u < IMG / 16; u += NWAVES * 64) *(LAS v4u*)(L + O_ST + u * 16) = (v4u){zu_, zu_, zu_, zu_}; }
        R3_LOAD(0);
        R3_STAGE(0);
        R3_LOAD(1);
        MX_BAR();
        for (int c = 0; c < NCH; ++c) {
            const int vb = c & 1;
            LAS unsigned char* const Vc = L + O_VT + vb * VTB;
            const int rlo = R3_ROWLO(c);
            const bool do_out = ctx_out || c >= NCTX;
            if (c > 0) {
#pragma unroll
                for (int td = 0; td < 2; ++td)
#pragma unroll
                    for (int te = 0; te < 4; ++te) { const int d0 = 16 * (2 * w + td); const f32x4 s = accS[td][te];
                        v2u sw; sw.x = pk2(s[0], s[1]); sw.y = pk2(s[2], s[3]);
                        *(LAS v2u*)(L + O_ST + (16 * te + i) * QS + (d0 + 4 * g) * 2) = sw; }
            }
            mx_bf16x8 aq[KS];
            if (do_out) {
#pragma unroll
                for (int ks = 0; ks < KS; ++ks) aq[ks] = frag_row(L, QS, nq0, 32 * ks, lane);
                f32x4 pt0 = ZERO4, pt1 = ZERO4;
#pragma unroll
                for (int kb = 0; kb < KS; kb += 4) {
                    mx_bf16x8 kf[2][4];
#pragma unroll
                    for (int ks = 0; ks < 4; ++ks) { kf[0][ks] = frag_row(L + IMG, QS, 32 * cg, 32 * (kb + ks), lane); kf[1][ks] = frag_row(L + IMG, QS, 32 * cg + 16, 32 * (kb + ks), lane); }
                    __builtin_amdgcn_sched_barrier(0);
#pragma unroll
                    for (int ks = 0; ks < 4; ++ks) { pt0 = MX_MFMA(kf[0][ks], aq[kb + ks], pt0); pt1 = MX_MFMA(kf[1][ks], aq[kb + ks], pt1); }
                    __builtin_amdgcn_sched_barrier(0);
                }
                const int m0 = 32 * cg + 4 * g, m1 = m0 + 16, n = nq0 + i;
                v2u pw; pw.x = pk2((m0 <= n) ? pt0[0] : 0.f, (m0 + 1 <= n) ? pt0[1] : 0.f); pw.y = pk2((m0 + 2 <= n) ? pt0[2] : 0.f, (m0 + 3 <= n) ? pt0[3] : 0.f);
                *(LAS v2u*)(L + O_P + n * PS + m0 * 2) = pw;
                pw.x = pk2((m1 <= n) ? pt1[0] : 0.f, (m1 + 1 <= n) ? pt1[1] : 0.f); pw.y = pk2((m1 + 2 <= n) ? pt1[2] : 0.f, (m1 + 3 <= n) ? pt1[3] : 0.f);
                *(LAS v2u*)(L + O_P + n * PS + m1 * 2) = pw;
            }
            {
                mx_bf16x8 vt[4][2], ak[2][2];
#pragma unroll
                for (int te = 0; te < 4; ++te) { vt[te][0] = frag_row8(Vc, 16 * te, 0, lane); vt[te][1] = frag_row8(Vc, 16 * te, 32, lane); }
#pragma unroll
                for (int td = 0; td < 2; ++td) { ak[td][0] = frag_tr(L + IMG, QS, 0, 16 * (2 * w + td), lane); ak[td][1] = frag_tr(L + IMG, QS, 32, 16 * (2 * w + td), lane); }
                __builtin_amdgcn_sched_barrier(0);
#pragma unroll
                for (int td = 0; td < 2; ++td)
#pragma unroll
                    for (int te = 0; te < 4; ++te) accS[td][te] = MX_MFMA(ak[td][0], vt[te][0], accS[td][te] * cdec);
#pragma unroll
                for (int td = 0; td < 2; ++td)
#pragma unroll
                    for (int te = 0; te < 4; ++te) accS[td][te] = MX_MFMA(ak[td][1], vt[te][1], accS[td][te]);
            }
            MX_BAR();
            if (do_out) {
                mx_bf16x8 vo[2][2];
                const mx_bf16x8 bp0 = frag_row8(L + O_P, nq0, 0, lane), bp1 = frag_row8(L + O_P, nq0, 32, lane);
#pragma unroll
                for (int te = 0; te < 2; ++te) { vo[te][0] = frag_row8(Vc, 32 * cg + 16 * te, 0, lane); vo[te][1] = frag_row8(Vc, 32 * cg + 16 * te, 32, lane); }
                f32x4 o1a = ZERO4, o1b = ZERO4, o2a = ZERO4, o2b = ZERO4;
#pragma unroll
                for (int kb = 0; kb < KS; kb += 4) {
                    mx_bf16x8 st[2][4];
#pragma unroll
                    for (int ks = 0; ks < 4; ++ks) { st[0][ks] = frag_row(L + O_ST, QS, 32 * cg, 32 * (kb + ks), lane); st[1][ks] = frag_row(L + O_ST, QS, 32 * cg + 16, 32 * (kb + ks), lane); }
                    __builtin_amdgcn_sched_barrier(0);
                    if (kb == 0) { o1a = MX_MFMA(vo[0][0], bp0, o1a); o1b = MX_MFMA(vo[1][0], bp0, o1b); o1a = MX_MFMA(vo[0][1], bp1, o1a); o1b = MX_MFMA(vo[1][1], bp1, o1b); }
#pragma unroll
                    for (int ks = 0; ks < 4; ++ks) { o2a = MX_MFMA(st[0][ks], aq[kb + ks], o2a); o2b = MX_MFMA(st[1][ks], aq[kb + ks], o2b); }
                    __builtin_amdgcn_sched_barrier(0);
                }
                bf16* op = O + (size_t)(rlo + (dir ? 63 - (nq0 + i) : (nq0 + i))) * D + h * HD + eb * 64 + 32 * cg + 4 * g;
                const f32x4 ya = o1a * r1 + o2a * r2, yb = o1b * r1 + o2b * r2; v2u wa, wb; wa.x = pk2(ya[0], ya[1]); wa.y = pk2(ya[2], ya[3]); wb.x = pk2(yb[0], yb[1]); wb.y = pk2(yb[2], yb[3]);
                *(GAS v2u*)(op) = wa; *(GAS v2u*)(op + 16) = wb;
            }
            if (c + 1 < NCH) R3_STAGE(vb ^ 1);
            { const int cn = (c + 2 < NCH) ? c + 2 : NCH - 1; R3_LOAD(cn); }
            MX_BAR();
        }
#undef R3_ROWLO
#undef R3_LOAD
#undef R3_STAGE
    }
}
#ifndef MIX_MFMA_RET
#define MIX_MFMA_RET 1
#endif
#ifndef MIX_RET_V3
#define MIX_RET_V3 0
#endif
#ifndef MIX_HG_V2
#define MIX_HG_V2 1
#endif
#ifndef MIX_MFMA_HG
#define MIX_MFMA_HG 1
#endif
#ifndef REP_NORM
#define REP_NORM 1
#endif
#ifndef REP_GEMM_IN
#define REP_GEMM_IN 1
#endif
#ifndef REP_MIX_RET
#define REP_MIX_RET 1
#endif
#ifndef REP_MIX_HG
#define REP_MIX_HG 1
#endif
#ifndef REP_READ
#define REP_READ 1
#endif
#ifndef REP_GU
#define REP_GU 1
#endif
__global__ void __launch_bounds__(NWAVES * 64, 2) fwd_kernel(Args args_in) {
    const Args& args = args_in;
    extern __shared__ __attribute__((aligned(16))) unsigned char lds[];
    Frame F;
    F.lds = (LAS unsigned char*)lds;
    volatile LAS unsigned* MISC = (volatile LAS unsigned*)(F.lds + MISC_OFF);
    F.tid = threadIdx.x; F.lane = F.tid & 63; F.wave = __builtin_amdgcn_readfirstlane(F.tid >> 6);
    F.G = gridDim.x; { const int bx = blockIdx.x; F.vcu = (F.G % 8 == 0) ? (bx % 8) * (F.G / 8) + bx / 8 : bx; }
    unsigned char* ws = args.ws;
    F.ctl = (gu32*)(ws + WS_CTL);
    for (int u = F.tid; u < (LDS_BYTES - LDSCTL_OFF) / 4; u += NWAVES * 64) ((LAS unsigned*)(F.lds + LDSCTL_OFF))[u] = 0u;
    __syncthreads();
    if (F.lane == 0) *(volatile LAS unsigned*)(F.lds + TIDTAB_OFF + 4 * mk_hwkey()) = (unsigned)F.wave;
    XcdBarrier bar; bar.bar = (unsigned*)(F.ctl + CW_BAR); bar.x = 0; bar.st = nullptr;
    if (MK_N_LAUNCHES == 1) bar = xcd_barrier_post((unsigned*)(F.ctl + CW_BAR), MISC + 8);
    const int lo = args.ph_lo, hi = args.ph_hi;
#define IN(k) (lo <= (k) && (k) < hi)
#define SEAM(k) do { if (IN(k) && IN((k) + 1)) { XcdBarrier b_ = bar; asm volatile("" : "+s"(b_.bar), "+s"(b_.x));     \
        xcd_barrier(b_); if (REP_BAR > 1) xcd_barrier(b_); } } while (0)
    if (IN(0)) { p0_prologue(args, F); }
    SEAM(0);
    if (IN(1)) { p1_modreduce(args, F); }
    SEAM(1);

    for (int layer = 0; layer < DEPTH; ++layer) {
        asm volatile("" : "+s"(ws));
        const Args* kap = (const Args*)__builtin_amdgcn_kernarg_segment_ptr(); asm volatile("" : "+s"(kap));
        const Args& args = *kap;
        const float* MOD = (const float*)(ws + WS_MOD);
        const float* TAB = (const float*)(ws + WS_TAB);
        bf16* X = (bf16*)(ws + WS_X);
        bf16* HN = (bf16*)(ws + WS_HN);
        bf16* ACT = (bf16*)(ws + WS_ACT);
        const int pb = 2 + 8 * layer;
        const bool last = (layer == DEPTH - 1), hg = (layer & 1) != 0;
        const int j = layer >> 1;
        const int Mr = last ? ML : M;
        const bool tc = TAIL_CONVERT != 0 && !last && F.G == 256 && MK_N_LAUNCHES == 1;
        const int tc_slot = ((int)blockIdx.x & 7) * 32 + ((int)blockIdx.x >> 3);
        const int tc_rem1 = (hg ? (M / 256) * 40 : (M / 256) * 32) % 256, tc_idle1 = 256 - tc_rem1;
        const float* modl = MOD + (size_t)layer * 5 * MOD_LD;
        unsigned char* wb = ws + WS_W + (size_t)layer * W_LAYER;
        if (IN(pb + 0)) NORM_FN(args, F, args.in[6] + (size_t)layer * D, modl, 0, D, M, layer > 0 ? (modl - 5 * MOD_LD) + 4 * MOD_LD + 5 * D : nullptr);
        SEAM(pb + 0);
        if (!hg) {
            if (IN(pb + 1)) {
                pg8::Gemm g{HN, (const bf16*)(wb + W_IN), M, 4 * D, D, D, D}; pg8::StaticOrder S; S.init(M, 4 * D, F.G, (int)blockIdx.x);
                pg8::EpiRetIn E{ACT, ACT_STRIDE, TAB + TAB_COS / 4, TAB + TAB_SIN / 4, NLP};
                for (int rep = 0; rep < REP_GEMM_IN; ++rep) pg8::gemm_phase<pg8::EpiRetIn, pg8::StaticOrder, GEMM_ALIGN, GEMM_SP2>(F.lds, g, S, E);
                if (tc && tc_slot >= tc_rem1) tail_convert(args, F, layer + 1, 1, tc_slot - tc_rem1, tc_idle1, tc_idle1);
            }
            SEAM(pb + 1);
            if (IN(pb + 2)) for (int rep = 0; rep < REP_MIX_RET; ++rep) { if (MIX_RET_V3) mixer_ret3(args, F, j, !last); else if (MIX_MFMA_RET) mixer_mfma<false>(args, F, j, !last); else mixer_phase<false>(args, F, j, !last); if (MXV_RET) mixer_mfma<false, MXV_RET>(args, F, j, !last); }
            SEAM(pb + 2);
            if (IN(pb + 3)) for (int rep = 0; rep < REP_READ; ++rep) { if (NORM_PIPE && F.G == 256) readout_phase2<false>(args, F, nullptr, Mr); else readout_phase<false>(args, F, nullptr, Mr); }
            SEAM(pb + 3);
        } else {
            if (IN(pb + 1)) {
                pg8::Gemm g{HN, (const bf16*)(wb + W_IN), M, 5 * D, D, D, D}; pg8::StaticOrder S; S.init(M, 5 * D, F.G, (int)blockIdx.x);
                pg8::EpiHgIn E{ACT, ACT_STRIDE, TAB + TAB_LB / 4 + (size_t)j * D};
                for (int rep = 0; rep < REP_GEMM_IN; ++rep) pg8::gemm_phase<pg8::EpiHgIn, pg8::StaticOrder, GEMM_ALIGN, GEMM_SP2>(F.lds, g, S, E);
                if (tc && tc_slot >= tc_rem1) tail_convert(args, F, layer + 1, 1, tc_slot - tc_rem1, tc_idle1, tc_idle1);
            }
            SEAM(pb + 1);
            if (IN(pb + 2)) for (int rep = 0; rep < REP_MIX_HG; ++rep) { if (MIX_HG_V2) mixer_hg2(args, F, !last); else if (MIX_MFMA_HG) mixer_mfma<true>(args, F, j, !last); else mixer_phase<true>(args, F, j, !last); if (MXV_HG) mixer_mfma<true, MXV_HG>(args, F, j, !last); }
            SEAM(pb + 2);
            if (IN(pb + 3)) for (int rep = 0; rep < REP_READ; ++rep) { if (NORM_PIPE && F.G == 256) readout_phase2<true>(args, F, args.in[13] + (size_t)j * D, Mr); else readout_phase<true>(args, F, args.in[13] + (size_t)j * D, Mr); }
            SEAM(pb + 3);
        }
        if (IN(pb + 4)) {
            pg8::Gemm g{HN, (const bf16*)(wb + W_OUT), ML, D, D, D, D}; pg8::StaticOrder S; S.init(ML, D, F.G, (int)blockIdx.x);
            pg8::EpiResid E{X, modl + 2 * D, MOD_LD, NLP};
            pg8::gemm_phase<pg8::EpiResid, pg8::StaticOrder, RESID_ALIGN, GEMM_SP2>(F.lds, g, S, E);
            if (!last) {
                pg8::Gemm g2{HN, (const bf16*)(wb + W_OUT), M, D, D / 4, D, D}; pg8::SplitKOrder S2{F.G, (int)blockIdx.x, NLP, D / 4};
                pg8::EpiSlab E2{(float*)(ws + WS_SLAB), NLP, D / 4, (size_t)MC * D};
                pg8::gemm_phase<pg8::EpiSlab, pg8::SplitKOrder, true, true>(F.lds, g2, S2, E2);
                if (tc && (int)blockIdx.x >= 128) tail_convert(args, F, layer + 1, 2, (int)blockIdx.x - 128, 128, tc_idle1);
            }
        }
        SEAM(pb + 4);
        if (IN(pb + 5)) NORM_FN(args, F, args.in[7] + (size_t)layer * D, modl, 3 * D, 4 * D, Mr, last ? nullptr : modl + 4 * MOD_LD + 2 * D);
        SEAM(pb + 5);
        if (IN(pb + 6)) {
            pg8::Gemm g{HN, (const bf16*)(wb + W_GU), Mr, 2 * FF, D, D, D}; pg8::StaticOrder S; S.init(Mr, 2 * FF, F.G, (int)blockIdx.x, GU_WGM);
            if (KPROBE_GU) { pg8::TwiceOrder S2; S2.init(Mr, 2 * FF, F.G, (int)blockIdx.x); pg8::EpiGateUp E{ACT, FF, 0.5f}; pg8::gemm_phase<pg8::EpiGateUp, pg8::TwiceOrder, true, true>(F.lds, g, S2, E); }
            else { pg8::EpiGateUp E{ACT, FF, 1.0f};
            for (int rep = 0; rep < REP_GU; ++rep) pg8::gemm_phase<pg8::EpiGateUp, pg8::StaticOrder, GEMM_ALIGN, GEMM_SP2>(F.lds, g, S, E); }
            if (tc && tc_slot >= 176) tail_convert(args, F, layer + 1, 3, tc_slot - 176, 80, tc_idle1);
        }
        SEAM(pb + 6);
        if (IN(pb + 7)) {
            pg8::Gemm g{ACT, (const bf16*)(wb + W_DN), ML, D, FF, FF, FF}; pg8::StaticOrder S; S.init(ML, D, F.G, (int)blockIdx.x);
            pg8::EpiResid E{X, modl + 5 * D, MOD_LD, NLP};
            pg8::gemm_phase<pg8::EpiResid, pg8::StaticOrder, RESID_ALIGN, GEMM_SP2>(F.lds, g, S, E);
            if (!last) {
                pg8::Gemm g2{ACT, (const bf16*)(wb + W_DN), M, D, FF / 4, FF, FF}; pg8::SplitKOrder S2{F.G, (int)blockIdx.x, NLP, FF / 4};
                pg8::EpiSlab E2{(float*)(ws + WS_SLAB), NLP, FF / 4, (size_t)MC * D};
                pg8::gemm_phase<pg8::EpiSlab, pg8::SplitKOrder, true, true>(F.lds, g2, S2, E2);
                if (tc && (int)blockIdx.x >= 128) tail_convert(args, F, layer + 1, 4, (int)blockIdx.x - 128, 128, tc_idle1);
            }
        }
        SEAM(pb + 7);
    }
    if (IN(N_PHASES - 1)) { if (NORM_PIPE && F.G == 256) final_norm_phase2(args, F); else final_norm_phase(args, F); }
#undef IN
#undef SEAM
}

extern "C" void kernel_launch(void* const* d_in, const int* in_sizes, int n_in, void* d_out, int out_size, void* d_ws, size_t ws_size, hipStream_t stream) {
    static int grid = 0;
    if (grid == 0) {
        if (n_in != 18 || in_sizes[0] != ML * D || out_size != ML * D || ws_size < WS_END) { fprintf(stderr, "kernel_launch: unexpected shapes (n_in %d, in0 %d, out %d, ws %zu < %zu); nothing launched\n", n_in, n_in > 0 ? in_sizes[0] : -1, out_size, ws_size, (size_t)WS_END); grid = -1; return; }
        int dev = 0, cus = 0, per_cu = 0;
        if (hipGetDevice(&dev) != hipSuccess || hipDeviceGetAttribute(&cus, hipDeviceAttributeMultiprocessorCount, dev) != hipSuccess) { grid = -1; return; }
        if (hipFuncSetAttribute((const void*)fwd_kernel, hipFuncAttributeMaxDynamicSharedMemorySize, LDS_BYTES) != hipSuccess) { fprintf(stderr, "kernel_launch: hipFuncSetAttribute failed\n"); grid = -1; return; }
        if (hipOccupancyMaxActiveBlocksPerMultiprocessor(&per_cu, (const void*)fwd_kernel, NWAVES * 64, LDS_BYTES) != hipSuccess || per_cu < 1) { fprintf(stderr, "kernel_launch: occupancy query says %d blocks per CU\n", per_cu); (void)hipGetLastError(); grid = -1; return; }
        grid = cus;
    }
    if (grid < 0) return;
    if (hipMemsetAsync((char*)d_ws, 0, ZERO_BYTES, stream) != hipSuccess) return;
    Args a{};
    for (int i = 0; i < 18; ++i) a.in[i] = (const float*)d_in[i];
    a.out = (float*)d_out; a.ws = (unsigned char*)d_ws;
    if (MK_N_LAUNCHES == 1) {
        a.ph_lo = 0; a.ph_hi = N_PHASES;
        hipLaunchKernelGGL(fwd_kernel, dim3(grid), dim3(NWAVES * 64), LDS_BYTES, stream, a);
    } else {
        for (int p = 0; p < N_PHASES; ++p) { a.ph_lo = p; a.ph_hi = p + 1; hipLaunchKernelGGL(fwd_kernel, dim3(grid), dim3(NWAVES * 64), LDS_BYTES, stream, a); }
    }
}
```

```cpp
#include <hip/hip_runtime.h>
#include <cstdio>
#include <cstdint>
#ifndef REP_EPI
#define REP_EPI 1
#endif
#ifndef REP_PRO
#define REP_PRO 1
#endif
#ifndef REP_BAR
#define REP_BAR 1
#endif
#ifndef RESID_ATOMIC
#define RESID_ATOMIC 1
#endif
#ifndef REP_RESID
#define REP_RESID 1
#endif
#ifndef MXP_STG
#define MXP_STG 1
#endif
#ifndef MXP_S1
#define MXP_S1 1
#endif
#ifndef MXP_S2
#define MXP_S2 1
#endif
#ifndef MX_PF_HG
#define MX_PF_HG 1
#endif
#ifndef MX_PF_RET
#define MX_PF_RET 1
#endif
#ifndef MXP_SLEEP
#define MXP_SLEEP 0
#endif
#ifndef MXP_BAR
#define MXP_BAR 1
#endif
#ifndef MXV_RET
#define MXV_RET 0
#endif
#ifndef MXV_HG
#define MXV_HG 0
#endif
#ifndef REP_BIAS
#define REP_BIAS 1
#endif
#ifndef KPROBE_GU
#define KPROBE_GU 0
#endif
#ifndef STEAL_TICKS_UNIT
#define STEAL_TICKS_UNIT 4000u
#endif
#ifndef STEAL_TICKS_OUT
#define STEAL_TICKS_OUT 900u
#endif
#ifndef STEAL_TICKS_DOWN
#define STEAL_TICKS_DOWN 2800u
#endif
#ifndef STEAL_BATCH
#define STEAL_BATCH 4
#endif
#ifndef RESID_ALIGN
#define RESID_ALIGN false
#endif
#ifndef GEMM_ALIGN
#define GEMM_ALIGN true
#endif
#ifndef PG8_WGM
#define PG8_WGM 4
#endif
#ifndef GEMM_SP2
#define GEMM_SP2 true
#endif
#ifndef PG8_ROUND_MAJOR
#define PG8_ROUND_MAJOR 1
#endif
#ifndef PRO_NT
#define PRO_NT 1
#endif
#ifndef WT_STORES
#define WT_STORES 0
#endif
#ifndef GU_WGM
#define GU_WGM 8
#endif
#ifndef EW_NT
#define EW_NT 1
#endif
#ifndef EPI_NT
#define EPI_NT 0
#endif
#ifndef RESID_NT
#define RESID_NT 0
#endif
#ifndef ST16_GLOBAL
#define ST16_GLOBAL 1
#endif
#ifndef TAIL_CONVERT
#define TAIL_CONVERT 1
#endif
#ifndef WT_NT_ST
#define WT_NT_ST 1
#endif
#ifndef EPI_DRAIN_OVERLAP
#define EPI_DRAIN_OVERLAP 1
#endif
#ifndef XRES_F16
#define XRES_F16 1
#endif
#ifndef NORM_PIPE
#define NORM_PIPE 1
#endif

#define TIDTAB_OFF 132416
#define MK_LAS __attribute__((address_space(3)))
__device__ __forceinline__ unsigned mk_hwkey() { unsigned hw; asm volatile("s_getreg_b32 %0, hwreg(HW_REG_HW_ID, 0, 6)" : "=s"(hw)); return hw; }
__device__ __forceinline__ int mk_wave() {
    extern __shared__ __attribute__((aligned(16))) unsigned char lds[];
    const unsigned hw = mk_hwkey();
    return __builtin_amdgcn_readfirstlane((int)*(volatile MK_LAS unsigned*)((MK_LAS unsigned char*)lds + TIDTAB_OFF + 4 * hw));
}
__device__ __forceinline__ int mk_lane() { int l; asm volatile("v_mbcnt_lo_u32_b32 %0, -1, 0\n\tv_mbcnt_hi_u32_b32 %0, -1, %0" : "=v"(l)); return l; }
__device__ __forceinline__ int mk_tid() { return mk_wave() * 64 + mk_lane(); }
namespace pg8 {
#define PG8_LAS __attribute__((address_space(3)))
typedef unsigned short bf16_t;
typedef short bf16x8 __attribute__((ext_vector_type(8)));
typedef float f32x4 __attribute__((ext_vector_type(4)));
typedef unsigned u32x4 __attribute__((ext_vector_type(4)));
constexpr int BM = 256, BK = 64, HALF = 128, HTB = HALF * BK * 2  , STAGE_BYTES = 8 * HTB, NXCD = 8, WGM = PG8_WGM;

__host__ __device__ __forceinline__ int lds_byte(int r, int c) { const int st = (r >> 4) * 2 + (c >> 5), rr = r & 15, cc = c & 31, ob = rr * 64 + cc * 2; return st * 1024 + (ob ^ (((ob >> 9) & 1) << 5)); }
__host__ __device__ __forceinline__ void stage_rc(int b, int& R, int& C) { const int st = b / 1024, sb = b % 1024, swz = sb ^ (((sb >> 9) & 1) << 5); R = (st >> 1) * 16 + swz / 64; C = (st & 1) * 32 + (swz % 64) / 2; }
__host__ __device__ __forceinline__ int perm32(int rho) { const int n = rho >> 4, i = rho & 15; return 8 * (i >> 2) + 4 * n + (i & 3); }

struct Unit { int pm, pn, k0; };
struct Gemm { const bf16_t* A; const bf16_t* Bt; int M, N, K, lda, ldb; };

struct StaticOrder {
    static constexpr bool KTWICE = false;
    int nM, nN, nwg, G, c, wgm;
    __host__ __device__ void init(int M, int N, int G_, int c_, int wgm_ = WGM) { nM = M / BM; nN = N / BM; nwg = nM * nN; G = G_; c = c_; wgm = wgm_; }
    __host__ __device__ bool next(int i, Unit& u) const {
        const long L = (long)i * G + c; if (!(PG8_ROUND_MAJOR && G % NXCD == 0) && L >= nwg) return false; if ((long)i * G >= nwg) return false;
        int wgid = (int)L;
        if (PG8_ROUND_MAJOR && G % NXCD == 0) { const int per = G / NXCD; wgid = ((i * NXCD) + (c % NXCD)) * per + (c / NXCD); if (wgid >= nwg) return false; }
        else { const int q = nwg / NXCD, r = nwg % NXCD, xcd = wgid % NXCD, off = wgid / NXCD; wgid = (xcd < r ? xcd * (q + 1) : r * (q + 1) + (xcd - r) * q) + off; }
        const int nig = wgm * nN, gid = wgid / nig, fm = gid * wgm, gsz = (nM - fm) < wgm ? (nM - fm) : wgm;
        u.pm = fm + ((wgid % nig) % gsz); u.pn = (wgid % nig) / gsz; u.k0 = 0; return true;
    }
    __device__ __forceinline__ void a_ready(const Unit&) const {}
    __device__ __forceinline__ void done(const Unit&) const {}
};
struct TwiceOrder : StaticOrder {
    static constexpr bool KTWICE = true;
    __host__ __device__ bool next(int i, Unit& u) const { return StaticOrder::next(i >> 1, u); }
};
struct SplitKOrder {
    static constexpr bool KTWICE = false;
    int G, c, pm0, ksub;
    __device__ __forceinline__ bool next(int i, Unit& u) const { const int s = i * G + c; if (s >= 128) return false; const int t = s >> 2; u.pm = pm0 + (t & 3); u.pn = t >> 2; u.k0 = (s & 3) * ksub; return true; }
    __device__ __forceinline__ void a_ready(const Unit&) const {}
    __device__ __forceinline__ void done(const Unit&) const {}
};
__device__ __forceinline__ unsigned cvt_pk_bf16(float lo, float hi) { unsigned r; asm volatile("v_cvt_pk_bf16_f32 %0, %1, %2" : "=v"(r) : "v"(lo), "v"(hi)); return r; }
#define PG8_GAS __attribute__((address_space(1)))
#if ST16_GLOBAL
#define ST16_AS PG8_GAS
#else
#define ST16_AS
#endif
__device__ __forceinline__ float fast_sigmoid(float x) { return __builtin_amdgcn_rcpf(1.0f + __expf(-x)); }
__device__ __forceinline__ f32x4 sigm4(f32x4 v) { const f32x4 t = v * -1.4426950408889634f; f32x4 e = {__builtin_amdgcn_exp2f(t[0]), __builtin_amdgcn_exp2f(t[1]), __builtin_amdgcn_exp2f(t[2]), __builtin_amdgcn_exp2f(t[3])};
    e = e + 1.0f; return (f32x4){__builtin_amdgcn_rcpf(e[0]), __builtin_amdgcn_rcpf(e[1]), __builtin_amdgcn_rcpf(e[2]), __builtin_amdgcn_rcpf(e[3])}; }
__device__ __forceinline__ f32x4 silu4(f32x4 v) { return v * sigm4(v); }
__device__ __forceinline__ void hg_gate4(f32x4& z, f32x4& key, const f32x4 l) {
    const f32x4 zc = {__builtin_amdgcn_fmed3f(z[0], -80.f, 80.f), __builtin_amdgcn_fmed3f(z[1], -80.f, 80.f), __builtin_amdgcn_fmed3f(z[2], -80.f, 80.f), __builtin_amdgcn_fmed3f(z[3], -80.f, 80.f)};
    const f32x4 t = zc * -1.4426950408889634f;
    const f32x4 e = {__builtin_amdgcn_exp2f(t[0]), __builtin_amdgcn_exp2f(t[1]), __builtin_amdgcn_exp2f(t[2]), __builtin_amdgcn_exp2f(t[3])};
    const f32x4 den = e + 1.0f;
    const f32x4 sg = {__builtin_amdgcn_rcpf(den[0]), __builtin_amdgcn_rcpf(den[1]), __builtin_amdgcn_rcpf(den[2]), __builtin_amdgcn_rcpf(den[3])};
    const f32x4 oml = 1.0f - l;
    const f32x4 f = l + oml * sg;
    z = (f32x4){__builtin_amdgcn_logf(f[0]), __builtin_amdgcn_logf(f[1]), __builtin_amdgcn_logf(f[2]), __builtin_amdgcn_logf(f[3])} * 0.6931471805599453f;
    key = oml * (e * sg);
}
template <typename T> __device__ __forceinline__ void st16(T* base, unsigned elem_off, u32x4 v) {
#if WT_STORES
    const __amdgpu_buffer_rsrc_t r = __builtin_amdgcn_make_buffer_rsrc(base, 0, 0x7fffffff, 0x00020000);
    __builtin_amdgcn_raw_buffer_store_b128(v, r, (int)(elem_off * sizeof(T)), 0, 16);
#elif EPI_NT
    __builtin_nontemporal_store(v, (u32x4*)(base + elem_off));
#else
    *(ST16_AS u32x4*)((ST16_AS char*)base + (size_t)(elem_off * (unsigned)sizeof(T))) = v;
#endif
}
__device__ __forceinline__ u32x4 pack8(f32x4 v0, f32x4 v1) { u32x4 w; w.x = cvt_pk_bf16(v0[0], v0[1]); w.y = cvt_pk_bf16(v0[2], v0[3]); w.z = cvt_pk_bf16(v1[0], v1[1]); w.w = cvt_pk_bf16(v1[2], v1[3]); return w; }

struct EpiRetIn {
    static constexpr bool PERM = true, AFTER_DRAIN = false, REP2 = false;
    static constexpr bool DRAIN_OK = true;
    static constexpr int NVM = 16;
    bf16_t* act; size_t tstride; const float* cosT; const float* sinT; int n_lat_panels;
    __device__ __forceinline__ void store_rows(const f32x4& a0, const f32x4& a1, const f32x4& b0, const f32x4& b1, int type, bf16_t* base, size_t off) const {
        f32x4 x0 = a0, x1 = a1, y0 = b0, y1 = b1;
        if (type == 1) { x0 = x0 * 0.0625f; x1 = x1 * 0.0625f; y0 = y0 * 0.0625f; y1 = y1 * 0.0625f; }
        if (type == 3) { x0 = silu4(x0); x1 = silu4(x1); y0 = silu4(y0); y1 = silu4(y1); }
        st16(base, off, pack8(x0, x1));
        st16(base, off + HALF, pack8(y0, y1));
    }
    __device__ __forceinline__ void operator()(const f32x4 (&acc)[2][2][4][2], const Unit& u, int wr, int wc, int fr_in, int fq_in) const {
        int fr = fr_in, fq = fq_in; asm volatile("" : "+v"(fr), "+v"(fq));
        const int type = u.pn >> 3, head = u.pn & 7;
        bf16_t* base = act + (size_t)type * tstride; const size_t coff = head * 256 + wc * 32 + 8 * fq;
        const int row0 = u.pm * BM + wr * 64 + fr;
        const bool rope = (type < 2) && (u.pm < n_lat_panels);
        const int fidx = (wc & 1) * 32 + 8 * fq;
        if (!rope) {
#pragma unroll
            for (int ai = 0; ai < 2; ++ai)
#pragma unroll
                for (int m = 0; m < 4; ++m) store_rows(acc[ai][0][m][0], acc[ai][0][m][1], acc[ai][1][m][0], acc[ai][1][m][1], type, base, (size_t)(row0 + ai * HALF + m * 16) * 2048 + coff);
        } else if (wc < 2) {
#pragma unroll
            for (int ai = 0; ai < 2; ++ai) {
                const int pos = (4 * u.pm + 2 * ai + wr) & 63;
                const f32x4 c0 = *(const PG8_GAS f32x4*)(cosT + pos * 64 + fidx), c1 = *(const PG8_GAS f32x4*)(cosT + pos * 64 + fidx + 4), s0 = *(const PG8_GAS f32x4*)(sinT + pos * 64 + fidx), s1 = *(const PG8_GAS f32x4*)(sinT + pos * 64 + fidx + 4);
#pragma unroll
                for (int m = 0; m < 4; ++m) { const f32x4 a0 = acc[ai][0][m][0], a1 = acc[ai][0][m][1], b0 = acc[ai][1][m][0], b1 = acc[ai][1][m][1];
                    store_rows(a0 * c0 - b0 * s0, a1 * c1 - b1 * s1, a0 * s0 + b0 * c0, a1 * s1 + b1 * c1, type, base, (size_t)(row0 + ai * HALF + m * 16) * 2048 + coff); }
            }
        } else {
#pragma unroll
            for (int m = 0; m < 4; ++m) {
                const int pos = 16 * m + fr;
                const f32x4 c0 = *(const PG8_GAS f32x4*)(cosT + pos * 64 + fidx), c1 = *(const PG8_GAS f32x4*)(cosT + pos * 64 + fidx + 4), s0 = *(const PG8_GAS f32x4*)(sinT + pos * 64 + fidx), s1 = *(const PG8_GAS f32x4*)(sinT + pos * 64 + fidx + 4);
#pragma unroll
                for (int ai = 0; ai < 2; ++ai) { const f32x4 a0 = acc[ai][0][m][0], a1 = acc[ai][0][m][1], b0 = acc[ai][1][m][0], b1 = acc[ai][1][m][1];
                    store_rows(a0 * c0 - b0 * s0, a1 * c1 - b1 * s1, a0 * s0 + b0 * c0, a1 * s1 + b1 * c1, type, base, (size_t)(row0 + ai * HALF + m * 16) * 2048 + coff); }
            }
        }
    }
};

struct EpiHgIn {
    static constexpr bool PERM = true, AFTER_DRAIN = false, REP2 = false;
    static constexpr bool DRAIN_OK = true;
    static constexpr int NVM = 16;
    bf16_t* act; size_t tstride; const float* lb;
    __device__ __forceinline__ void operator()(const f32x4 (&acc)[2][2][4][2], const Unit& u, int wr, int wc, int fr_in, int fq_in) const {
        int fr = fr_in, fq = fq_in; asm volatile("" : "+v"(fr), "+v"(fq));
        const int type = u.pn >> 3, cb = (u.pn & 7) * 256 + wc * 32 + 8 * fq;
        const int row0 = u.pm * BM + wr * 64 + fr;
        const int slot = (type == 0) ? 0 : (type == 1) ? 1 : (type == 2) ? 3 : (type == 3) ? 5 : 6;
        bf16_t* base = act + (size_t)slot * tstride;
        f32x4 lbv[2][2];
#pragma unroll
        for (int bj = 0; bj < 2; ++bj)
#pragma unroll
            for (int n = 0; n < 2; ++n) lbv[bj][n] = (type == 1 || type == 2) ? *(const PG8_GAS f32x4*)(lb + cb + bj * HALF + 4 * n) : (f32x4){0.f, 0.f, 0.f, 0.f};
#pragma unroll
        for (int ai = 0; ai < 2; ++ai)
#pragma unroll
            for (int m = 0; m < 4; ++m) {
                const int r = row0 + ai * HALF + m * 16;
                const size_t roff = (size_t)r * 2048 + cb;
#pragma unroll
                for (int bj = 0; bj < 2; ++bj) {
                    f32x4 v0 = acc[ai][bj][m][0], v1 = acc[ai][bj][m][1];
                    if (type == 0) { v0 = silu4(v0); v1 = silu4(v1); }
                    if (type == 4) { v0 = sigm4(v0); v1 = sigm4(v1); }
                    if (type == 1 || type == 2) {
                        f32x4 k0, k1;
                        hg_gate4(v0, k0, lbv[bj][0]); hg_gate4(v1, k1, lbv[bj][1]);
                        st16(base + tstride, roff + bj * HALF, pack8(k0, k1));
                    }
                    st16(base, roff + bj * HALF, pack8(v0, v1));
                }
            }
    }
};

typedef _Float16 x_h2 __attribute__((ext_vector_type(2)));
typedef float x_f2 __attribute__((ext_vector_type(2)));
__device__ __forceinline__ float x_lo(unsigned w) { if (XRES_F16) { const x_h2 h = __builtin_bit_cast(x_h2, w); return (float)h[0]; } return __builtin_bit_cast(float, w << 16); }
__device__ __forceinline__ float x_hi(unsigned w) { if (XRES_F16) { const x_h2 h = __builtin_bit_cast(x_h2, w); return (float)h[1]; } return __builtin_bit_cast(float, w & 0xffff0000u); }
__device__ __forceinline__ unsigned x_pk(float lo, float hi) { if (XRES_F16) { const x_f2 v = {lo, hi}; const x_h2 h = __builtin_convertvector(v, x_h2); return __builtin_bit_cast(unsigned, h); } return cvt_pk_bf16(lo, hi); }
__device__ __forceinline__ u32x4 x_pack8(f32x4 v0, f32x4 v1) { u32x4 w; w.x = x_pk(v0[0], v0[1]); w.y = x_pk(v0[2], v0[3]); w.z = x_pk(v1[0], v1[1]); w.w = x_pk(v1[2], v1[3]); return w; }
struct EpiResid {
    static constexpr bool PERM = true, AFTER_DRAIN = false, REP2 = false;
    static constexpr bool DRAIN_OK = true;
    static constexpr int NVM = 36;
    bf16_t* X; const float* gate; int gstride; int n_lat_panels;
    __device__ __forceinline__ void operator()(const f32x4 (&acc)[2][2][4][2], const Unit& u, int wr, int wc, int fr, int fq) const {
        const int row0 = u.pm * BM + wr * 64 + fr, col0 = u.pn * BM + wc * 32 + 8 * fq;
        const int b = (u.pm < n_lat_panels) ? (u.pm >> 4) : 4;
        const float* g = gate + (size_t)b * gstride + col0;
        bf16_t* xb = X + (size_t)row0 * 2048 + col0;
        f32x4 gv[2][2];
#pragma unroll
        for (int bj = 0; bj < 2; ++bj)
#pragma unroll
            for (int n = 0; n < 2; ++n) gv[bj][n] = *(const f32x4*)(g + bj * HALF + 4 * n);
        u32x4 xa[2][2], xc[2][2];
#define ER_LOAD(dst, ai, mp) do { _Pragma("unroll") for (int mm = 0; mm < 2; ++mm) _Pragma("unroll") for (int bj = 0; bj < 2; ++bj) \
            dst[mm][bj] = *(const u32x4*)(xb + (size_t)((ai) * HALF + (2 * (mp) + mm) * 16) * 2048 + bj * HALF); } while (0)
#define ER_STORE(src, ai, mp) do { _Pragma("unroll") for (int mm = 0; mm < 2; ++mm) _Pragma("unroll") for (int bj = 0; bj < 2; ++bj) { const u32x4 w_ = src[mm][bj]; \
            const f32x4 lo_ = (f32x4){x_lo(w_.x), x_hi(w_.x), x_lo(w_.y), x_hi(w_.y)} + gv[bj][0] * acc[ai][bj][2 * (mp) + mm][0]; \
            const f32x4 hi_ = (f32x4){x_lo(w_.z), x_hi(w_.z), x_lo(w_.w), x_hi(w_.w)} + gv[bj][1] * acc[ai][bj][2 * (mp) + mm][1]; \
            *(u32x4*)(xb + (size_t)((ai) * HALF + (2 * (mp) + mm) * 16) * 2048 + bj * HALF) = x_pack8(lo_, hi_); } } while (0)
        ER_LOAD(xa, 0, 0); ER_LOAD(xc, 0, 1);
        ER_STORE(xa, 0, 0); ER_LOAD(xa, 1, 0);
        ER_STORE(xc, 0, 1); ER_LOAD(xc, 1, 1);
        ER_STORE(xa, 1, 0); ER_STORE(xc, 1, 1);
#undef ER_LOAD
#undef ER_STORE
    }
};

struct EpiGateUp {
    static constexpr bool PERM = true, AFTER_DRAIN = false, REP2 = true;
    static constexpr bool DRAIN_OK = true;
    static constexpr int NVM = 8;
    bf16_t* H; int ldh; float pre;
    __device__ __forceinline__ void operator()(const f32x4 (&acc)[2][2][4][2], const Unit& u, int wr, int wc, int fr, int fq) const {
        const int row0 = u.pm * BM + wr * 64 + fr, col0 = u.pn * HALF + wc * 32 + 8 * fq;
#pragma unroll
        for (int ai = 0; ai < 2; ++ai)
#pragma unroll
            for (int m = 0; m < 4; ++m) {
                const f32x4 h0 = silu4(acc[ai][0][m][0] * pre) * (acc[ai][1][m][0] * pre), h1 = silu4(acc[ai][0][m][1] * pre) * (acc[ai][1][m][1] * pre);
                st16(H, (size_t)(row0 + ai * HALF + m * 16) * ldh + col0, pack8(h0, h1));
            }
    }
};


struct EpiSlab {
    static constexpr bool PERM = false, AFTER_DRAIN = false, REP2 = false;
    static constexpr bool DRAIN_OK = true;
    static constexpr int NVM = 32;
    float* slab; int pm0, ksub; size_t kstride;
    __device__ __forceinline__ void operator()(const f32x4 (&acc)[2][2][4][2], const Unit& u, int wr, int wc, int fr, int fq) const {
        float* base = slab + (size_t)(u.k0 / ksub) * kstride + (size_t)((u.pm - pm0) * BM + wr * 64 + fr) * 2048 + u.pn * BM + wc * 32 + 4 * fq;
#pragma unroll
        for (int ai = 0; ai < 2; ++ai)
#pragma unroll
            for (int m = 0; m < 4; ++m) { float* rowp = base + (size_t)(ai * HALF + m * 16) * 2048;
#pragma unroll
                for (int bj = 0; bj < 2; ++bj)
#pragma unroll
                    for (int n = 0; n < 2; ++n) *(PG8_GAS f32x4*)(rowp + bj * HALF + n * 16) = acc[ai][bj][m][n]; }
    }
};
template <class Epi, class Sched, bool ALIGN_EPI = false, bool SP2 = false>
__device__ __forceinline__ void gemm_phase(PG8_LAS unsigned char* lds, const Gemm g, const Sched& S, const Epi& E) {
    int tid_ = mk_tid(); asm volatile("" : "+v"(tid_));
    const int tid = tid_, wid = __builtin_amdgcn_readfirstlane(tid >> 6), lane = tid & 63, wr = wid >> 2, wc = wid & 3, fr = lane & 15, fq = lane >> 4;
    const int K = g.K, nt = K / BK;
    unsigned voffA[2], voffB[2];
#pragma unroll
    for (int i = 0; i < 2; ++i) { int R, C; stage_rc(tid * 16 + i * 8192, R, C); const int Rb = Epi::PERM ? ((R & ~31) + perm32(R & 31)) : R;
        voffA[i] = (unsigned)(R * g.lda + C) * 2u; voffB[i] = (unsigned)(Rb * g.ldb + C) * 2u; }
    const size_t kstep = (size_t)(BK * 2);
    const size_t hsA = (size_t)HALF * g.lda * 2, hsB = (size_t)HALF * g.ldb * 2;
    const size_t tsA = 2 * hsA, tsB = 2 * hsB;
    const unsigned ldsbase = (unsigned)(unsigned long long)lds;
    const unsigned ldsw = (unsigned)wid * 1024u;
    const int aoff = lds_byte(wr * 64 + fr, fq * 8), boff = lds_byte(wc * 32 + fr, fq * 8);
#define PG8_SA(b, h) (((b) * 2 + (h)) * HTB)
#define PG8_SB(b, h) ((4 + (b) * 2 + (h)) * HTB)
#define PG8_STAGE(bufoff, gbase, voff) do { _Pragma("unroll") for (int _i = 0; _i < 2; ++_i) { \
        const unsigned m0_ = ldsbase + (unsigned)(bufoff) + ldsw + (unsigned)_i * 8192u; \
        asm volatile("s_mov_b32 m0, %2\n\ts_nop 0\n\tglobal_load_lds_dwordx4 %0, %1" :: "v"((voff)[_i]), "s"((const char*)(gbase)), "s"(m0_) : "memory", "m0"); } } while (0)
#define PG8_LDA(dst, b, h) do { _Pragma("unroll") for (int m = 0; m < 4; ++m) _Pragma("unroll") for (int k = 0; k < 2; ++k) dst[m][k] = *(const PG8_LAS bf16x8*)(lds + PG8_SA(b, h) + aoff + m * 2048 + k * 1024); } while (0)
#define PG8_LDB(dst, b, h) do { _Pragma("unroll") for (int n = 0; n < 2; ++n) _Pragma("unroll") for (int k = 0; k < 2; ++k) dst[n][k] = *(const PG8_LAS bf16x8*)(lds + PG8_SB(b, h) + boff + n * 2048 + k * 1024); } while (0)
#define PG8_MMA(ai, bj, At, Bt) do { __builtin_amdgcn_s_setprio(1); _Pragma("unroll") for (int m = 0; m < 4; ++m) _Pragma("unroll") for (int n = 0; n < 2; ++n) _Pragma("unroll") for (int k = 0; k < 2; ++k) \
        acc[ai][bj][m][n] = __builtin_amdgcn_mfma_f32_16x16x32_bf16(Bt[n][k], At[m][k], acc[ai][bj][m][n], 0, 0, 0); __builtin_amdgcn_s_setprio(0); } while (0)
#define PG8_WAIT_V(n) asm volatile("s_waitcnt vmcnt(" #n ")" ::: "memory")
#define PG8_WAIT_L(n) asm volatile("s_waitcnt lgkmcnt(" #n ")" ::: "memory")
#define PG8_BAR __builtin_amdgcn_s_barrier()
#define PG8_SCHED __builtin_amdgcn_sched_barrier(0)
    Unit cur, nxt; int ui = 0; bool epi_ran = false;
    if (!S.next(0, cur)) return;
    f32x4 acc[2][2][4][2];
#pragma unroll
    for (int a = 0; a < 2; ++a)
#pragma unroll
        for (int b = 0; b < 2; ++b)
#pragma unroll
            for (int m = 0; m < 4; ++m)
#pragma unroll
                for (int n = 0; n < 2; ++n) acc[a][b][m][n] = (f32x4){0.f, 0.f, 0.f, 0.f};
    bf16x8 At[4][2], B0[2][2], B1[2][2];
    const char* cA = (const char*)g.A + (size_t)cur.pm * tsA + (size_t)cur.k0 * 2; const char* cB = (const char*)g.Bt + (size_t)cur.pn * tsB + (size_t)cur.k0 * 2;
    S.a_ready(cur);
    if constexpr (SP2) {
        PG8_STAGE(PG8_SB(0, 0), cB, voffB); PG8_STAGE(PG8_SB(0, 1), cB + hsB, voffB); PG8_STAGE(PG8_SA(0, 0), cA, voffA); PG8_STAGE(PG8_SA(0, 1), cA + hsA, voffA);
        if (wr == 1) PG8_BAR;
        PG8_WAIT_V(2); PG8_BAR;
        PG8_STAGE(PG8_SB(1, 0), cB + kstep, voffB); PG8_STAGE(PG8_SA(1, 0), cA + kstep, voffA); PG8_STAGE(PG8_SB(1, 1), cB + hsB + kstep, voffB);
        PG8_WAIT_V(6); PG8_BAR;
    } else {
        PG8_STAGE(PG8_SB(0, 0), cB, voffB); PG8_STAGE(PG8_SA(0, 0), cA, voffA); PG8_STAGE(PG8_SB(0, 1), cB + hsB, voffB); PG8_STAGE(PG8_SA(0, 1), cA + hsA, voffA);
        if (wr == 1) PG8_BAR;
        PG8_WAIT_V(4); PG8_BAR;
        PG8_STAGE(PG8_SB(1, 0), cB + kstep, voffB); PG8_STAGE(PG8_SA(1, 0), cA + kstep, voffA); PG8_STAGE(PG8_SB(1, 1), cB + hsB + kstep, voffB);
        PG8_WAIT_V(6); PG8_BAR;
    }
    constexpr bool DRO = SP2 && (EPI_DRAIN_OVERLAP != 0) && !Sched::KTWICE && !Epi::AFTER_DRAIN && Epi::DRAIN_OK;
#define PG8_TRIP(STAGE11, WV) do { \
            PG8_LDB(B0, 0, 0); PG8_LDB(B1, 0, 1); PG8_SCHED; PG8_LDA(At, 0, 0); if (STAGE11) PG8_STAGE(PG8_SA(1, 1), a1 + hsA, voffA); \
            WV; PG8_WAIT_L(0); PG8_BAR; PG8_MMA(0, 0, At, B0); PG8_MMA(0, 1, At, B1); PG8_BAR; PG8_SCHED; \
              \
            PG8_LDA(At, 0, 1); PG8_STAGE(PG8_SB(0, 0), b2, voffB); PG8_STAGE(PG8_SB(0, 1), b2 + hsB, voffB); PG8_STAGE(PG8_SA(0, 0), a2, voffA); \
            WV; PG8_WAIT_L(0); PG8_BAR; PG8_MMA(1, 0, At, B0); PG8_MMA(1, 1, At, B1); PG8_BAR; PG8_SCHED; \
              \
            PG8_LDB(B0, 1, 0); PG8_LDB(B1, 1, 1); PG8_SCHED; PG8_LDA(At, 1, 0); PG8_STAGE(PG8_SA(0, 1), a2 + hsA, voffA); \
            WV; PG8_WAIT_L(0); PG8_BAR; PG8_MMA(0, 0, At, B0); PG8_MMA(0, 1, At, B1); PG8_BAR; PG8_SCHED; \
              \
            PG8_LDA(At, 1, 1); PG8_STAGE(PG8_SB(1, 0), b3, voffB); PG8_STAGE(PG8_SB(1, 1), b3 + hsB, voffB); PG8_STAGE(PG8_SA(1, 0), a3, voffA); \
            PG8_WAIT_V(8); PG8_WAIT_L(0); PG8_BAR; PG8_MMA(1, 0, At, B0); PG8_MMA(1, 1, At, B1); PG8_BAR; PG8_SCHED; } while (0)
    for (;;) {
        const bool has_next = S.next(ui + 1, nxt);
        const char* nA = has_next ? (const char*)g.A + (size_t)nxt.pm * tsA + (size_t)nxt.k0 * 2 : cA; const char* nB = has_next ? (const char*)g.Bt + (size_t)nxt.pn * tsB + (size_t)nxt.k0 * 2 : cB;
        for (int t = (DRO && ui > 0) ? 2 : 0; t < nt; t += 2) {
            const bool last = (t == nt - 2);
            const char* a1 = cA + (size_t)(t + 1) * kstep;
            const char* a2 = last ? nA : cA + (size_t)(t + 2) * kstep; const char* b2 = last ? nB : cB + (size_t)(t + 2) * kstep;
            const char* a3 = a2 + kstep; const char* b3 = b2 + kstep;
            if (last && has_next) S.a_ready(nxt);
            if constexpr (SP2) {
            PG8_TRIP(true, PG8_WAIT_V(8));
            } else {
            PG8_LDB(B0, 0, 0); PG8_SCHED; PG8_LDA(At, 0, 0); PG8_STAGE(PG8_SA(1, 1), a1 + hsA, voffA);
            PG8_WAIT_L(8); PG8_BAR; PG8_WAIT_L(0); PG8_MMA(0, 0, At, B0); PG8_BAR; PG8_SCHED;
            PG8_LDB(B1, 0, 1); PG8_STAGE(PG8_SB(0, 0), b2, voffB);
            PG8_BAR; PG8_WAIT_L(0); PG8_MMA(0, 1, At, B1); PG8_BAR;
            PG8_LDA(At, 0, 1); PG8_STAGE(PG8_SA(0, 0), a2, voffA);
            PG8_BAR; PG8_WAIT_L(0); PG8_MMA(1, 0, At, B0); PG8_BAR; PG8_SCHED;
            PG8_STAGE(PG8_SB(0, 1), b2 + hsB, voffB);
            PG8_WAIT_V(6); PG8_BAR; PG8_MMA(1, 1, At, B1); PG8_BAR;
            PG8_LDB(B0, 1, 0); PG8_SCHED; PG8_LDA(At, 1, 0); PG8_STAGE(PG8_SA(0, 1), a2 + hsA, voffA);
            PG8_WAIT_L(8); PG8_BAR; PG8_WAIT_L(0); PG8_MMA(0, 0, At, B0); PG8_BAR; PG8_SCHED;
            PG8_LDB(B1, 1, 1); PG8_STAGE(PG8_SB(1, 0), b3, voffB);
            PG8_BAR; PG8_WAIT_L(0); PG8_MMA(0, 1, At, B1); PG8_BAR;
            PG8_LDA(At, 1, 1); PG8_STAGE(PG8_SA(1, 0), a3, voffA);
            PG8_BAR; PG8_WAIT_L(0); PG8_MMA(1, 0, At, B0); PG8_BAR; PG8_SCHED;
            PG8_STAGE(PG8_SB(1, 1), b3 + hsB, voffB);
            PG8_WAIT_V(6); PG8_BAR; PG8_MMA(1, 1, At, B1); PG8_BAR;
            }
        }
        if constexpr (DRO) { asm volatile("" ::: "memory"); PG8_STAGE(PG8_SA(1, 1), nA + kstep + hsA, voffA); asm volatile("" ::: "memory"); }
        const bool kp_first = Sched::KTWICE && ((ui & 1) == 0);
        (void)epi_ran;
        if constexpr (ALIGN_EPI) { if (wr == 0) PG8_BAR; }
        if (!kp_first) if constexpr (!Epi::AFTER_DRAIN) { E(acc, cur, wr, wc, fr, fq); if constexpr (REP_EPI > 1 && Epi::REP2) { asm volatile("" ::: "memory"); E(acc, cur, wr, wc, fr, fq); } S.done(cur); }
        asm volatile("" ::: "memory");
        if (!has_next) break;
        if (!kp_first)
#pragma unroll
        for (int a = 0; a < 2; ++a)
#pragma unroll
            for (int b = 0; b < 2; ++b)
#pragma unroll
                for (int m = 0; m < 4; ++m)
#pragma unroll
                    for (int n = 0; n < 2; ++n) acc[a][b][m][n] = (f32x4){0.f, 0.f, 0.f, 0.f};
        cur = nxt; cA = nA; cB = nB; ++ui;
        if constexpr (ALIGN_EPI) { if (wr == 1) PG8_BAR; }
        if constexpr (DRO) {
            const char* a1 = cA + kstep; const char* a2 = cA + 2 * kstep; const char* b2 = cB + 2 * kstep; const char* a3 = a2 + kstep; const char* b3 = b2 + kstep;
            PG8_TRIP(false, asm volatile("s_waitcnt vmcnt(%0)" :: "n"(8 + Epi::NVM) : "memory"));
        }
    }
    PG8_WAIT_V(0);
    if constexpr (!ALIGN_EPI) { if (wr == 0) PG8_BAR; }
    PG8_BAR;
    if constexpr (Epi::AFTER_DRAIN) { E.fused(acc, cur, wr, wc, fr, fq, lds, wid, lane); S.done(cur); }
#undef PG8_SA
#undef PG8_SB
#undef PG8_STAGE
#undef PG8_LDA
#undef PG8_LDB
#undef PG8_MMA
#undef PG8_WAIT_V
#undef PG8_TRIP
#undef PG8_WAIT_L
#undef PG8_BAR
#undef PG8_SCHED
}
}

#ifndef MK_N_LAUNCHES
#define MK_N_LAUNCHES 1
#endif
constexpr int NWAVES = 8;
constexpr int D = 2048, BATCH = 4, SEQ = 4096, CTXL = 256, DEPTH = 4, FF = 5632;
constexpr int ML = BATCH * SEQ, MC = BATCH * CTXL, M = ML + MC;
constexpr int NLP = ML / 256;
constexpr int MOD_LD = 6 * D;
constexpr float EPS = 1e-6f;
constexpr int N_PHASES = 3 + 8 * DEPTH;

constexpr size_t MiB = 1u << 20;
constexpr size_t WS_CTL = 0, WS_MOD = 1 * MiB, ZERO_BYTES = 64 * 1024;
constexpr size_t WS_TAB = 2 * MiB;
constexpr size_t TAB_COS = 0, TAB_SIN = 16384, TAB_LB = 32768;
constexpr size_t WS_X = 4 * MiB;
constexpr size_t WS_HN = 140 * MiB;
constexpr size_t WS_ACT = 208 * MiB;
constexpr size_t ACT_STRIDE = (size_t)M * D;
constexpr size_t WS_OF = 684 * MiB, WS_OB = 820 * MiB;
constexpr size_t WS_W = 956 * MiB, W_LAYER = 114 * MiB;
constexpr size_t W_IN = 0, W_OUT = 40 * MiB, W_GU = 48 * MiB, W_DN = 92 * MiB;
constexpr size_t WS_SLAB = WS_W + 4 * W_LAYER;
constexpr size_t WS_END = WS_SLAB + 32 * MiB;
constexpr int CW_BAR = 4096;

constexpr int RING_BYTES = 131072;
constexpr int LDSCTL_OFF = RING_BYTES, MISC_OFF = LDSCTL_OFF + 320;
constexpr int LDS_BYTES = 147456;

#define GAS __attribute__((address_space(1)))
#define LAS __attribute__((address_space(3)))
typedef unsigned short bf16;
typedef unsigned v4u __attribute__((ext_vector_type(4)));
typedef unsigned v2u __attribute__((ext_vector_type(2)));
typedef float f32x4 __attribute__((ext_vector_type(4)));
typedef GAS unsigned gu32;
#define LDS_WAIT() asm volatile("s_waitcnt lgkmcnt(0)" ::: "memory")
__device__ __forceinline__ unsigned f2bf(float f) { unsigned u = __builtin_bit_cast(unsigned, f); return (u + 0x7fffu + ((u >> 16) & 1u)) >> 16; }
typedef float f32x2_t __attribute__((ext_vector_type(2)));
typedef __bf16 bf16x2_t __attribute__((ext_vector_type(2)));
__device__ __forceinline__ unsigned pk2(float lo, float hi) { const f32x2_t v = {lo, hi}; const bf16x2_t b = __builtin_convertvector(v, bf16x2_t); return __builtin_bit_cast(unsigned, b); }
__device__ __forceinline__ float bflo(unsigned w) { return __builtin_bit_cast(float, w << 16); }
typedef _Float16 f16x2_t __attribute__((ext_vector_type(2)));
__device__ __forceinline__ unsigned xpk2(float lo, float hi) { if (XRES_F16) { const f32x2_t v = {lo, hi}; const f16x2_t h = __builtin_convertvector(v, f16x2_t); return __builtin_bit_cast(unsigned, h); } return pk2(lo, hi); }
__device__ __forceinline__ float xlo(unsigned w) { if (XRES_F16) { const f16x2_t h = __builtin_bit_cast(f16x2_t, w); return (float)h[0]; } return __builtin_bit_cast(float, w << 16); }
__device__ __forceinline__ float xhi(unsigned w) { if (XRES_F16) { const f16x2_t h = __builtin_bit_cast(f16x2_t, w); return (float)h[1]; } return __builtin_bit_cast(float, w & 0xffff0000u); }
__device__ __forceinline__ float bfhi(unsigned w) { return __builtin_bit_cast(float, w & 0xffff0000u); }
template <int CTRL> __device__ __forceinline__ float dpp_mov(float v) { return __builtin_bit_cast(float, __builtin_amdgcn_update_dpp(0, __builtin_bit_cast(int, v), CTRL, 0xF, 0xF, true)); }
__device__ __forceinline__ float wave_sum(float v) {
    v += dpp_mov<0xB1>(v);
    v += dpp_mov<0x4E>(v);
    v += dpp_mov<0x141>(v);
    v += dpp_mov<0x140>(v);
    const int iv = __builtin_bit_cast(int, v);
    const float a = __builtin_bit_cast(float, __builtin_amdgcn_readlane(iv, 0)), b = __builtin_bit_cast(float, __builtin_amdgcn_readlane(iv, 16));
    const float c = __builtin_bit_cast(float, __builtin_amdgcn_readlane(iv, 32)), d = __builtin_bit_cast(float, __builtin_amdgcn_readlane(iv, 48));
    return (a + b) + (c + d);
}
#define XB_TMO      128
#define XB_XCNT(j)  (256  + 64 * (j))
#define XB_XSUB(j)  (1280 + 64 * (j))
#define XB_XGEN(j)  (2304 + 64 * (j))
#define XB_TOP      3328
#define XB_TOPGEN   3392
#define XCD_BAR_WORDS 3456
#define XB_SPIN_CAP (1u << 18)

__device__ __forceinline__ unsigned xb_ld(unsigned* p)              { return __hip_atomic_load(p, __ATOMIC_RELAXED, __HIP_MEMORY_SCOPE_AGENT); }
__device__ __forceinline__ unsigned xb_add(unsigned* p, unsigned v) { return __hip_atomic_fetch_add(p, v, __ATOMIC_RELAXED, __HIP_MEMORY_SCOPE_AGENT); }
__device__ __forceinline__ unsigned xb_xcc_id() { return (unsigned)__builtin_amdgcn_s_getreg((3 << 11) | 20) & 0xFu; }
#define XB_SPIN(cond, bar) do { unsigned _sp = 0; while (cond) { __builtin_amdgcn_s_sleep(1); \
    if ((++_sp & 255u) == 0u) { if (xb_ld(&(bar)[XB_TMO])) break; if (_sp > XB_SPIN_CAP) { atomicAdd(&(bar)[XB_TMO], 1u); break; } } } } while (0)

struct XcdBarrier {
    unsigned* bar; unsigned x;
    volatile LAS unsigned* st;
};

__device__ __forceinline__ XcdBarrier xcd_barrier_post(unsigned* bar, volatile LAS unsigned* st) {
    XcdBarrier b; b.bar = bar; b.x = xb_xcc_id(); b.st = st;
    if (threadIdx.x == 0) (void)xb_add(&bar[XB_XCNT(b.x)], 1u);
    return b;
}
__device__ __forceinline__ void xcd_barrier_complete(unsigned* bar, unsigned x, unsigned& nloc, unsigned& nx) {
    const unsigned G = gridDim.x * gridDim.y * gridDim.z;
    unsigned sum, cnt, mine, sp = 0u;
    for (;;) {
        sum = 0u; cnt = 0u; mine = 0u;
#pragma unroll
        for (unsigned j = 0; j < 16; ++j) { const unsigned c = xb_ld(&bar[XB_XCNT(j)]); sum += c; cnt += (c > 0u) ? 1u : 0u; mine = (j == x) ? c : mine; }
        if (sum == G) break;
        __builtin_amdgcn_s_sleep(1);
        if ((++sp & 255u) == 0u) { if (xb_ld(&bar[XB_TMO])) break; if (sp > XB_SPIN_CAP) { atomicAdd(&bar[XB_TMO], 1u); break; } }
    }
    nloc = mine > 0u ? mine : 1u; nx = cnt > 0u ? cnt : 1u;
}

__device__ __forceinline__ void xcd_barrier(const XcdBarrier& b) {
    asm volatile("s_waitcnt vmcnt(0)" ::: "memory");
    __syncthreads();
    if (mk_tid() == 0) {
        unsigned* bar = b.bar;
        __builtin_amdgcn_s_waitcnt(0);
        unsigned nloc = b.st[0], nx = b.st[1];
        if (nloc == 0u) { xcd_barrier_complete(bar, b.x, nloc, nx); b.st[0] = nloc; b.st[1] = nx; }
        const unsigned old = xb_add(&bar[XB_XSUB(b.x)], 1u);
        const unsigned gen = old / nloc;
        if (old + 1u == (gen + 1u) * nloc) {
            __builtin_amdgcn_fence(__ATOMIC_RELEASE, "agent");
            asm volatile("s_waitcnt vmcnt(0)" ::: "memory");
            const unsigned og = xb_add(&bar[XB_TOP], 1u);
            const unsigned tg = og / nx;
            if (og + 1u == (tg + 1u) * nx) xb_add(&bar[XB_TOPGEN], 1u);
            else XB_SPIN(xb_ld(&bar[XB_TOPGEN]) == tg, bar);
            __builtin_amdgcn_fence(__ATOMIC_ACQUIRE, "agent");
            xb_add(&bar[XB_XGEN(b.x)], 1u);
            asm volatile("s_waitcnt vmcnt(0)" ::: "memory");
        } else {
            XB_SPIN(xb_ld(&bar[XB_XGEN(b.x)]) == gen, bar);
            __builtin_amdgcn_fence(__ATOMIC_ACQUIRE, "agent");
            asm volatile("s_waitcnt vmcnt(0)" ::: "memory");
        }
    }
    __syncthreads();
}

struct Args { const float* in[18]; float* out; unsigned char* ws; int ph_lo, ph_hi; };
struct Frame {
    LAS unsigned char* lds;
    gu32* ctl;
    int tid, lane, wave, vcu, G;
};
__device__ __forceinline__ void relaunder(Frame& F) { int t = mk_tid(); asm volatile("" : "+v"(t)); F.tid = t; F.lane = t & 63; F.wave = __builtin_amdgcn_readfirstlane(t >> 6); }

__device__ __forceinline__ void p0_transpose_item(const float* W, int K, int N, bf16* WT, int dst_row0, LAS float* scr, int k0, int n0, int lane) {
    float r[32];
    const GAS float* wp = (const GAS float*)W + (size_t)(k0 + (lane >> 5)) * N + n0 + (lane & 31);
#pragma unroll
    for (int i = 0; i < 32; ++i) r[i] = PRO_NT ? __builtin_nontemporal_load(wp + (size_t)(2 * i) * N) : wp[(size_t)(2 * i) * N];
#pragma unroll
    for (int i = 0; i < 32; ++i) scr[(2 * i + (lane >> 5)) * 33 + (lane & 31)] = r[i];
    LDS_WAIT(); asm volatile("" ::: "memory");
    const int c = lane & 7;
#pragma unroll
    for (int j = 0; j < 4; ++j) { const int n = (lane >> 3) + 8 * j; const LAS float* s = scr + (8 * c) * 33 + n;
        v4u o; o.x = pk2(s[0 * 33], s[1 * 33]); o.y = pk2(s[2 * 33], s[3 * 33]); o.z = pk2(s[4 * 33], s[5 * 33]); o.w = pk2(s[6 * 33], s[7 * 33]);
        if (WT_NT_ST) __builtin_nontemporal_store(o, (GAS v4u*)(WT + (size_t)(dst_row0 + n) * K + k0 + 8 * c)); else *(GAS v4u*)(WT + (size_t)(dst_row0 + n) * K + k0 + 8 * c) = o; }
    LDS_WAIT(); asm volatile("" ::: "memory");
}
__device__ __forceinline__ bool p0_matrix(int& it, const float* W, int K, int N, bf16* WT, bool gu, LAS float* scr, int lane) {
    const int nblk = N / 32, items = (K / 64) * nblk;
    if (it >= items) { it -= items; return false; }
    const int kb = it / nblk, nb = it % nblk, n0 = 32 * nb;
    int dst = n0;
    if (gu) { const int half = n0 / FF, w = n0 % FF; dst = (w / 128) * 256 + half * 128 + (w % 128); }
    p0_transpose_item(W, K, N, WT, dst, scr, 64 * kb, n0, lane);
    return true;
}
__device__ __forceinline__ void sincos_pos(float x, float& s, float& c) {
    const float n = rintf(x * 0.63661977236758f);
    float r = fmaf(n, -1.5707962512969971f, x); r = fmaf(n, -7.5497894158615964e-08f, r);
    const float r2 = r * r;
    const float sp = r + r * r2 * (-1.6666667e-1f + r2 * (8.3333333e-3f + r2 * (-1.9841270e-4f + r2 * 2.7557319e-6f)));
    const float cp = 1.0f + r2 * (-0.5f + r2 * (4.1666667e-2f + r2 * (-1.3888889e-3f + r2 * (2.4801587e-5f + r2 * -2.7557319e-7f))));
    const int q = ((int)n) & 3;
    s = (q == 0) ? sp : (q == 1) ? cp : (q == 2) ? -sp : -cp;
    c = (q == 0) ? cp : (q == 1) ? -sp : (q == 2) ? -cp : sp;
}
constexpr int I_RET = 32 * 256 + 32 * 64 + 32 * 352 + 88 * 64, I_HG = 32 * 320 + 32 * 64 + 32 * 352 + 88 * 64;
__device__ __forceinline__ void p0_convert_item(const Args& a, int layer, int it, LAS float* scr, int lane) {
    unsigned char* wb = a.ws + WS_W + (size_t)layer * W_LAYER;
    const int j = layer >> 1;
    if (layer & 1) { if (p0_matrix(it, a.in[11] + (size_t)j * D * 5 * D, D, 5 * D, (bf16*)(wb + W_IN), false, scr, lane)) return;
                     if (p0_matrix(it, a.in[12] + (size_t)j * D * D, D, D, (bf16*)(wb + W_OUT), false, scr, lane)) return; }
    else           { if (p0_matrix(it, a.in[8] + (size_t)j * D * 4 * D, D, 4 * D, (bf16*)(wb + W_IN), false, scr, lane)) return;
                     if (p0_matrix(it, a.in[9] + (size_t)j * D * D, D, D, (bf16*)(wb + W_OUT), false, scr, lane)) return; }
    if (p0_matrix(it, a.in[15] + (size_t)layer * D * 2 * FF, D, 2 * FF, (bf16*)(wb + W_GU), true, scr, lane)) return;
    p0_matrix(it, a.in[16] + (size_t)layer * FF * D, FF, D, (bf16*)(wb + W_DN), false, scr, lane);
}
__device__ __forceinline__ void tail_convert(const Args& a, Frame& F, int layer_next, int window, int widx, int nidle, int nidle1) {
    relaunder(F);
    const int T = (layer_next & 1) ? I_HG : I_RET;
    const int n1 = nidle1 * NWAVES * 12, n2 = n1 + 128 * NWAVES * 4, n3 = n2 + 80 * NWAVES * 12;
    const int lo = window == 1 ? 0 : window == 2 ? n1 : window == 3 ? n2 : n3, hi_ = window == 1 ? n1 : window == 2 ? n2 : window == 3 ? n3 : T;
    const int hi = hi_ < T ? hi_ : T;
    LAS float* scr = (LAS float*)(F.lds + F.wave * 9216);
    for (int it = lo + widx * NWAVES + F.wave; it < hi; it += nidle * NWAVES) p0_convert_item(a, layer_next, it, scr, F.lane);
}
__device__ __forceinline__ void p0_prologue(const Args& a, Frame& F) {
    relaunder(F);
    LAS float* scr = (LAS float*)(F.lds + F.wave * 9216);
    LAS float* act = (LAS float*)(F.lds + 73728);
    for (int i = F.tid; i < 5 * D; i += NWAVES * 64) { const float v = (i < 4 * D) ? a.in[1][i] : a.in[3][i - 4 * D]; act[i] = v / (1.f + __expf(-v)); }
    __syncthreads();
    const int gw = F.vcu * NWAVES + F.wave, NGW = F.G * NWAVES;
    for (int t = gw; t < DEPTH * 48 * 32; t += NGW) {
        const int layer = t / (48 * 32), rem = t % (48 * 32), cb = rem >> 5, ks = rem & 31;
        const int col = cb * 256 + F.lane * 4;
        const float* wp = a.in[4] + ((size_t)layer * D + ks * 64) * MOD_LD + col;
        f32x4 acc0 = {0.f, 0.f, 0.f, 0.f}, acc1 = acc0, acc2 = acc0, acc3 = acc0, acc4 = acc0;
        for (int kk = 0; kk < 64; kk += 16) {
            f32x4 w[16];
#pragma unroll
            for (int u = 0; u < 16; ++u) w[u] = PRO_NT ? __builtin_nontemporal_load((const GAS f32x4*)(wp + (size_t)(kk + u) * MOD_LD)) : *(const GAS f32x4*)(wp + (size_t)(kk + u) * MOD_LD);
#pragma unroll
            for (int u = 0; u < 16; ++u) { const int k = ks * 64 + kk + u;
                acc0 += act[k] * w[u]; acc1 += act[D + k] * w[u]; acc2 += act[2 * D + k] * w[u]; acc3 += act[3 * D + k] * w[u]; acc4 += act[4 * D + k] * w[u]; }
        }
        float* pp = (float*)(a.ws + WS_SLAB) + ((size_t)(layer * 32 + ks) * 5) * MOD_LD + col;
        *(GAS f32x4*)(pp) = acc0; *(GAS f32x4*)(pp + MOD_LD) = acc1; *(GAS f32x4*)(pp + 2 * MOD_LD) = acc2; *(GAS f32x4*)(pp + 3 * MOD_LD) = acc3; *(GAS f32x4*)(pp + 4 * MOD_LD) = acc4;
    }
    {
        const int gt = (F.vcu * NWAVES + F.wave) * 64 + F.lane;
        float* tab = (float*)(a.ws + WS_TAB);
        if (gt < 4096) { const int pos = gt >> 6, f = gt & 63; const float inv = expf(-(float)f * (9.210340371976184f / 64.0f)); float s, c; sincos_pos((float)pos * inv, s, c);
            tab[TAB_COS / 4 + gt] = c; tab[TAB_SIN / 4 + gt] = s; }
        else if (gt < 4096 + D) { const int ch = gt - 4096; const float b0 = a.in[14][ch], b1 = a.in[14][D + ch], mx = fmaxf(b0, b1), e0 = __expf(b0 - mx), e1 = __expf(b1 - mx), p0 = e0 / (e0 + e1), p1 = e1 / (e0 + e1);
            tab[TAB_LB / 4 + ch] = p0 - p0; tab[TAB_LB / 4 + D + ch] = (p0 + p1) - p0; }
    }
    for (int rep_ = 0; rep_ < REP_PRO; ++rep_) {
    {
        bf16* Xb = (bf16*)(a.ws + WS_X);
        for (int r0_ = gw; r0_ < M; r0_ += 4 * NGW) {
            f32x4 t[4][8];
#pragma unroll
            for (int u = 0; u < 4; ++u) { const int r = r0_ + u * NGW; if (r < M) { const GAS f32x4* xr = (const GAS f32x4*)((r < ML) ? a.in[0] + (size_t)r * D : a.in[2] + (size_t)(r - ML) * D) + F.lane;
#pragma unroll
                for (int j = 0; j < 8; ++j) t[u][j] = __builtin_nontemporal_load(xr + 64 * j); } }
#pragma unroll
            for (int u = 0; u < 4; ++u) { const int r = r0_ + u * NGW; if (r < M) { GAS v2u* o = (GAS v2u*)(Xb + (size_t)r * D) + F.lane;
#pragma unroll
                for (int j = 0; j < 8; ++j) { v2u w; w.x = xpk2(t[u][j][0], t[u][j][1]); w.y = xpk2(t[u][j][2], t[u][j][3]); o[64 * j] = w; } } }
        }
    }
    if (TAIL_CONVERT && F.G == 256) {
        for (int it = gw; it < I_RET; it += NGW) p0_convert_item(a, 0, it, scr, F.lane);
    } else {
        for (int it0 = gw; it0 < 2 * (I_RET + I_HG); it0 += NGW) {
            int it = it0; const int lp = it / (I_RET + I_HG); it -= lp * (I_RET + I_HG);
            int layer = 2 * lp; if (it >= I_RET) { it -= I_RET; layer += 1; }
            p0_convert_item(a, layer, it, scr, F.lane);
        }
    }
    }
}

__device__ __forceinline__ void p1_modreduce(const Args& a, Frame& F) {
    relaunder(F);
    static_assert((size_t)DEPTH * 32 * 5 * MOD_LD * 4 <= 32 * MiB, "the GEMV partials fit the slab region");
    for (int q = (F.vcu * NWAVES + F.wave) * 64 + F.lane; q < DEPTH * 5 * (MOD_LD / 4); q += F.G * NWAVES * 64) {
        const int layer = q / (5 * (MOD_LD / 4)), rem = q % (5 * (MOD_LD / 4)), row = rem / (MOD_LD / 4), c4 = rem % (MOD_LD / 4);
        const GAS f32x4* pp = (const GAS f32x4*)((const float*)(a.ws + WS_SLAB) + ((size_t)(layer * 32) * 5 + row) * MOD_LD) + c4;
        f32x4 t[32];
#pragma unroll
        for (int ks = 0; ks < 32; ++ks) t[ks] = pp[(size_t)ks * 5 * (MOD_LD / 4)];
        f32x4 sum = *(const GAS f32x4*)(a.in[5] + (size_t)layer * MOD_LD + 4 * c4);
#pragma unroll
        for (int ks = 0; ks < 32; ++ks) sum += t[ks];
        *((GAS f32x4*)((float*)(a.ws + WS_MOD) + ((size_t)layer * 5 + row) * MOD_LD) + c4) = sum;
    }
}

__device__ __forceinline__ void norm_mod_phase(const Args& a, Frame& F, const float* gain, const float* modl, int sh_off, int sc_off, int nrows, const float* slab_gate) {
    relaunder(F);
    const int gw = F.vcu * NWAVES + F.wave, NGW = F.G * NWAVES;
    bf16* X = (bf16*)(a.ws + WS_X); bf16* HN = (bf16*)(a.ws + WS_HN);
    for (int r = gw; r < nrows; r += NGW) {
        const int b = (r < ML) ? (r >> 12) : 4;
        const GAS v2u* xr = (const GAS v2u*)(X + (size_t)r * D) + F.lane;
        f32x4 v[8]; float ss = 0.f;
#pragma unroll
        for (int j = 0; j < 8; ++j) { const v2u w = xr[64 * j]; v[j] = (f32x4){xlo(w.x), xhi(w.x), xlo(w.y), xhi(w.y)}; }
        if (slab_gate != nullptr && r >= ML) {
            const GAS f32x4* sl = (const GAS f32x4*)((const float*)(a.ws + WS_SLAB) + (size_t)(r - ML) * D) + F.lane;
#pragma unroll
            for (int j = 0; j < 8; ++j) { const f32x4 p = (sl[64 * j] + sl[64 * j + (size_t)MC * D / 4]) + (sl[64 * j + 2 * ((size_t)MC * D / 4)] + sl[64 * j + 3 * ((size_t)MC * D / 4)]);
                v[j] += *(const GAS f32x4*)(slab_gate + 256 * j + 4 * F.lane) * p; v2u w; w.x = xpk2(v[j][0], v[j][1]); w.y = xpk2(v[j][2], v[j][3]); ((GAS v2u*)(X + (size_t)r * D) + F.lane)[64 * j] = w;
                v[j] = (f32x4){xlo(w.x), xhi(w.x), xlo(w.y), xhi(w.y)}; }
        }
#pragma unroll
        for (int j = 0; j < 8; ++j) ss += (v[j][0] * v[j][0] + v[j][1] * v[j][1]) + (v[j][2] * v[j][2] + v[j][3] * v[j][3]);
        const float rstd = 1.0f / sqrtf(wave_sum(ss) * (1.0f / D) + EPS);
        const float* mb = modl + (size_t)b * MOD_LD;
        GAS v2u* o8 = (GAS v2u*)(HN + (size_t)r * D) + F.lane;
#pragma unroll
        for (int j = 0; j < 8; ++j) { const int c = 256 * j + 4 * F.lane;
            const f32x4 g = *(const GAS f32x4*)(gain + c), sh = *(const GAS f32x4*)(mb + sh_off + c), sc = *(const GAS f32x4*)(mb + sc_off + c);
            const f32x4 y = (v[j] * rstd) * g * (sc + 1.0f) + sh;
            v2u w; w.x = pk2(y[0], y[1]); w.y = pk2(y[2], y[3]); o8[64 * j] = w; }
    }
}
#define NORM_FN(...) do { if (NORM_PIPE && F.G == 256) norm_mod_phase2(__VA_ARGS__); else norm_mod_phase(__VA_ARGS__); } while (0)
__device__ __forceinline__ void norm_mod_phase2(const Args& a, Frame& F, const float* gain, const float* modl, int sh_off, int sc_off, int nrows, const float* slab_gate) {
    relaunder(F);
    static_assert(ML == 8 * 2048 && MC <= 2048, "8 latent rows and at most one context row per wave of 2048");
    const int nw = F.vcu * NWAVES + F.wave;
    bf16* X = (bf16*)(a.ws + WS_X); bf16* HN = (bf16*)(a.ws + WS_HN);
    LAS float* CA = (LAS float*)F.lds; LAS float* CB = CA + 5 * D;
    v2u r0[8], r1[8], r2[8], r3[8], r4[8], r5[8], r6[8], r7[8];
#define NR_LOAD(dst, k_) do { const GAS v2u* xr_ = (const GAS v2u*)(X + (size_t)(nw + 2048 * (k_)) * D) + F.lane; \
        _Pragma("unroll") for (int j = 0; j < 8; ++j) dst[j] = __builtin_nontemporal_load(xr_ + 64 * j); } while (0)
#define NR_FINISH(raw, r_, b_) do { const int rr_ = (r_); float ss_ = 0.f; f32x4 v[8]; \
        _Pragma("unroll") for (int j = 0; j < 8; ++j) { v[j] = (f32x4){xlo(raw[j].x), xhi(raw[j].x), xlo(raw[j].y), xhi(raw[j].y)}; ss_ += (v[j][0] * v[j][0] + v[j][1] * v[j][1]) + (v[j][2] * v[j][2] + v[j][3] * v[j][3]); } \
        const float rstd_ = 1.0f / sqrtf(wave_sum(ss_) * (1.0f / D) + EPS); \
        GAS v2u* ho_ = (GAS v2u*)(HN + (size_t)rr_ * D) + F.lane; \
        _Pragma("unroll") for (int j = 0; j < 8; ++j) { const int c_ = 256 * j + 4 * F.lane; \
            const f32x4 y_ = (v[j] * rstd_) * *(const LAS f32x4*)(CA + (b_) * D + c_) + *(const LAS f32x4*)(CB + (b_) * D + c_); v2u w_; w_.x = pk2(y_[0], y_[1]); w_.y = pk2(y_[2], y_[3]); \
            ho_[64 * j] = w_; } } while (0)
    NR_LOAD(r0, 0); NR_LOAD(r1, 1); NR_LOAD(r2, 2); NR_LOAD(r3, 3); NR_LOAD(r4, 4); NR_LOAD(r5, 5); NR_LOAD(r6, 6); NR_LOAD(r7, 7);
    { const GAS f32x4* g4 = (const GAS f32x4*)gain;
      for (int q = F.tid; q < 5 * D / 4; q += NWAVES * 64) { const int bq = q >> 9, cq = q & 511; const GAS f32x4* mb4 = (const GAS f32x4*)(modl + (size_t)bq * MOD_LD);
          ((LAS f32x4*)CA)[q] = g4[cq] * (mb4[sc_off / 4 + cq] + 1.0f); ((LAS f32x4*)CB)[q] = mb4[sh_off / 4 + cq]; } }
    asm volatile("s_waitcnt lgkmcnt(0)" ::: "memory"); __builtin_amdgcn_s_barrier(); asm volatile("" ::: "memory");
    NR_FINISH(r0, nw,            (nw) >> 12);
    NR_FINISH(r1, nw + 2048,     (nw + 2048) >> 12);
    NR_FINISH(r2, nw + 2 * 2048, (nw + 2 * 2048) >> 12);
    NR_FINISH(r3, nw + 3 * 2048, (nw + 3 * 2048) >> 12);
    NR_FINISH(r4, nw + 4 * 2048, (nw + 4 * 2048) >> 12);
    NR_FINISH(r5, nw + 5 * 2048, (nw + 5 * 2048) >> 12);
    NR_FINISH(r6, nw + 6 * 2048, (nw + 6 * 2048) >> 12);
    NR_FINISH(r7, nw + 7 * 2048, (nw + 7 * 2048) >> 12);
    if (ML + nw < nrows) {
        const int r = ML + nw, rc = nw;
        const GAS v2u* xr = (const GAS v2u*)(X + (size_t)r * D) + F.lane;
#pragma unroll
        for (int j = 0; j < 8; ++j) r0[j] = xr[64 * j];
        if (slab_gate != nullptr) { const GAS f32x4* sl = (const GAS f32x4*)((const float*)(a.ws + WS_SLAB) + (size_t)rc * D) + F.lane;
#pragma unroll
            for (int j = 0; j < 8; ++j) { const f32x4 p = (sl[64 * j] + sl[64 * j + (size_t)MC * D / 4]) + (sl[64 * j + 2 * ((size_t)MC * D / 4)] + sl[64 * j + 3 * ((size_t)MC * D / 4)]);
                const f32x4 x = (f32x4){xlo(r0[j].x), xhi(r0[j].x), xlo(r0[j].y), xhi(r0[j].y)} + *(const GAS f32x4*)(slab_gate + 256 * j + 4 * F.lane) * p;
                v2u w; w.x = xpk2(x[0], x[1]); w.y = xpk2(x[2], x[3]); ((GAS v2u*)(X + (size_t)r * D) + F.lane)[64 * j] = w; r0[j] = w; } }
        NR_FINISH(r0, r, 4);
    }
    __syncthreads();
#undef NR_LOAD
#undef NR_FINISH
}

template <bool HG>
__device__ __forceinline__ void readout_phase(const Args& a, Frame& F, const float* gain, int nrows) {
    relaunder(F);
    const int gw = F.vcu * NWAVES + F.wave, NGW = F.G * NWAVES;
    const bf16* OF = (const bf16*)(a.ws + WS_OF); const bf16* OB = (const bf16*)(a.ws + WS_OB);
    const bf16* G = (const bf16*)(a.ws + WS_ACT) + (size_t)(HG ? 6 : 3) * ACT_STRIDE; bf16* HN = (bf16*)(a.ws + WS_HN);
    for (int r = gw; r < nrows; r += NGW) {
        const GAS v2u* f = (const GAS v2u*)(OF + (size_t)r * D) + F.lane; const GAS v2u* bk = (const GAS v2u*)(OB + (size_t)r * D) + F.lane;
        const GAS v2u* g8 = (const GAS v2u*)(G + (size_t)r * D) + F.lane;
        f32x4 v[8]; float ssj[8]; float tot = 0.f;
#pragma unroll
        for (int j = 0; j < 8; ++j) { const v2u fa = EW_NT ? __builtin_nontemporal_load(f + 64 * j) : f[64 * j], fb = EW_NT ? __builtin_nontemporal_load(bk + 64 * j) : bk[64 * j]; v[j] = (f32x4){bflo(fa.x) + bflo(fb.x), bfhi(fa.x) + bfhi(fb.x), bflo(fa.y) + bflo(fb.y), bfhi(fa.y) + bfhi(fb.y)}; ssj[j] = (v[j][0] * v[j][0] + v[j][1] * v[j][1]) + (v[j][2] * v[j][2] + v[j][3] * v[j][3]); tot += ssj[j]; }
        float rs_all = 0.f;
        if (HG) rs_all = 1.0f / sqrtf(wave_sum(tot) * (1.0f / D) + EPS);
        GAS v2u* o8 = (GAS v2u*)(HN + (size_t)r * D) + F.lane;
#pragma unroll
        for (int j = 0; j < 8; ++j) {
            float rs = rs_all; f32x4 gn = {1.f, 1.f, 1.f, 1.f};
            if (!HG) rs = 1.0f / sqrtf(wave_sum(ssj[j]) * (1.0f / 256.0f) + EPS);
            else gn = *(const GAS f32x4*)(gain + 256 * j + 4 * F.lane);
            const v2u gw2 = EW_NT ? __builtin_nontemporal_load(g8 + 64 * j) : g8[64 * j];
            const f32x4 gt = {bflo(gw2.x), bfhi(gw2.x), bflo(gw2.y), bfhi(gw2.y)};
            const f32x4 y = (v[j] * rs) * gn * gt;
            v2u w; w.x = pk2(y[0], y[1]); w.y = pk2(y[2], y[3]); o8[64 * j] = w; }
    }
}
template <bool HG>
__device__ __forceinline__ void readout_phase2(const Args& a, Frame& F, const float* gain, int nrows) {
    relaunder(F);
    const int nw = F.vcu * NWAVES + F.wave;
    const bf16* OF = (const bf16*)(a.ws + WS_OF); const bf16* OB = (const bf16*)(a.ws + WS_OB);
    const bf16* G = (const bf16*)(a.ws + WS_ACT) + (size_t)(HG ? 6 : 3) * ACT_STRIDE; bf16* HN = (bf16*)(a.ws + WS_HN);
    LAS float* GL = (LAS float*)F.lds;
    v2u f0[8], b0[8], g0[8], f1[8], b1[8], g1[8], f2[8], b2[8], g2[8];
#define RO_LOAD(fs, bs, gs, r_) do { const size_t o_ = (size_t)(r_) * D; const GAS v2u* f_ = (const GAS v2u*)(OF + o_) + F.lane; const GAS v2u* k_ = (const GAS v2u*)(OB + o_) + F.lane; const GAS v2u* q_ = (const GAS v2u*)(G + o_) + F.lane; \
        _Pragma("unroll") for (int j = 0; j < 8; ++j) { fs[j] = __builtin_nontemporal_load(f_ + 64 * j); bs[j] = __builtin_nontemporal_load(k_ + 64 * j); gs[j] = __builtin_nontemporal_load(q_ + 64 * j); } } while (0)
#define RO_FINISH(fs, bs, gs, r_) do { f32x4 v[8]; float ssj[8]; float tot = 0.f; \
        _Pragma("unroll") for (int j = 0; j < 8; ++j) { v[j] = (f32x4){bflo(fs[j].x) + bflo(bs[j].x), bfhi(fs[j].x) + bfhi(bs[j].x), bflo(fs[j].y) + bflo(bs[j].y), bfhi(fs[j].y) + bfhi(bs[j].y)}; \
            ssj[j] = (v[j][0] * v[j][0] + v[j][1] * v[j][1]) + (v[j][2] * v[j][2] + v[j][3] * v[j][3]); tot += ssj[j]; } \
        float rs_all = 0.f; if (HG) rs_all = 1.0f / sqrtf(wave_sum(tot) * (1.0f / D) + EPS); \
        GAS v2u* o8 = (GAS v2u*)(HN + (size_t)(r_) * D) + F.lane; \
        _Pragma("unroll") for (int j = 0; j < 8; ++j) { float rs = rs_all; f32x4 gn = {1.f, 1.f, 1.f, 1.f}; \
            if (!HG) rs = 1.0f / sqrtf(wave_sum(ssj[j]) * (1.0f / 256.0f) + EPS); else gn = *(const LAS f32x4*)(GL + 256 * j + 4 * F.lane); \
            const f32x4 gt = {bflo(gs[j].x), bfhi(gs[j].x), bflo(gs[j].y), bfhi(gs[j].y)}; const f32x4 y = (v[j] * rs) * gn * gt; \
            v2u w; w.x = pk2(y[0], y[1]); w.y = pk2(y[2], y[3]); o8[64 * j] = w; } } while (0)
    RO_LOAD(f0, b0, g0, nw); RO_LOAD(f1, b1, g1, nw + 2048); RO_LOAD(f2, b2, g2, nw + 2 * 2048);
    if (HG) { for (int q = F.tid; q < D / 4; q += NWAVES * 64) ((LAS f32x4*)GL)[q] = ((const GAS f32x4*)gain)[q];
              asm volatile("s_waitcnt lgkmcnt(0)" ::: "memory"); __builtin_amdgcn_s_barrier(); asm volatile("" ::: "memory"); }
    RO_FINISH(f0, b0, g0, nw);            RO_LOAD(f0, b0, g0, nw + 3 * 2048);
    RO_FINISH(f1, b1, g1, nw + 2048);     RO_LOAD(f1, b1, g1, nw + 4 * 2048);
    RO_FINISH(f2, b2, g2, nw + 2 * 2048); RO_LOAD(f2, b2, g2, nw + 5 * 2048);
    RO_FINISH(f0, b0, g0, nw + 3 * 2048); RO_LOAD(f0, b0, g0, nw + 6 * 2048);
    RO_FINISH(f1, b1, g1, nw + 4 * 2048); RO_LOAD(f1, b1, g1, nw + 7 * 2048);
    RO_FINISH(f2, b2, g2, nw + 5 * 2048);
    const bool cx = ML + nw < nrows;
    RO_LOAD(f2, b2, g2, cx ? ML + nw : nw + 7 * 2048);
    RO_FINISH(f0, b0, g0, nw + 6 * 2048);
    RO_FINISH(f1, b1, g1, nw + 7 * 2048);
    if (cx) RO_FINISH(f2, b2, g2, ML + nw);
    if (HG) __syncthreads();
#undef RO_LOAD
#undef RO_FINISH
}
__device__ __forceinline__ void final_norm_phase2(const Args& a, Frame& F) {
    relaunder(F);
    const int nw = F.vcu * NWAVES + F.wave;
    const bf16* X = (const bf16*)(a.ws + WS_X); const float* gain = a.in[17];
    LAS float* GL = (LAS float*)F.lds;
    v2u r0[8], r1[8], r2[8], r3[8], r4[8], r5[8], r6[8], r7[8];
#define FN_LOAD(dst, k_) do { const GAS v2u* xr_ = (const GAS v2u*)(X + (size_t)(nw + 2048 * (k_)) * D) + F.lane; \
        _Pragma("unroll") for (int j = 0; j < 8; ++j) dst[j] = __builtin_nontemporal_load(xr_ + 64 * j); } while (0)
#define FN_FINISH(raw, k_) do { float ss_ = 0.f; f32x4 v[8]; \
        _Pragma("unroll") for (int j = 0; j < 8; ++j) { v[j] = (f32x4){xlo(raw[j].x), xhi(raw[j].x), xlo(raw[j].y), xhi(raw[j].y)}; ss_ += (v[j][0] * v[j][0] + v[j][1] * v[j][1]) + (v[j][2] * v[j][2] + v[j][3] * v[j][3]); } \
        const float rstd_ = 1.0f / sqrtf(wave_sum(ss_) * (1.0f / D) + EPS); \
        GAS f32x4* o_ = (GAS f32x4*)(a.out + (size_t)(nw + 2048 * (k_)) * D) + F.lane; \
        _Pragma("unroll") for (int j = 0; j < 8; ++j) o_[64 * j] = (v[j] * rstd_) * *(const LAS f32x4*)(GL + 256 * j + 4 * F.lane); } while (0)
    FN_LOAD(r0, 0); FN_LOAD(r1, 1); FN_LOAD(r2, 2); FN_LOAD(r3, 3); FN_LOAD(r4, 4); FN_LOAD(r5, 5); FN_LOAD(r6, 6); FN_LOAD(r7, 7);
    for (int q = F.tid; q < D / 4; q += NWAVES * 64) ((LAS f32x4*)GL)[q] = ((const GAS f32x4*)gain)[q];
    asm volatile("s_waitcnt lgkmcnt(0)" ::: "memory"); __builtin_amdgcn_s_barrier(); asm volatile("" ::: "memory");
    FN_FINISH(r0, 0); FN_FINISH(r1, 1); FN_FINISH(r2, 2); FN_FINISH(r3, 3); FN_FINISH(r4, 4); FN_FINISH(r5, 5); FN_FINISH(r6, 6); FN_FINISH(r7, 7);
#undef FN_LOAD
#undef FN_FINISH
}
__device__ __forceinline__ void final_norm_phase(const Args& a, Frame& F) {
    relaunder(F);
    const int gw = F.vcu * NWAVES + F.wave, NGW = F.G * NWAVES;
    const bf16* X = (const bf16*)(a.ws + WS_X); const float* gain = a.in[17];
    for (int r = gw; r < ML; r += NGW) {
        const GAS v2u* xr = (const GAS v2u*)(X + (size_t)r * D) + F.lane;
        f32x4 v[8]; float ss = 0.f;
#pragma unroll
        for (int j = 0; j < 8; ++j) { const v2u w = xr[64 * j]; v[j] = (f32x4){xlo(w.x), xhi(w.x), xlo(w.y), xhi(w.y)}; ss += (v[j][0] * v[j][0] + v[j][1] * v[j][1]) + (v[j][2] * v[j][2] + v[j][3] * v[j][3]); }
        const float rstd = 1.0f / sqrtf(wave_sum(ss) * (1.0f / D) + EPS);
        GAS f32x4* o = (GAS f32x4*)(a.out + (size_t)r * D) + F.lane;
#pragma unroll
        for (int j = 0; j < 8; ++j) o[64 * j] = (v[j] * rstd) * *(const GAS f32x4*)(gain + 256 * j + 4 * F.lane);
    }
}

template <bool HG>
__device__ __forceinline__ void mixer_phase(const Args& a, Frame& F, int j_layer, bool ctx_out) {
    relaunder(F);
    constexpr int DPL = HG ? 2 : 4, HD = HG ? 128 : 256, NH = HG ? 16 : 8, NEB = HD / 64, CH = 32;
    constexpr int QB = CH * HD * 2;
    constexpr int NQ = HG ? 3 : 2;
    constexpr int VB_OFF = NQ * QB, BUF = VB_OFF + CH * 128;
    static_assert(2 * BUF <= RING_BYTES, "mixer LDS");
    const bf16* act = (const bf16*)(a.ws + WS_ACT);
    const int lane = F.lane, w = F.wave, tid = F.tid;
    for (int task = F.vcu; task < BATCH * NH * 2 * NEB; task += F.G) {
        const int eb = task % NEB, dir = (task / NEB) & 1, h = (task / (2 * NEB)) % NH, b = task / (2 * NEB * NH);
        bf16* O = (bf16*)(a.ws + (dir ? WS_OB : WS_OF));
        const bf16* src0 = act;
        const bf16* src1 = act + (size_t)(HG ? (1 + 2 * dir) : 1) * ACT_STRIDE;
        const bf16* src2 = act + (size_t)(2 + 2 * dir) * ACT_STRIDE;
        const bf16* srcv = act + (size_t)(HG ? 5 : 2) * ACT_STRIDE;
        float gamma = 0.f;
        if (!HG) { const float lg = a.in[10][(j_layer * 2 + dir) * 8 + h]; gamma = 1.0f / (1.0f + expf(-lg)); }
        float S[DPL][8];
#pragma unroll
        for (int i = 0; i < DPL; ++i)
#pragma unroll
            for (int jj = 0; jj < 8; ++jj) S[i][jj] = 0.f;
        constexpr int NCH = (CTXL + SEQ) / CH;
        constexpr int NPQ = HG ? 1 : 2;
        v4u rq[NQ][NPQ]; v4u rv = {0u, 0u, 0u, 0u};
#define MIX_ROWLO(c) (((c) < CTXL / CH) ? (ML + b * CTXL + (dir ? (CTXL / CH - 1 - (c)) : (c)) * CH) : (b * SEQ + (dir ? (SEQ / CH - 1 - ((c) - CTXL / CH)) : ((c) - CTXL / CH)) * CH))
#define MIX_LOAD(c) do { const int rlo_ = MIX_ROWLO(c); \
        _Pragma("unroll") for (int p_ = 0; p_ < NPQ; ++p_) { const int pc_ = tid + 512 * p_; const int row_ = HG ? (pc_ >> 4) : (pc_ >> 5), cc_ = HG ? (pc_ & 15) : (pc_ & 31); \
            const size_t go_ = (size_t)(rlo_ + row_) * D + h * HD + cc_ * 8; \
            rq[0][p_] = *(const GAS v4u*)(src0 + go_); rq[1][p_] = *(const GAS v4u*)(src1 + go_); if (HG) rq[NQ - 1][p_] = *(const GAS v4u*)(src2 + go_); } \
        if (tid < 256) { const int row_ = tid >> 3, cc_ = tid & 7; rv = *(const GAS v4u*)(srcv + (size_t)(rlo_ + row_) * D + h * HD + eb * 64 + cc_ * 8); } } while (0)
#define MIX_STORE(bufp) do { \
        _Pragma("unroll") for (int p_ = 0; p_ < NPQ; ++p_) { const int pc_ = tid + 512 * p_; \
            _Pragma("unroll") for (int q_ = 0; q_ < NQ; ++q_) *(LAS v4u*)((bufp) + q_ * QB + pc_ * 16) = rq[q_][p_]; } \
        if (tid < 256) *(LAS v4u*)((bufp) + VB_OFF + tid * 16) = rv; } while (0)
        __syncthreads();
        MIX_LOAD(0); MIX_STORE(F.lds);
        __syncthreads();
        for (int c = 0; c < NCH; ++c) {
            LAS unsigned char* cur = F.lds + (c & 1) * BUF; LAS unsigned char* nxt = F.lds + ((c + 1) & 1) * BUF;
            if (c + 1 < NCH) MIX_LOAD(c + 1);
            const int rlo = MIX_ROWLO(c);
            const bool do_out = ctx_out || c >= CTXL / CH;
#pragma unroll 2
            for (int s = 0; s < CH; ++s) {
                const int lrow = dir ? (CH - 1 - s) : s;
                float q[DPL], k[DPL], f[DPL];
                if (HG) {
                    const unsigned qw = *(const LAS unsigned*)(cur + lrow * 256 + lane * 4), lw = *(const LAS unsigned*)(cur + QB + lrow * 256 + lane * 4), kw = *(const LAS unsigned*)(cur + 2 * QB + lrow * 256 + lane * 4);
                    q[0] = bflo(qw); q[1] = bfhi(qw); f[0] = __expf(bflo(lw)); f[1] = __expf(bfhi(lw)); k[0] = bflo(kw); k[1] = bfhi(kw);
                } else {
                    const v2u qw = *(const LAS v2u*)(cur + lrow * 512 + lane * 8), kw = *(const LAS v2u*)(cur + QB + lrow * 512 + lane * 8);
                    q[0] = bflo(qw.x); q[1] = bfhi(qw.x); q[DPL - 2] = bflo(qw.y); q[DPL - 1] = bfhi(qw.y);
                    k[0] = bflo(kw.x); k[1] = bfhi(kw.x); k[DPL - 2] = bflo(kw.y); k[DPL - 1] = bfhi(kw.y);
#pragma unroll
                    for (int i = 0; i < DPL; ++i) f[i] = gamma;
                }
                const v4u vw = *(const LAS v4u*)(cur + VB_OFF + lrow * 128 + w * 16);
                const float v[8] = {bflo(vw.x), bfhi(vw.x), bflo(vw.y), bfhi(vw.y), bflo(vw.z), bfhi(vw.z), bflo(vw.w), bfhi(vw.w)};
                float p[8];
#pragma unroll
                for (int jj = 0; jj < 8; ++jj) {
                    float acc = 0.f;
#pragma unroll
                    for (int i = 0; i < DPL; ++i) { S[i][jj] = fmaf(f[i], S[i][jj], k[i] * v[jj]); acc = fmaf(q[i], S[i][jj], acc); }
                    p[jj] = acc;
                }
                if (do_out) {
                    const bool h1 = (lane & 32) != 0, h2 = (lane & 16) != 0, h3 = (lane & 8) != 0;
                    float a4[4], a2[2];
#pragma unroll
                    for (int jj = 0; jj < 4; ++jj) { const float snd = h1 ? p[jj] : p[jj + 4]; const float rcv = __shfl_xor(snd, 32); a4[jj] = (h1 ? p[jj + 4] : p[jj]) + rcv; }
#pragma unroll
                    for (int jj = 0; jj < 2; ++jj) { const float snd = h2 ? a4[jj] : a4[jj + 2]; const float rcv = __shfl_xor(snd, 16); a2[jj] = (h2 ? a4[jj + 2] : a4[jj]) + rcv; }
                    float r1; { const float snd = h3 ? a2[0] : a2[1]; const float rcv = __shfl_xor(snd, 8); r1 = (h3 ? a2[1] : a2[0]) + rcv; }
                    r1 += __shfl_xor(r1, 4); r1 += __shfl_xor(r1, 2); r1 += __shfl_xor(r1, 1);
                    if ((lane & 7) == 0) O[(size_t)(rlo + lrow) * D + h * HD + eb * 64 + w * 8 + (lane >> 3)] = (bf16)f2bf(r1);
                }
            }
            if (c + 1 < NCH) MIX_STORE(nxt);
            __syncthreads();
        }
#undef MIX_ROWLO
#undef MIX_LOAD
#undef MIX_STORE
    }
}


typedef short mx_bf16x8 __attribute__((ext_vector_type(8)));
typedef short mx_s4 __attribute__((ext_vector_type(4)));
#ifndef MX_SWZ
#define MX_SWZ 0
#endif
constexpr int MX_PS = MX_SWZ ? 128 : 144;
__device__ __forceinline__ int sw16(int row) { return MX_SWZ ? 2 * (row & 3) + 8 * ((row >> 3) & 1) : 0; }
__device__ __forceinline__ int sw8(int row) { return MX_SWZ ? (row >> 1) & 7 : 0; }
__device__ __forceinline__ mx_bf16x8 frag_row(const LAS unsigned char* img, int stride, int row0, int k0, int lane) {
    const int row = row0 + (lane & 15);
    return *(const LAS mx_bf16x8*)(img + row * stride + 16 * (((k0 >> 3) + (lane >> 4)) ^ sw16(row)));
}
__device__ __forceinline__ mx_bf16x8 frag_row8(const LAS unsigned char* img, int row0, int k0, int lane) {
    const int row = row0 + (lane & 15);
    return *(const LAS mx_bf16x8*)(img + row * MX_PS + 16 * (((k0 >> 3) + (lane >> 4)) ^ sw8(row)));
}
__device__ __forceinline__ mx_bf16x8 frag_tr(const LAS unsigned char* img, int stride, int k0, int c0, int lane) {
    const int g = lane >> 4, i = lane & 15, q = i >> 2, p = i & 3;
    const int row = k0 + 8 * g + q;
    const LAS unsigned char* ad = img + row * stride + 16 * (((c0 >> 3) + (p >> 1)) ^ sw16(row)) + 8 * (p & 1);
    const mx_s4 x = __builtin_amdgcn_ds_read_tr16_b64_v4i16((LAS mx_s4*)ad);
    const mx_s4 y = __builtin_amdgcn_ds_read_tr16_b64_v4i16((LAS mx_s4*)(ad + 4 * stride));
    return (mx_bf16x8){x[0], x[1], x[2], x[3], y[0], y[1], y[2], y[3]};
}
#define MX_MFMA(a, b, c) __builtin_amdgcn_mfma_f32_16x16x32_bf16((a), (b), (c), 0, 0, 0)
#define MX_BAR() do { asm volatile("s_waitcnt lgkmcnt(0)" ::: "memory"); __builtin_amdgcn_s_barrier(); if (MXP_BAR > 1) __builtin_amdgcn_s_barrier(); asm volatile("" ::: "memory"); } while (0)

template <bool HG, int VAR = 0>
__device__ __forceinline__ void mixer_mfma(const Args& a, Frame& F, int j_layer, bool ctx_out) {
    relaunder(F);
    float zf_ = 0.f; asm volatile("" : "+v"(zf_));
    const f32x4 ZERO4 = {zf_, zf_, zf_, zf_};
    constexpr int HD = HG ? 128 : 256, NH = HG ? 16 : 8, NEB = HD / 64, C = 64, NCTX = CTXL / C, NCH = (CTXL + SEQ) / C;
    constexpr int KS = HD / 32;
    constexpr int DT = HD / 128;
    constexpr int QS = HD * 2 + (MX_SWZ ? 0 : 16);
    constexpr int IMG = 64 * QS;
    constexpr int PS = MX_PS;
    constexpr int NI = HG ? 4 : 2;
    constexpr int O_VT = NI * IMG, O_P = O_VT + 64 * PS, O_ST = O_P + 64 * PS, O_TOT = O_ST + IMG, O_END = O_TOT + 4 * 128 * 4 + 128 * 4;
    static_assert(O_END <= RING_BYTES, "mixer LDS");
    const int lane = F.lane, w = F.wave, tid = F.tid, g = lane >> 4, i = lane & 15;
    const int rg = w >> 1, cg = w & 1, nq0 = 16 * rg;
    LAS unsigned char* const L = F.lds;
    const bf16* act = (const bf16*)(a.ws + WS_ACT);
    for (int task = F.vcu; task < BATCH * NH * 2 * NEB; task += F.G) {
        const int eb = task % NEB, dir = (task / NEB) & 1, h = (task / (2 * NEB)) % NH, b = task / (2 * NEB * NH);
        bf16* O = (bf16*)(a.ws + (dir ? WS_OB : WS_OF));
        const bf16* src0 = act;
        const bf16* src1 = act + (size_t)(HG ? (2 + 2 * dir) : 1) * ACT_STRIDE;
        const bf16* src2 = act + (size_t)(1 + 2 * dir) * ACT_STRIDE;
        const bf16* srcv = act + (size_t)(HG ? 5 : 2) * ACT_STRIDE;
        float lg2 = 0.f;
        if (!HG) { const float x = a.in[10][(j_layer * 2 + dir) * 8 + h]; lg2 = -log1pf(expf(-x)) * 1.4426950408889634f; }
        const float r1 = HG ? 1.f : exp2f((float)(nq0 + i - 63) * lg2), r2 = HG ? 1.f : exp2f((float)(nq0 + i + 1) * lg2), cdec = HG ? 1.f : exp2f(64.f * lg2);
        const int vrow = tid & 63, vcc = tid >> 6;
        const int vs = dir ? 63 - vrow : vrow;
        const float kdec = HG ? 1.f : exp2f((float)(63 - vs) * lg2);
        f32x4 accS[DT][4];
#pragma unroll
        for (int td = 0; td < DT; ++td)
#pragma unroll
            for (int te = 0; te < 4; ++te) accS[td][te] = ZERO4;
        constexpr int NPQ = HG ? 2 : 4;
        constexpr int PF = HG ? MX_PF_HG : MX_PF_RET;
        static_assert(NCH % PF == 0, "prefetch depth must divide the chunk count");
        v4u rq[PF][HG ? 3 : 2][NPQ]; v4u rv[PF];
#define MX_ROWLO(c) (((c) < NCTX) ? (ML + b * CTXL + (dir ? (NCTX - 1 - (c)) : (c)) * C) : (b * SEQ + (dir ? (SEQ / C - 1 - ((c) - NCTX)) : ((c) - NCTX)) * C))
#define MX_LOAD(c, SET) do { const int rlo_ = (VAR & 1) ? MX_ROWLO(0) : MX_ROWLO(c); \
        _Pragma("unroll") for (int p_ = 0; p_ < NPQ; ++p_) { const int pc_ = tid + 512 * p_; const int row_ = pc_ / (HD / 8), cc_ = pc_ % (HD / 8); \
            const size_t go_ = (size_t)(rlo_ + row_) * D + h * HD + cc_ * 8; \
            rq[SET][0][p_] = *(const GAS v4u*)(src0 + go_); rq[SET][1][p_] = *(const GAS v4u*)(src1 + go_); if (HG) rq[SET][HG ? 2 : 1][p_] = *(const GAS v4u*)(src2 + go_); } \
        rv[SET] = *(const GAS v4u*)(srcv + (size_t)(rlo_ + vrow) * D + h * HD + eb * 64 + vcc * 8); } while (0)
#define MX_STAGE(SET) do { \
        _Pragma("unroll") for (int p_ = 0; p_ < NPQ; ++p_) { const int pc_ = tid + 512 * p_; const int row_ = pc_ / (HD / 8), cc_ = pc_ % (HD / 8); const int s_ = dir ? 63 - row_ : row_; \
            const int so_ = s_ * QS + 16 * (cc_ ^ sw16(s_)); *(LAS v4u*)(L + so_) = rq[SET][0][p_]; *(LAS v4u*)(L + IMG + so_) = rq[SET][1][p_]; if (HG) *(LAS v4u*)(L + 2 * IMG + so_) = rq[SET][HG ? 2 : 1][p_]; } \
        { const unsigned vw_[4] = {rv[SET].x, rv[SET].y, rv[SET].z, rv[SET].w}; \
          _Pragma("unroll") for (int jj_ = 0; jj_ < 4; ++jj_) { \
              *(LAS unsigned short*)(L + O_VT + (vcc * 8 + 2 * jj_) * PS + 16 * ((vs >> 3) ^ sw8(vcc * 8 + 2 * jj_)) + (vs & 7) * 2) = (unsigned short)(pk2(bflo(vw_[jj_]) * kdec, bfhi(vw_[jj_]) * kdec) & 0xffffu); \
              *(LAS unsigned short*)(L + O_VT + (vcc * 8 + 2 * jj_ + 1) * PS + 16 * ((vs >> 3) ^ sw8(vcc * 8 + 2 * jj_ + 1)) + (vs & 7) * 2) = (unsigned short)(pk2(bflo(vw_[jj_]) * kdec, bfhi(vw_[jj_]) * kdec) >> 16); } } } while (0)
        __syncthreads();
        for (int u = tid; u < IMG / 16; u += NWAVES * 64) { const unsigned zu_ = __builtin_bit_cast(unsigned, zf_); *(LAS v4u*)(L + O_ST + u * 16) = (v4u){zu_, zu_, zu_, zu_}; }
#pragma unroll
        for (int u = 0; u < PF; ++u) MX_LOAD(u, u);
        for (int c0 = 0; c0 < NCH; c0 += PF)
#pragma unroll
        for (int u = 0; u < PF; ++u) {
            const int c = c0 + u;
            MX_STAGE(u);
            if (MXP_STG > 1) { asm volatile("" ::: "memory"); MX_STAGE(u); }
            if (HG) {
                MX_BAR();
                const int d = tid & 127, qr = tid >> 7;
                float cl[16], qv[16], kv[16]; float run = 0.f;
#pragma unroll
                for (int ii = 0; ii < 16; ++ii) { const int s = 16 * qr + ii;
                    const int eo = s * QS + 16 * ((d >> 3) ^ sw16(s)) + (d & 7) * 2;
                    run += bflo((unsigned)*(const LAS unsigned short*)(L + 2 * IMG + eo)); cl[ii] = run;
                    qv[ii] = bflo((unsigned)*(const LAS unsigned short*)(L + eo)); kv[ii] = bflo((unsigned)*(const LAS unsigned short*)(L + IMG + eo)); }
                LAS float* tot = (LAS float*)(L + O_TOT);
                tot[qr * 128 + d] = run;
                MX_BAR();
                const float t0 = tot[d], t1 = tot[128 + d], t2 = tot[256 + d], t3 = tot[384 + d];
                const float off = (qr == 0) ? 0.f : (qr == 1) ? t0 : (qr == 2) ? (t0 + t1) : (t0 + t1 + t2);
                const float cref = t0 + t1, cend = (t0 + t1) + (t2 + t3);
                if (qr == 0) tot[512 + d] = cend;
#pragma unroll
                for (int ii = 0; ii < 16; ++ii) { const int s = 16 * qr + ii; const float cm = off + cl[ii]; const int eo = s * QS + 16 * ((d >> 3) ^ sw16(s)) + (d & 7) * 2;
                    const float e1 = __expf(fminf(cm - cref, 80.f)), e2 = __expf(fminf(cref - cm, 80.f)), e3 = __expf(cm), e4 = __expf(cend - cm);
                    const unsigned w12 = pk2(qv[ii] * e1, kv[ii] * e2), w34 = pk2(qv[ii] * e3, kv[ii] * e4);
                    *(LAS unsigned short*)(L + eo) = (unsigned short)(w12 & 0xffffu);
                    *(LAS unsigned short*)(L + IMG + eo) = (unsigned short)(w12 >> 16);
                    *(LAS unsigned short*)(L + 2 * IMG + eo) = (unsigned short)(w34 & 0xffffu);
                    *(LAS unsigned short*)(L + 3 * IMG + eo) = (unsigned short)(w34 >> 16); }
            }
            MX_BAR();
            { const int cn = (c + PF < NCH) ? c + PF : NCH - 1; MX_LOAD(cn, u); }
            if (MXP_SLEEP > 0) __builtin_amdgcn_s_sleep(MXP_SLEEP);
            const int rlo = MX_ROWLO(c);
            const bool do_out = ctx_out || c >= NCTX;
            mx_bf16x8 aq[KS];
            if (do_out) {
#pragma unroll
                for (int ks = 0; ks < KS; ++ks) aq[ks] = frag_row(L, QS, nq0, 32 * ks, lane);
                for (int rep1 = 0; rep1 < MXP_S1; ++rep1) {
                f32x4 pt0 = ZERO4, pt1 = ZERO4;
#pragma unroll
                for (int kb = 0; kb < KS; kb += 4) {
                    mx_bf16x8 kf[2][4];
#pragma unroll
                    for (int ks = 0; ks < 4; ++ks) { kf[0][ks] = frag_row(L + IMG, QS, 32 * cg, 32 * (kb + ks), lane); kf[1][ks] = frag_row(L + IMG, QS, 32 * cg + 16, 32 * (kb + ks), lane); }
                    __builtin_amdgcn_sched_barrier(0);
#pragma unroll
                    for (int ks = 0; ks < 4; ++ks) { pt0 = MX_MFMA(kf[0][ks], aq[kb + ks], pt0); pt1 = MX_MFMA(kf[1][ks], aq[kb + ks], pt1); }
                    __builtin_amdgcn_sched_barrier(0);
                }
                const int m0 = 32 * cg + 4 * g, n = nq0 + i;
                v2u pw; pw.x = pk2((m0 <= n) ? pt0[0] : 0.f, (m0 + 1 <= n) ? pt0[1] : 0.f); pw.y = pk2((m0 + 2 <= n) ? pt0[2] : 0.f, (m0 + 3 <= n) ? pt0[3] : 0.f);
                *(LAS v2u*)(L + O_P + n * PS + 16 * ((m0 >> 3) ^ sw8(n)) + (m0 & 7) * 2) = pw;
                const int m1 = m0 + 16;
                pw.x = pk2((m1 <= n) ? pt1[0] : 0.f, (m1 + 1 <= n) ? pt1[1] : 0.f); pw.y = pk2((m1 + 2 <= n) ? pt1[2] : 0.f, (m1 + 3 <= n) ? pt1[3] : 0.f);
                *(LAS v2u*)(L + O_P + n * PS + 16 * ((m1 >> 3) ^ sw8(n)) + (m1 & 7) * 2) = pw;
                }
            }
            {
                mx_bf16x8 vt[4][2], ak[DT][2]; f32x4 dec[DT];
#pragma unroll
                for (int te = 0; te < 4; ++te) { vt[te][0] = frag_row8(L + O_VT, 16 * te, 0, lane); vt[te][1] = frag_row8(L + O_VT, 16 * te, 32, lane); }
#pragma unroll
                for (int td = 0; td < DT; ++td) { const int d0 = 16 * (DT * w + td);
                    ak[td][0] = frag_tr(L + (HG ? 3 : 1) * IMG, QS, 0, d0, lane); ak[td][1] = frag_tr(L + (HG ? 3 : 1) * IMG, QS, 32, d0, lane);
                    dec[td] = (f32x4){cdec, cdec, cdec, cdec};
                    if (HG) { const f32x4 ce = *(const LAS f32x4*)(L + O_TOT + 2048 + (d0 + 4 * g) * 4); dec[td] = (f32x4){__expf(ce[0]), __expf(ce[1]), __expf(ce[2]), __expf(ce[3])}; } }
                __builtin_amdgcn_sched_barrier(0);
#pragma unroll
                for (int td = 0; td < DT; ++td)
#pragma unroll
                    for (int te = 0; te < 4; ++te) accS[td][te] = MX_MFMA(ak[td][0], vt[te][0], accS[td][te] * dec[td]);
#pragma unroll
                for (int td = 0; td < DT; ++td)
#pragma unroll
                    for (int te = 0; te < 4; ++te) accS[td][te] = MX_MFMA(ak[td][1], vt[te][1], accS[td][te]);
            }
            MX_BAR();
            if (do_out) {
                if (HG) {
#pragma unroll
                    for (int ks = 0; ks < KS; ++ks) aq[ks] = frag_row(L + 2 * IMG, QS, nq0, 32 * ks, lane);
                }
                mx_bf16x8 vo[2][2];
                const mx_bf16x8 bp0 = frag_row8(L + O_P, nq0, 0, lane), bp1 = frag_row8(L + O_P, nq0, 32, lane);
#pragma unroll
                for (int te = 0; te < 2; ++te) { vo[te][0] = frag_row8(L + O_VT, 32 * cg + 16 * te, 0, lane); vo[te][1] = frag_row8(L + O_VT, 32 * cg + 16 * te, 32, lane); }
                const int grow = rlo + (dir ? 63 - (nq0 + i) : (nq0 + i));
                for (int rep2 = 0; rep2 < MXP_S2; ++rep2) {
                f32x4 o1a = ZERO4, o1b = o1a, o2a = o1a, o2b = o1a;
#pragma unroll
                for (int kb = 0; kb < KS; kb += 4) {
                    mx_bf16x8 st[2][4];
#pragma unroll
                    for (int ks = 0; ks < 4; ++ks) { st[0][ks] = frag_row(L + O_ST, QS, 32 * cg, 32 * (kb + ks), lane); st[1][ks] = frag_row(L + O_ST, QS, 32 * cg + 16, 32 * (kb + ks), lane); }
                    __builtin_amdgcn_sched_barrier(0);
                    if (kb == 0) { o1a = MX_MFMA(vo[0][0], bp0, o1a); o1b = MX_MFMA(vo[1][0], bp0, o1b); o1a = MX_MFMA(vo[0][1], bp1, o1a); o1b = MX_MFMA(vo[1][1], bp1, o1b); }
#pragma unroll
                    for (int ks = 0; ks < 4; ++ks) { o2a = MX_MFMA(st[0][ks], aq[kb + ks], o2a); o2b = MX_MFMA(st[1][ks], aq[kb + ks], o2b); }
                    __builtin_amdgcn_sched_barrier(0);
                }
                bf16* op = O + (size_t)grow * D + h * HD + eb * 64 + 32 * cg + 4 * g;
                if (!(VAR & 2)) { const f32x4 ya = o1a * r1 + o2a * r2, yb = o1b * r1 + o2b * r2; v2u wa, wb; wa.x = pk2(ya[0], ya[1]); wa.y = pk2(ya[2], ya[3]); wb.x = pk2(yb[0], yb[1]); wb.y = pk2(yb[2], yb[3]);
                    *(GAS v2u*)(op) = wa; *(GAS v2u*)(op + 16) = wb; }
                else { asm volatile("" :: "v"(o1a), "v"(o1b), "v"(o2a), "v"(o2b)); }
                }
            }
            MX_BAR();
#pragma unroll
            for (int td = 0; td < DT; ++td)
#pragma unroll
                for (int te = 0; te < 4; ++te) { const int d0 = 16 * (DT * w + td); const f32x4 s = accS[td][te];
                    v2u sw; sw.x = pk2(s[0], s[1]); sw.y = pk2(s[2], s[3]);
                    *(LAS v2u*)(L + O_ST + (16 * te + i) * QS + 16 * (((d0 + 4 * g) >> 3) ^ sw16(16 * te + i)) + ((d0 + 4 * g) & 7) * 2) = sw; }
        }
#undef MX_ROWLO
#undef MX_LOAD
#undef MX_STAGE
    }
}

__device__ __forceinline__ void mixer_hg2(const Args& a, Frame& F, bool ctx_out) {
    relaunder(F);
    float zf_ = 0.f; asm volatile("" : "+v"(zf_));
    const f32x4 ZERO4 = {zf_, zf_, zf_, zf_};
    constexpr int HD = 128, NH = 16, NEB = 2, C = 64, NCTX = CTXL / C, NCH = (CTXL + SEQ) / C, KS = HD / 32;
    constexpr int QS = HD * 2 + 16, IMG = 64 * QS, PS = MX_PS;
    constexpr int O_VT = 3 * IMG, O_P = O_VT + 64 * PS, O_ST = O_P + 64 * PS, O_END = O_ST + IMG;
    static_assert(O_END <= RING_BYTES && MX_SWZ == 0, "mixer_hg2 LDS (padded images)");
    const int lane = F.lane, w = F.wave, tid = F.tid, g = lane >> 4, i = lane & 15;
    const int rg = w >> 1, cg = w & 1, nq0 = 16 * rg;
    LAS unsigned char* const L = F.lds;
    const bf16* act = (const bf16*)(a.ws + WS_ACT);
    mx_bf16x8 bt0, bt1;
#pragma unroll
    for (int j = 0; j < 8; ++j) { bt0[j] = (8 * g + j <= i) ? (short)0x3F80 : (short)0; bt1[j] = (8 * g + j <= 16 + i) ? (short)0x3F80 : (short)0; }
    for (int task = F.vcu; task < BATCH * NH * 2 * NEB; task += F.G) {
        const int eb = task % NEB, dir = (task / NEB) & 1, h = (task / (2 * NEB)) % NH, b = task / (2 * NEB * NH);
        bf16* O = (bf16*)(a.ws + (dir ? WS_OB : WS_OF));
        const bf16* src0 = act;
        const bf16* src1 = act + (size_t)(2 + 2 * dir) * ACT_STRIDE;
        const bf16* src2 = act + (size_t)(1 + 2 * dir) * ACT_STRIDE;
        const bf16* srcv = act + (size_t)5 * ACT_STRIDE;
        const int vrow = tid & 63, vcc = tid >> 6, vs = dir ? 63 - vrow : vrow;
        f32x4 accS[4];
#pragma unroll
        for (int te = 0; te < 4; ++te) accS[te] = ZERO4;
        constexpr int PF = MX_PF_HG;
        static_assert(NCH % PF == 0, "prefetch depth must divide the chunk count");
        v4u rq[PF][3][2]; v4u rv[PF];
#define H2_ROWLO(c) (((c) < NCTX) ? (ML + b * CTXL + (dir ? (NCTX - 1 - (c)) : (c)) * C) : (b * SEQ + (dir ? (SEQ / C - 1 - ((c) - NCTX)) : ((c) - NCTX)) * C))
#define H2_LOAD(c, SET) do { const int rlo_ = H2_ROWLO(c); \
        _Pragma("unroll") for (int p_ = 0; p_ < 2; ++p_) { const int pc_ = tid + 512 * p_; const size_t go_ = (size_t)(rlo_ + (pc_ >> 4)) * D + h * HD + (pc_ & 15) * 8; \
            rq[SET][0][p_] = *(const GAS v4u*)(src0 + go_); rq[SET][1][p_] = *(const GAS v4u*)(src1 + go_); rq[SET][2][p_] = *(const GAS v4u*)(src2 + go_); } \
        rv[SET] = *(const GAS v4u*)(srcv + (size_t)(rlo_ + vrow) * D + h * HD + eb * 64 + vcc * 8); } while (0)
#define H2_STAGE(SET) do { \
        _Pragma("unroll") for (int p_ = 0; p_ < 2; ++p_) { const int pc_ = tid + 512 * p_; const int row_ = pc_ >> 4; const int s_ = dir ? 63 - row_ : row_; const int so_ = s_ * QS + (pc_ & 15) * 16; \
            *(LAS v4u*)(L + so_) = rq[SET][0][p_]; *(LAS v4u*)(L + IMG + so_) = rq[SET][1][p_]; *(LAS v4u*)(L + 2 * IMG + so_) = rq[SET][2][p_]; } \
        { const unsigned vw_[4] = {rv[SET].x, rv[SET].y, rv[SET].z, rv[SET].w}; \
          _Pragma("unroll") for (int jj_ = 0; jj_ < 4; ++jj_) { \
              *(LAS unsigned short*)(L + O_VT + (vcc * 8 + 2 * jj_) * PS + vs * 2) = (unsigned short)(vw_[jj_] & 0xffffu); \
              *(LAS unsigned short*)(L + O_VT + (vcc * 8 + 2 * jj_ + 1) * PS + vs * 2) = (unsigned short)(vw_[jj_] >> 16); } } } while (0)
        __syncthreads();
#pragma unroll
        for (int u = 0; u < PF; ++u) H2_LOAD(u, u);
        for (int c0 = 0; c0 < NCH; c0 += PF)
#pragma unroll
        for (int u = 0; u < PF; ++u) {
            const int c = c0 + u;
            H2_STAGE(u);
            MX_BAR();
            { const int cn = (c + PF < NCH) ? c + PF : NCH - 1; H2_LOAD(cn, u); }
            f32x4 fe, fu;
            {
                unsigned one2_ = 0x3F803F80u; asm volatile("" : "+v"(one2_));
                typedef unsigned u4_ __attribute__((ext_vector_type(4)));
                const mx_bf16x8 ones = __builtin_bit_cast(mx_bf16x8, (u4_){one2_, one2_, one2_, one2_});
                const mx_bf16x8 a0 = frag_tr(L + 2 * IMG, QS, 0, 16 * w, lane), a1 = frag_tr(L + 2 * IMG, QS, 32, 16 * w, lane);
                const f32x4 z = ZERO4;
                f32x4 ct[4];
                ct[0] = MX_MFMA(a0, bt0, z); ct[1] = MX_MFMA(a0, bt1, z);
                const f32x4 cref = MX_MFMA(a0, ones, z);
                ct[2] = MX_MFMA(a1, bt0, cref); ct[3] = MX_MFMA(a1, bt1, cref);
                const f32x4 cend = MX_MFMA(a1, ones, cref);
                fe = (f32x4){__expf(cend[0]), __expf(cend[1]), __expf(cend[2]), __expf(cend[3])};
                fu = (f32x4){__expf(cend[0] - cref[0]), __expf(cend[1] - cref[1]), __expf(cend[2] - cref[2]), __expf(cend[3] - cref[3])};
                const f32x4 fs = {__expf(cref[0]), __expf(cref[1]), __expf(cref[2]), __expf(cref[3])};
#pragma unroll
                for (int te = 0; te < 4; ++te) { const f32x4 s = accS[te] * fs; v2u sw; sw.x = pk2(s[0], s[1]); sw.y = pk2(s[2], s[3]);
                    *(LAS v2u*)(L + O_ST + (16 * te + i) * QS + (16 * w + 4 * g) * 2) = sw; }
#pragma unroll
                for (int t = 0; t < 4; ++t) {
                    LAS unsigned char* pq = L + (16 * t + i) * QS + (16 * w + 4 * g) * 2;
                    const v2u qw = *(const LAS v2u*)pq, kw = *(const LAS v2u*)(pq + IMG);
                    f32x4 e1;
#pragma unroll
                    for (int r = 0; r < 4; ++r) e1[r] = __expf(fminf(fmaxf(ct[t][r] - cref[r], -80.f), 80.f));
                    const f32x4 e2 = {__builtin_amdgcn_rcpf(e1[0]), __builtin_amdgcn_rcpf(e1[1]), __builtin_amdgcn_rcpf(e1[2]), __builtin_amdgcn_rcpf(e1[3])};
                    v2u qo, ko;
                    qo.x = pk2(bflo(qw.x) * e1[0], bfhi(qw.x) * e1[1]); qo.y = pk2(bflo(qw.y) * e1[2], bfhi(qw.y) * e1[3]);
                    ko.x = pk2(bflo(kw.x) * e2[0], bfhi(kw.x) * e2[1]); ko.y = pk2(bflo(kw.y) * e2[2], bfhi(kw.y) * e2[3]);
                    *(LAS v2u*)pq = qo; *(LAS v2u*)(pq + IMG) = ko;
                }
            }
            MX_BAR();
            const int rlo = H2_ROWLO(c);
            const bool do_out = ctx_out || c >= NCTX;
            mx_bf16x8 aq[KS];
            {
                mx_bf16x8 kf[2][KS], vt[4][2];
                if (do_out) {
#pragma unroll
                    for (int ks = 0; ks < KS; ++ks) { aq[ks] = frag_row(L, QS, nq0, 32 * ks, lane); kf[0][ks] = frag_row(L + IMG, QS, 32 * cg, 32 * ks, lane); kf[1][ks] = frag_row(L + IMG, QS, 32 * cg + 16, 32 * ks, lane); }
                }
#pragma unroll
                for (int te = 0; te < 4; ++te) { vt[te][0] = frag_row8(L + O_VT, 16 * te, 0, lane); vt[te][1] = frag_row8(L + O_VT, 16 * te, 32, lane); }
                const mx_bf16x8 ak0 = frag_tr(L + IMG, QS, 0, 16 * w, lane), ak1 = frag_tr(L + IMG, QS, 32, 16 * w, lane);
                __builtin_amdgcn_sched_barrier(0);
                f32x4 pt0 = ZERO4, pt1 = ZERO4;
                if (do_out) {
#pragma unroll
                    for (int ks = 0; ks < KS; ++ks) { pt0 = MX_MFMA(kf[0][ks], aq[ks], pt0); pt1 = MX_MFMA(kf[1][ks], aq[ks], pt1); }
                }
                f32x4 uu[4];
#pragma unroll
                for (int te = 0; te < 4; ++te) { const f32x4 z4 = ZERO4; uu[te] = MX_MFMA(ak0, vt[te][0], z4); }
#pragma unroll
                for (int te = 0; te < 4; ++te) uu[te] = MX_MFMA(ak1, vt[te][1], uu[te]);
                __builtin_amdgcn_sched_barrier(0);
                if (do_out) {
                    const int m0 = 32 * cg + 4 * g, m1 = m0 + 16, n = nq0 + i;
                    v2u pw; pw.x = pk2((m0 <= n) ? pt0[0] : 0.f, (m0 + 1 <= n) ? pt0[1] : 0.f); pw.y = pk2((m0 + 2 <= n) ? pt0[2] : 0.f, (m0 + 3 <= n) ? pt0[3] : 0.f);
                    *(LAS v2u*)(L + O_P + n * PS + m0 * 2) = pw;
                    pw.x = pk2((m1 <= n) ? pt1[0] : 0.f, (m1 + 1 <= n) ? pt1[1] : 0.f); pw.y = pk2((m1 + 2 <= n) ? pt1[2] : 0.f, (m1 + 3 <= n) ? pt1[3] : 0.f);
                    *(LAS v2u*)(L + O_P + n * PS + m1 * 2) = pw;
                }
#pragma unroll
                for (int te = 0; te < 4; ++te) accS[te] = accS[te] * fe + uu[te] * fu;
            }
            mx_bf16x8 st[2][KS], vo[2][2];
            if (do_out) {
#pragma unroll
                for (int te = 0; te < 2; ++te)
#pragma unroll
                    for (int ks = 0; ks < KS; ++ks) st[te][ks] = frag_row(L + O_ST, QS, 32 * cg + 16 * te, 32 * ks, lane);
            }
            MX_BAR();
            if (do_out) {
                const mx_bf16x8 bp0 = frag_row8(L + O_P, nq0, 0, lane), bp1 = frag_row8(L + O_P, nq0, 32, lane);
#pragma unroll
                for (int te = 0; te < 2; ++te) { vo[te][0] = frag_row8(L + O_VT, 32 * cg + 16 * te, 0, lane); vo[te][1] = frag_row8(L + O_VT, 32 * cg + 16 * te, 32, lane); }
                __builtin_amdgcn_sched_barrier(0);
                f32x4 oa = ZERO4, ob = oa;
                oa = MX_MFMA(vo[0][0], bp0, oa); ob = MX_MFMA(vo[1][0], bp0, ob);
#pragma unroll
                for (int ks = 0; ks < KS; ++ks) { oa = MX_MFMA(st[0][ks], aq[ks], oa); ob = MX_MFMA(st[1][ks], aq[ks], ob); }
                oa = MX_MFMA(vo[0][1], bp1, oa); ob = MX_MFMA(vo[1][1], bp1, ob);
                bf16* op = O + (size_t)(rlo + (dir ? 63 - (nq0 + i) : (nq0 + i))) * D + h * HD + eb * 64 + 32 * cg + 4 * g;
                v2u wa, wb; wa.x = pk2(oa[0], oa[1]); wa.y = pk2(oa[2], oa[3]); wb.x = pk2(ob[0], ob[1]); wb.y = pk2(ob[2], ob[3]);
                *(GAS v2u*)(op) = wa; *(GAS v2u*)(op + 16) = wb;
            }
            MX_BAR();
        }
#undef H2_ROWLO
#undef H2_LOAD
#undef H2_STAGE
    }
}

__device__ __forceinline__ void mixer_ret3(const Args& a, Frame& F, int j_layer, bool ctx_out) {
    relaunder(F);
    float zf_ = 0.f; asm volatile("" : "+v"(zf_));
    const f32x4 ZERO4 = {zf_, zf_, zf_, zf_};
    constexpr int HD = 256, NH = 8, NEB = 4, C = 64, NCTX = CTXL / C, NCH = (CTXL + SEQ) / C, KS = HD / 32;
    constexpr int QS = HD * 2 + 16, IMG = 64 * QS, PS = MX_PS, VTB = 64 * PS;
    constexpr int O_VT = 2 * IMG, O_P = O_VT + 2 * VTB, O_ST = O_P + VTB, O_END = O_ST + IMG;
    static_assert(O_END <= RING_BYTES && MX_SWZ == 0, "mixer_ret3 LDS (padded images)");
    const int lane = F.lane, w = F.wave, tid = F.tid, g = lane >> 4, i = lane & 15;
    const int rg = w >> 1, cg = w & 1, nq0 = 16 * rg;
    LAS unsigned char* const L = F.lds;
    const bf16* act = (const bf16*)(a.ws + WS_ACT);
    for (int task = F.vcu; task < BATCH * NH * 2 * NEB; task += F.G) {
        const int eb = task % NEB, dir = (task / NEB) & 1, h = (task / (2 * NEB)) % NH, b = task / (2 * NEB * NH);
        bf16* O = (bf16*)(a.ws + (dir ? WS_OB : WS_OF));
        const bf16* src0 = act; const bf16* src1 = act + ACT_STRIDE; const bf16* srcv = act + (size_t)2 * ACT_STRIDE;
        const float x = a.in[10][(j_layer * 2 + dir) * 8 + h];
        const float lg2 = -log1pf(expf(-x)) * 1.4426950408889634f;
        const float r1 = exp2f((float)(nq0 + i - 63) * lg2), r2 = exp2f((float)(nq0 + i + 1) * lg2), cdec = exp2f(64.f * lg2);
        const int vrow = tid & 63, vcc = tid >> 6, vs = dir ? 63 - vrow : vrow;
        const float kdec = exp2f((float)(63 - vs) * lg2);
        f32x4 accS[2][4];
#pragma unroll
        for (int td = 0; td < 2; ++td)
#pragma unroll
            for (int te = 0; te < 4; ++te) accS[td][te] = ZERO4;
        v4u rq[2][4]; v4u rv;
#define R3_ROWLO(c) (((c) < NCTX) ? (ML + b * CTXL + (dir ? (NCTX - 1 - (c)) : (c)) * C) : (b * SEQ + (dir ? (SEQ / C - 1 - ((c) - NCTX)) : ((c) - NCTX)) * C))
#define R3_LOAD(c) do { const int rlo_ = R3_ROWLO(c); \
        _Pragma("unroll") for (int p_ = 0; p_ < 4; ++p_) { const int pc_ = tid + 512 * p_; const size_t go_ = (size_t)(rlo_ + (pc_ >> 5)) * D + h * HD + (pc_ & 31) * 8; \
            rq[0][p_] = *(const GAS v4u*)(src0 + go_); rq[1][p_] = *(const GAS v4u*)(src1 + go_); } \
        rv = *(const GAS v4u*)(srcv + (size_t)(rlo_ + vrow) * D + h * HD + eb * 64 + vcc * 8); } while (0)
#define R3_STAGE(vb) do { \
        _Pragma("unroll") for (int p_ = 0; p_ < 4; ++p_) { const int pc_ = tid + 512 * p_; const int row_ = pc_ >> 5; const int s_ = dir ? 63 - row_ : row_; const int so_ = s_ * QS + (pc_ & 31) * 16; \
            *(LAS v4u*)(L + so_) = rq[0][p_]; *(LAS v4u*)(L + IMG + so_) = rq[1][p_]; } \
        { const unsigned vw_[4] = {rv.x, rv.y, rv.z, rv.w}; \
          _Pragma("unroll") for (int jj_ = 0; jj_ < 4; ++jj_) { const unsigned pw_ = pk2(bflo(vw_[jj_]) * kdec, bfhi(vw_[jj_]) * kdec); \
              *(LAS unsigned short*)(L + O_VT + (vb) * VTB + (vcc * 8 + 2 * jj_) * PS + vs * 2) = (unsigned short)(pw_ & 0xffffu); \
              *(LAS unsigned short*)(L + O_VT + (vb) * VTB + (vcc * 8 + 2 * jj_ + 1) * PS + vs * 2) = (unsigned short)(pw_ >> 16); } } } while (0)
        __syncthreads();
        { const unsigned zu_ = __builtin_bit_cast(unsigned, zf_); for (int u = tid; u < IMG / 16; u += NWAVES * 64) *(LAS v4u*)(L + O_ST + u * 16) = (v4u){zu_, zu_, zu_, zu_}; }
        R3_LOAD(0);
        R3_STAGE(0);
        R3_LOAD(1);
        MX_BAR();
        for (int c = 0; c < NCH; ++c) {
            const int vb = c & 1;
            LAS unsigned char* const Vc = L + O_VT + vb * VTB;
            const int rlo = R3_ROWLO(c);
            const bool do_out = ctx_out || c >= NCTX;
            if (c > 0) {
#pragma unroll
                for (int td = 0; td < 2; ++td)
#pragma unroll
                    for (int te = 0; te < 4; ++te) { const int d0 = 16 * (2 * w + td); const f32x4 s = accS[td][te];
                        v2u sw; sw.x = pk2(s[0], s[1]); sw.y = pk2(s[2], s[3]);
                        *(LAS v2u*)(L + O_ST + (16 * te + i) * QS + (d0 + 4 * g) * 2) = sw; }
            }
            mx_bf16x8 aq[KS];
            if (do_out) {
#pragma unroll
                for (int ks = 0; ks < KS; ++ks) aq[ks] = frag_row(L, QS, nq0, 32 * ks, lane);
                f32x4 pt0 = ZERO4, pt1 = ZERO4;
#pragma unroll
                for (int kb = 0; kb < KS; kb += 4) {
                    mx_bf16x8 kf[2][4];
#pragma unroll
                    for (int ks = 0; ks < 4; ++ks) { kf[0][ks] = frag_row(L + IMG, QS, 32 * cg, 32 * (kb + ks), lane); kf[1][ks] = frag_row(L + IMG, QS, 32 * cg + 16, 32 * (kb + ks), lane); }
                    __builtin_amdgcn_sched_barrier(0);
#pragma unroll
                    for (int ks = 0; ks < 4; ++ks) { pt0 = MX_MFMA(kf[0][ks], aq[kb + ks], pt0); pt1 = MX_MFMA(kf[1][ks], aq[kb + ks], pt1); }
                    __builtin_amdgcn_sched_barrier(0);
                }
                const int m0 = 32 * cg + 4 * g, m1 = m0 + 16, n = nq0 + i;
                v2u pw; pw.x = pk2((m0 <= n) ? pt0[0] : 0.f, (m0 + 1 <= n) ? pt0[1] : 0.f); pw.y = pk2((m0 + 2 <= n) ? pt0[2] : 0.f, (m0 + 3 <= n) ? pt0[3] : 0.f);
                *(LAS v2u*)(L + O_P + n * PS + m0 * 2) = pw;
                pw.x = pk2((m1 <= n) ? pt1[0] : 0.f, (m1 + 1 <= n) ? pt1[1] : 0.f); pw.y = pk2((m1 + 2 <= n) ? pt1[2] : 0.f, (m1 + 3 <= n) ? pt1[3] : 0.f);
                *(LAS v2u*)(L + O_P + n * PS + m1 * 2) = pw;
            }
            {
                mx_bf16x8 vt[4][2], ak[2][2];
#pragma unroll
                for (int te = 0; te < 4; ++te) { vt[te][0] = frag_row8(Vc, 16 * te, 0, lane); vt[te][1] = frag_row8(Vc, 16 * te, 32, lane); }
#pragma unroll
                for (int td = 0; td < 2; ++td) { ak[td][0] = frag_tr(L + IMG, QS, 0, 16 * (2 * w + td), lane); ak[td][1] = frag_tr(L + IMG, QS, 32, 16 * (2 * w + td), lane); }
                __builtin_amdgcn_sched_barrier(0);
#pragma unroll
                for (int td = 0; td < 2; ++td)
#pragma unroll
                    for (int te = 0; te < 4; ++te) accS[td][te] = MX_MFMA(ak[td][0], vt[te][0], accS[td][te] * cdec);
#pragma unroll
                for (int td = 0; td < 2; ++td)
#pragma unroll
                    for (int te = 0; te < 4; ++te) accS[td][te] = MX_MFMA(ak[td][1], vt[te][1], accS[td][te]);
            }
            MX_BAR();
            if (do_out) {
                mx_bf16x8 vo[2][2];
                const mx_bf16x8 bp0 = frag_row8(L + O_P, nq0, 0, lane), bp1 = frag_row8(L + O_P, nq0, 32, lane);
#pragma unroll
                for (int te = 0; te < 2; ++te) { vo[te][0] = frag_row8(Vc, 32 * cg + 16 * te, 0, lane); vo[te][1] = frag_row8(Vc, 32 * cg + 16 * te, 32, lane); }
                f32x4 o1a = ZERO4, o1b = ZERO4, o2a = ZERO4, o2b = ZERO4;
#pragma unroll
                for (int kb = 0; kb < KS; kb += 4) {
                    mx_bf16x8 st[2][4];
#pragma unroll
                    for (int ks = 0; ks < 4; ++ks) { st[0][ks] = frag_row(L + O_ST, QS, 32 * cg, 32 * (kb + ks), lane); st[1][ks] = frag_row(L + O_ST, QS, 32 * cg + 16, 32 * (kb + ks), lane); }
                    __builtin_amdgcn_sched_barrier(0);
                    if (kb == 0) { o1a = MX_MFMA(vo[0][0], bp0, o1a); o1b = MX_MFMA(vo[1][0], bp0, o1b); o1a = MX_MFMA(vo[0][1], bp1, o1a); o1b = MX_MFMA(vo[1][1], bp1, o1b); }
#pragma unroll
                    for (int ks = 0; ks < 4; ++ks) { o2a = MX_MFMA(st[0][ks], aq[kb + ks], o2a); o2b = MX_MFMA(st[1][ks], aq[kb + ks], o2b); }
                    __builtin_amdgcn_sched_barrier(0);
                }
                bf16* op = O + (size_t)(rlo + (dir ? 63 - (nq0 + i) : (nq0 + i))) * D + h * HD + eb * 64 + 32 * cg + 4 * g;
                const f32x4 ya = o1a * r1 + o2a * r2, yb = o1b * r1 + o2b * r2; v2u wa, wb; wa.x = pk2(ya[0], ya[1]); wa.y = pk2(ya[2], ya[3]); wb.x = pk2(yb[0], yb[1]); wb.y = pk2(yb[2], yb[3]);
                *(GAS v2u*)(op) = wa; *(GAS v2u*)(op + 16) = wb;
            }
            if (c + 1 < NCH) R3_STAGE(vb ^ 1);
            { const int cn = (c + 2 < NCH) ? c + 2 : NCH - 1; R3_LOAD(cn); }
            MX_BAR();
        }
#undef R3_ROWLO
#undef R3_LOAD
#undef R3_STAGE
    }
}
#ifndef MIX_MFMA_RET
#define MIX_MFMA_RET 1
#endif
#ifndef MIX_RET_V3
#define MIX_RET_V3 0
#endif
#ifndef MIX_HG_V2
#define MIX_HG_V2 1
#endif
#ifndef MIX_MFMA_HG
#define MIX_MFMA_HG 1
#endif
#ifndef REP_NORM
#define REP_NORM 1
#endif
#ifndef REP_GEMM_IN
#define REP_GEMM_IN 1
#endif
#ifndef REP_MIX_RET
#define REP_MIX_RET 1
#endif
#ifndef REP_MIX_HG
#define REP_MIX_HG 1
#endif
#ifndef REP_READ
#define REP_READ 1
#endif
#ifndef REP_GU
#define REP_GU 1
#endif
__global__ void __launch_bounds__(NWAVES * 64, 2) fwd_kernel(Args args_in) {
    const Args& args = args_in;
    extern __shared__ __attribute__((aligned(16))) unsigned char lds[];
    Frame F;
    F.lds = (LAS unsigned char*)lds;
    volatile LAS unsigned* MISC = (volatile LAS unsigned*)(F.lds + MISC_OFF);
    F.tid = threadIdx.x; F.lane = F.tid & 63; F.wave = __builtin_amdgcn_readfirstlane(F.tid >> 6);
    F.G = gridDim.x; { const int bx = blockIdx.x; F.vcu = (F.G % 8 == 0) ? (bx % 8) * (F.G / 8) + bx / 8 : bx; }
    unsigned char* ws = args.ws;
    F.ctl = (gu32*)(ws + WS_CTL);
    for (int u = F.tid; u < (LDS_BYTES - LDSCTL_OFF) / 4; u += NWAVES * 64) ((LAS unsigned*)(F.lds + LDSCTL_OFF))[u] = 0u;
    __syncthreads();
    if (F.lane == 0) *(volatile LAS unsigned*)(F.lds + TIDTAB_OFF + 4 * mk_hwkey()) = (unsigned)F.wave;
    XcdBarrier bar; bar.bar = (unsigned*)(F.ctl + CW_BAR); bar.x = 0; bar.st = nullptr;
    if (MK_N_LAUNCHES == 1) bar = xcd_barrier_post((unsigned*)(F.ctl + CW_BAR), MISC + 8);
    const int lo = args.ph_lo, hi = args.ph_hi;
#define IN(k) (lo <= (k) && (k) < hi)
#define SEAM(k) do { if (IN(k) && IN((k) + 1)) { XcdBarrier b_ = bar; asm volatile("" : "+s"(b_.bar), "+s"(b_.x));     \
        xcd_barrier(b_); if (REP_BAR > 1) xcd_barrier(b_); } } while (0)
    if (IN(0)) { p0_prologue(args, F); }
    SEAM(0);
    if (IN(1)) { p1_modreduce(args, F); }
    SEAM(1);

    for (int layer = 0; layer < DEPTH; ++layer) {
        asm volatile("" : "+s"(ws));
        const Args* kap = (const Args*)__builtin_amdgcn_kernarg_segment_ptr(); asm volatile("" : "+s"(kap));
        const Args& args = *kap;
        const float* MOD = (const float*)(ws + WS_MOD);
        const float* TAB = (const float*)(ws + WS_TAB);
        bf16* X = (bf16*)(ws + WS_X);
        bf16* HN = (bf16*)(ws + WS_HN);
        bf16* ACT = (bf16*)(ws + WS_ACT);
        const int pb = 2 + 8 * layer;
        const bool last = (layer == DEPTH - 1), hg = (layer & 1) != 0;
        const int j = layer >> 1;
        const int Mr = last ? ML : M;
        const bool tc = TAIL_CONVERT != 0 && !last && F.G == 256 && MK_N_LAUNCHES == 1;
        const int tc_slot = ((int)blockIdx.x & 7) * 32 + ((int)blockIdx.x >> 3);
        const int tc_rem1 = (hg ? (M / 256) * 40 : (M / 256) * 32) % 256, tc_idle1 = 256 - tc_rem1;
        const float* modl = MOD + (size_t)layer * 5 * MOD_LD;
        unsigned char* wb = ws + WS_W + (size_t)layer * W_LAYER;
        if (IN(pb + 0)) NORM_FN(args, F, args.in[6] + (size_t)layer * D, modl, 0, D, M, layer > 0 ? (modl - 5 * MOD_LD) + 4 * MOD_LD + 5 * D : nullptr);
        SEAM(pb + 0);
        if (!hg) {
            if (IN(pb + 1)) {
                pg8::Gemm g{HN, (const bf16*)(wb + W_IN), M, 4 * D, D, D, D}; pg8::StaticOrder S; S.init(M, 4 * D, F.G, (int)blockIdx.x);
                pg8::EpiRetIn E{ACT, ACT_STRIDE, TAB + TAB_COS / 4, TAB + TAB_SIN / 4, NLP};
                for (int rep = 0; rep < REP_GEMM_IN; ++rep) pg8::gemm_phase<pg8::EpiRetIn, pg8::StaticOrder, GEMM_ALIGN, GEMM_SP2>(F.lds, g, S, E);
                if (tc && tc_slot >= tc_rem1) tail_convert(args, F, layer + 1, 1, tc_slot - tc_rem1, tc_idle1, tc_idle1);
            }
            SEAM(pb + 1);
            if (IN(pb + 2)) for (int rep = 0; rep < REP_MIX_RET; ++rep) { if (MIX_RET_V3) mixer_ret3(args, F, j, !last); else if (MIX_MFMA_RET) mixer_mfma<false>(args, F, j, !last); else mixer_phase<false>(args, F, j, !last); if (MXV_RET) mixer_mfma<false, MXV_RET>(args, F, j, !last); }
            SEAM(pb + 2);
            if (IN(pb + 3)) for (int rep = 0; rep < REP_READ; ++rep) { if (NORM_PIPE && F.G == 256) readout_phase2<false>(args, F, nullptr, Mr); else readout_phase<false>(args, F, nullptr, Mr); }
            SEAM(pb + 3);
        } else {
            if (IN(pb + 1)) {
                pg8::Gemm g{HN, (const bf16*)(wb + W_IN), M, 5 * D, D, D, D}; pg8::StaticOrder S; S.init(M, 5 * D, F.G, (int)blockIdx.x);
                pg8::EpiHgIn E{ACT, ACT_STRIDE, TAB + TAB_LB / 4 + (size_t)j * D};
                for (int rep = 0; rep < REP_GEMM_IN; ++rep) pg8::gemm_phase<pg8::EpiHgIn, pg8::StaticOrder, GEMM_ALIGN, GEMM_SP2>(F.lds, g, S, E);
                if (tc && tc_slot >= tc_rem1) tail_convert(args, F, layer + 1, 1, tc_slot - tc_rem1, tc_idle1, tc_idle1);
            }
            SEAM(pb + 1);
            if (IN(pb + 2)) for (int rep = 0; rep < REP_MIX_HG; ++rep) { if (MIX_HG_V2) mixer_hg2(args, F, !last); else if (MIX_MFMA_HG) mixer_mfma<true>(args, F, j, !last); else mixer_phase<true>(args, F, j, !last); if (MXV_HG) mixer_mfma<true, MXV_HG>(args, F, j, !last); }
            SEAM(pb + 2);
            if (IN(pb + 3)) for (int rep = 0; rep < REP_READ; ++rep) { if (NORM_PIPE && F.G == 256) readout_phase2<true>(args, F, args.in[13] + (size_t)j * D, Mr); else readout_phase<true>(args, F, args.in[13] + (size_t)j * D, Mr); }
            SEAM(pb + 3);
        }
        if (IN(pb + 4)) {
            pg8::Gemm g{HN, (const bf16*)(wb + W_OUT), ML, D, D, D, D}; pg8::StaticOrder S; S.init(ML, D, F.G, (int)blockIdx.x);
            pg8::EpiResid E{X, modl + 2 * D, MOD_LD, NLP};
            pg8::gemm_phase<pg8::EpiResid, pg8::StaticOrder, RESID_ALIGN, GEMM_SP2>(F.lds, g, S, E);
            if (!last) {
                pg8::Gemm g2{HN, (const bf16*)(wb + W_OUT), M, D, D / 4, D, D}; pg8::SplitKOrder S2{F.G, (int)blockIdx.x, NLP, D / 4};
                pg8::EpiSlab E2{(float*)(ws + WS_SLAB), NLP, D / 4, (size_t)MC * D};
                pg8::gemm_phase<pg8::EpiSlab, pg8::SplitKOrder, true, true>(F.lds, g2, S2, E2);
                if (tc && (int)blockIdx.x >= 128) tail_convert(args, F, layer + 1, 2, (int)blockIdx.x - 128, 128, tc_idle1);
            }
        }
        SEAM(pb + 4);
        if (IN(pb + 5)) NORM_FN(args, F, args.in[7] + (size_t)layer * D, modl, 3 * D, 4 * D, Mr, last ? nullptr : modl + 4 * MOD_LD + 2 * D);
        SEAM(pb + 5);
        if (IN(pb + 6)) {
            pg8::Gemm g{HN, (const bf16*)(wb + W_GU), Mr, 2 * FF, D, D, D}; pg8::StaticOrder S; S.init(Mr, 2 * FF, F.G, (int)blockIdx.x, GU_WGM);
            if (KPROBE_GU) { pg8::TwiceOrder S2; S2.init(Mr, 2 * FF, F.G, (int)blockIdx.x); pg8::EpiGateUp E{ACT, FF, 0.5f}; pg8::gemm_phase<pg8::EpiGateUp, pg8::TwiceOrder, true, true>(F.lds, g, S2, E); }
            else { pg8::EpiGateUp E{ACT, FF, 1.0f};
            for (int rep = 0; rep < REP_GU; ++rep) pg8::gemm_phase<pg8::EpiGateUp, pg8::StaticOrder, GEMM_ALIGN, GEMM_SP2>(F.lds, g, S, E); }
            if (tc && tc_slot >= 176) tail_convert(args, F, layer + 1, 3, tc_slot - 176, 80, tc_idle1);
        }
        SEAM(pb + 6);
        if (IN(pb + 7)) {
            pg8::Gemm g{ACT, (const bf16*)(wb + W_DN), ML, D, FF, FF, FF}; pg8::StaticOrder S; S.init(ML, D, F.G, (int)blockIdx.x);
            pg8::EpiResid E{X, modl + 5 * D, MOD_LD, NLP};
            pg8::gemm_phase<pg8::EpiResid, pg8::StaticOrder, RESID_ALIGN, GEMM_SP2>(F.lds, g, S, E);
            if (!last) {
                pg8::Gemm g2{ACT, (const bf16*)(wb + W_DN), M, D, FF / 4, FF, FF}; pg8::SplitKOrder S2{F.G, (int)blockIdx.x, NLP, FF / 4};
                pg8::EpiSlab E2{(float*)(ws + WS_SLAB), NLP, FF / 4, (size_t)MC * D};
                pg8::gemm_phase<pg8::EpiSlab, pg8::SplitKOrder, true, true>(F.lds, g2, S2, E2);
                if (tc && (int)blockIdx.x >= 128) tail_convert(args, F, layer + 1, 4, (int)blockIdx.x - 128, 128, tc_idle1);
            }
        }
        SEAM(pb + 7);
    }
    if (IN(N_PHASES - 1)) { if (NORM_PIPE && F.G == 256) final_norm_phase2(args, F); else final_norm_phase(args, F); }
#undef IN
#undef SEAM
}

extern "C" void kernel_launch(void* const* d_in, const int* in_sizes, int n_in, void* d_out, int out_size, void* d_ws, size_t ws_size, hipStream_t stream) {
    static int grid = 0;
    if (grid == 0) {
        if (n_in != 18 || in_sizes[0] != ML * D || out_size != ML * D || ws_size < WS_END) { fprintf(stderr, "kernel_launch: unexpected shapes (n_in %d, in0 %d, out %d, ws %zu < %zu); nothing launched\n", n_in, n_in > 0 ? in_sizes[0] : -1, out_size, ws_size, (size_t)WS_END); grid = -1; return; }
        int dev = 0, cus = 0, per_cu = 0;
        if (hipGetDevice(&dev) != hipSuccess || hipDeviceGetAttribute(&cus, hipDeviceAttributeMultiprocessorCount, dev) != hipSuccess) { grid = -1; return; }
        if (hipFuncSetAttribute((const void*)fwd_kernel, hipFuncAttributeMaxDynamicSharedMemorySize, LDS_BYTES) != hipSuccess) { fprintf(stderr, "kernel_launch: hipFuncSetAttribute failed\n"); grid = -1; return; }
        if (hipOccupancyMaxActiveBlocksPerMultiprocessor(&per_cu, (const void*)fwd_kernel, NWAVES * 64, LDS_BYTES) != hipSuccess || per_cu < 1) { fprintf(stderr, "kernel_launch: occupancy query says %d blocks per CU\n", per_cu); (void)hipGetLastError(); grid = -1; return; }
        grid = cus;
    }
    if (grid < 0) return;
    if (hipMemsetAsync((char*)d_ws, 0, ZERO_BYTES, stream) != hipSuccess) return;
    Args a{};
    for (int i = 0; i < 18; ++i) a.in[i] = (const float*)d_in[i];
    a.out = (float*)d_out; a.ws = (unsigned char*)d_ws;
    if (MK_N_LAUNCHES == 1) {
        a.ph_lo = 0; a.ph_hi = N_PHASES;
        hipLaunchKernelGGL(fwd_kernel, dim3(grid), dim3(NWAVES * 64), LDS_BYTES, stream, a);
    } else {
        for (int p = 0; p < N_PHASES; ++p) { a.ph_lo = p; a.ph_hi = p + 1; hipLaunchKernelGGL(fwd_kernel, dim3(grid), dim3(NWAVES * 64), LDS_BYTES, stream, a); }
    }
}
```
